# Optimizing an MI355X kernel written in HIP

```python
import jax
import jax.numpy as jnp
from jax import lax
import numpy as np

D_MODEL = 1024
BATCH = 8
SEQ = 4096
DEPTH = 2

HEAD_DIM = 64
ROPE_DIM = HEAD_DIM // 4
ROPE_THETA = 500000.0
NORM_EPS = 1e-6
ATTN_SCALE = HEAD_DIM ** -0.5
NEG_INF = -1e30
FORCE_SCORE = 1e4
Q_CHUNK = 128

A_HEADS = 6
A_WIDTH = A_HEADS * HEAD_DIM
A_PATTERNS = ((128, 1), (512, 4), (2048, 16))
A_BLOCK = 128

B_HEADS = 4
B_WIDTH = B_HEADS * HEAD_DIM
CMP_BLOCK = 32
CMP_STRIDE = 16
CMP_HIDDEN = 128
SEL_BLOCK = 64
SEL_TOP = 16
WIN_SIZE = 512
WIN_BLOCK = 128

C_HEADS = 4
C_WIDTH = C_HEADS * HEAD_DIM
MOBA_BLOCK = 256
MOBA_TOP = 3
MOBA_Q_CHUNK = 64

IN_SIZES = (A_WIDTH, A_WIDTH, A_WIDTH, A_WIDTH,
            B_WIDTH, HEAD_DIM, HEAD_DIM, HEAD_DIM, HEAD_DIM, HEAD_DIM, HEAD_DIM, 3 * B_HEADS, B_WIDTH,
            C_WIDTH, C_WIDTH, C_WIDTH, C_WIDTH,
            D_MODEL, D_MODEL, D_MODEL)
IN_WIDTH = sum(IN_SIZES)

kernel_name = 'hybrid_dilated_nsa_moba_block'


def rms_norm(x, g):
    xf = x.astype(jnp.float32)
    y = xf * lax.rsqrt(jnp.mean(xf * xf, axis=-1, keepdims=True) + NORM_EPS)
    return (y * g.astype(jnp.float32)).astype(x.dtype)


def partial_rope(x, positions):
    half = ROPE_DIM // 2
    freqs = ROPE_THETA ** (-jnp.arange(half, dtype=jnp.float32) / half)
    ang = positions.astype(jnp.float32)[..., None] * freqs
    cos = jnp.cos(ang)[:, :, None, :]
    sin = jnp.sin(ang)[:, :, None, :]
    xr = x[..., :ROPE_DIM].astype(jnp.float32)
    x1, x2 = xr[..., :half], xr[..., half:]
    rot = jnp.concatenate([x1 * cos - x2 * sin, x2 * cos + x1 * sin], axis=-1).astype(x.dtype)
    return jnp.concatenate([rot, x[..., ROPE_DIM:]], axis=-1)


def chunk_major(x, c):
    b, s = x.shape[:2]
    return x.reshape(b, s // c, c, *x.shape[2:]).swapaxes(0, 1)


def chunk_restore(y):
    n, b, c = y.shape[:3]
    return y.swapaxes(0, 1).reshape(b, n * c, *y.shape[3:])


def banded_attention(q, k, v, max_dist, blk):
    n, L, hk, g, dh = q.shape
    nb = -(-L // blk)
    pad = nb * blk - L
    n_prev = -(-max_dist // blk)
    qb = jnp.pad(q, ((0, 0), (0, pad), (0, 0), (0, 0), (0, 0))).reshape(n, nb, blk, hk, g, dh)

    def windows(t):
        tp = jnp.pad(t, ((0, 0), (n_prev * blk, pad), (0, 0), (0, 0))).reshape(n, nb + n_prev, blk, hk, dh)
        return jnp.concatenate([tp[:, o:o + nb] for o in range(n_prev + 1)], axis=2)

    kw, vw = windows(k), windows(v)
    s = jnp.einsum('nbqhgd,nbkhd->nbhgqk', qb, kw, preferred_element_type=jnp.float32) * ATTN_SCALE
    qi = jnp.arange(blk)[:, None]
    kj = jnp.arange((n_prev + 1) * blk)[None, :]
    dist = qi - kj + n_prev * blk
    kpos = (jnp.arange(nb)[:, None, None] - n_prev) * blk + kj[None]
    mask = (dist >= 0) & (dist <= max_dist) & (kpos >= 0)
    s = jnp.where(mask[None, :, None, None], s, NEG_INF)
    m = jnp.max(s, axis=-1, keepdims=True)
    e = jnp.exp(s - m)
    den = jnp.sum(e, axis=-1, keepdims=True)
    o = jnp.einsum('nbhgqk,nbkhd->nbqhgd', (e / den).astype(v.dtype), vw)
    lse = (m + jnp.log(den))[..., 0]
    o = o.reshape(n, nb * blk, hk, g, dh)[:, :L]
    lse = lse.transpose(0, 1, 4, 2, 3).reshape(n, nb * blk, hk, g)[:, :L]
    return o, lse


def dilated_mixture_attention(q, k, v):
    b, s, h, dh = q.shape
    outs, lses = [], []
    for window, dil in A_PATTERNS:
        L = s // dil

        def to_res(t):
            return t.reshape(b, L, dil, h, dh).transpose(0, 2, 1, 3, 4).reshape(b * dil, L, h, dh)

        o, lse = banded_attention(to_res(q)[:, :, :, None], to_res(k), to_res(v), window // dil, A_BLOCK)
        outs.append(o[:, :, :, 0].reshape(b, dil, L, h, dh).transpose(0, 2, 1, 3, 4).reshape(b, s, h, dh))
        lses.append(lse[..., 0].reshape(b, dil, L, h).transpose(0, 2, 1, 3).reshape(b, s, h))
    w = jax.nn.softmax(jnp.stack(lses), axis=0)
    return jnp.einsum('pbsh,pbshd->bshd', w.astype(q.dtype), jnp.stack(outs))


def nsa_attention(q, k_cmp, v_cmp, k_sel, v_sel, k_win, v_win, gates,
                  cmp_pos, ck_w1, ck_w2, cv_w1, cv_w2):
    b, s, g, dh = q.shape
    t = jnp.arange(s)
    r = CMP_BLOCK // CMP_STRIDE
    nc = s // CMP_STRIDE - r + 1

    def compress(x, w1, w2):
        xc = x.reshape(b, s // CMP_STRIDE, CMP_STRIDE, dh)
        blocks = jnp.concatenate([xc[:, o:o + nc] for o in range(r)], axis=2) + cmp_pos
        return jax.nn.silu(blocks.reshape(b, nc, CMP_BLOCK * dh) @ w1) @ w2

    kc = compress(k_cmp, ck_w1, ck_w2)
    vc = compress(v_cmp, cv_w1, cv_w2)
    s_c = jnp.einsum('bsgd,bcd->bsgc', q, kc, preferred_element_type=jnp.float32) * ATTN_SCALE
    c_start = jnp.arange(nc) * CMP_STRIDE
    c_mask = (c_start + CMP_BLOCK - 1)[None, :] <= t[:, None]
    cm = c_mask[None, :, None, :]
    p_c = jax.nn.softmax(jnp.where(cm, s_c, NEG_INF), axis=-1) * cm
    o_cmp = jnp.einsum('bsgc,bcd->bsgd', p_c.astype(vc.dtype), vc)

    ns = s // SEL_BLOCK
    j_start = jnp.arange(ns) * SEL_BLOCK
    cover = ((c_start[:, None] < j_start[None] + SEL_BLOCK) &
             (c_start[:, None] + CMP_BLOCK > j_start[None])).astype(jnp.float32)
    p_slc = jnp.einsum('bsgc,cj->bsj', p_c, cover)
    cur = t // SEL_BLOCK
    jj = jnp.arange(ns)
    valid = j_start[None, :] <= t[:, None]
    forced = (jj[None] == 0) | (jj[None] == cur[:, None]) | (jj[None] == cur[:, None] - 1)
    score = jnp.where(forced, FORCE_SCORE, jnp.where(valid, p_slc, NEG_INF))
    n_sel = min(SEL_TOP, ns)
    _, idx = lax.top_k(score, n_sel)
    sel_valid = jnp.take_along_axis(jnp.broadcast_to(valid, (b, s, ns)), idx, axis=-1)

    kb = k_sel.reshape(b, ns, SEL_BLOCK, dh)
    vb = v_sel.reshape(b, ns, SEL_BLOCK, dh)
    b_ix = jnp.arange(b)[:, None, None]
    kk = jnp.arange(SEL_BLOCK)

    def sel_chunk(args):
        qc, ic, mc, c = args
        kg = kb[b_ix, ic]
        vg = vb[b_ix, ic]
        tq = c * Q_CHUNK + jnp.arange(Q_CHUNK)
        kpos = ic[..., None] * SEL_BLOCK + kk
        msk = (kpos <= tq[None, :, None, None]) & mc[..., None]
        sc = jnp.einsum('bqgd,bqnkd->bqgnk', qc, kg, preferred_element_type=jnp.float32) * ATTN_SCALE
        sc = jnp.where(msk[:, :, None], sc, NEG_INF).reshape(b, Q_CHUNK, g, n_sel * SEL_BLOCK)
        p = jax.nn.softmax(sc, axis=-1).reshape(b, Q_CHUNK, g, n_sel, SEL_BLOCK)
        return jnp.einsum('bqgnk,bqnkd->bqgd', p.astype(vg.dtype), vg)

    nch = s // Q_CHUNK
    o_sel = chunk_restore(lax.map(sel_chunk, (chunk_major(q, Q_CHUNK), chunk_major(idx, Q_CHUNK),
                                              chunk_major(sel_valid, Q_CHUNK), jnp.arange(nch))))

    o_win, _ = banded_attention(q[:, :, None], k_win[:, :, None], v_win[:, :, None], WIN_SIZE - 1, WIN_BLOCK)
    o_win = o_win[:, :, 0]

    gs = jax.nn.sigmoid(gates.astype(jnp.float32)).astype(q.dtype)[..., None]
    return gs[:, :, 0] * o_cmp + gs[:, :, 1] * o_sel + gs[:, :, 2] * o_win


def moba_attention(q, k, v):
    b, s, h, dh = q.shape
    nblk = -(-s // MOBA_BLOCK)
    sp = nblk * MOBA_BLOCK
    padw = ((0, 0), (0, sp - s), (0, 0), (0, 0))
    q, k, v = jnp.pad(q, padw), jnp.pad(k, padw), jnp.pad(v, padw)
    t = jnp.arange(sp)
    kblk = k.reshape(b, nblk, MOBA_BLOCK, h, dh)
    vblk = v.reshape(b, nblk, MOBA_BLOCK, h, dh)
    n_top = min(MOBA_TOP, nblk - 1)
    kk = jnp.arange(MOBA_BLOCK)
    nch = sp // MOBA_Q_CHUNK
    xs = (chunk_major(q, MOBA_Q_CHUNK), jnp.arange(nch))
    if n_top > 0:
        kmean = jnp.mean(kblk.astype(jnp.float32), axis=2)
        s_blk = jnp.einsum('bshd,bnhd->bshn', q.astype(jnp.float32), kmean)
        past = (jnp.arange(nblk)[None, :] < (t // MOBA_BLOCK)[:, None])[None, :, None, :]
        _, idx = lax.top_k(jnp.where(past, s_blk, NEG_INF), n_top)
        sel_valid = jnp.take_along_axis(jnp.broadcast_to(past, s_blk.shape), idx, axis=-1)
        xs = xs + (chunk_major(idx, MOBA_Q_CHUNK), chunk_major(sel_valid, MOBA_Q_CHUNK))
    kt = kblk.transpose(0, 3, 1, 2, 4)
    vt = vblk.transpose(0, 3, 1, 2, 4)
    b_ix = jnp.arange(b)[:, None, None, None]
    h_ix = jnp.arange(h)[None, None, :, None]

    def chunk(args):
        qc, c = args[0], args[1]
        tq = c * MOBA_Q_CHUNK + jnp.arange(MOBA_Q_CHUNK)
        bo = (c * MOBA_Q_CHUNK) // MOBA_BLOCK
        k_own = lax.dynamic_index_in_dim(kblk, bo, axis=1, keepdims=False)
        v_own = lax.dynamic_index_in_dim(vblk, bo, axis=1, keepdims=False)
        s_own = jnp.einsum('bqhd,bkhd->bqhk', qc, k_own, preferred_element_type=jnp.float32) * ATTN_SCALE
        own_mask = (bo * MOBA_BLOCK + kk)[None, :] <= tq[:, None]
        s_own = jnp.where(own_mask[None, :, None, :], s_own, NEG_INF)
        if n_top == 0:
            p_own = jax.nn.softmax(s_own, axis=-1)
            return jnp.einsum('bqhk,bkhd->bqhd', p_own.astype(v_own.dtype), v_own)
        ic, mc = args[2], args[3]
        kg = kt[b_ix, h_ix, ic]
        vg = vt[b_ix, h_ix, ic]
        s_sel = jnp.einsum('bqhd,bqhnkd->bqhnk', qc, kg, preferred_element_type=jnp.float32) * ATTN_SCALE
        s_sel = jnp.where(mc[..., None], s_sel, NEG_INF).reshape(b, MOBA_Q_CHUNK, h, n_top * MOBA_BLOCK)
        p = jax.nn.softmax(jnp.concatenate([s_sel, s_own], axis=-1), axis=-1).astype(v.dtype)
        p_sel = p[..., :n_top * MOBA_BLOCK].reshape(b, MOBA_Q_CHUNK, h, n_top, MOBA_BLOCK)
        p_own = p[..., n_top * MOBA_BLOCK:]
        return (jnp.einsum('bqhnk,bqhnkd->bqhd', p_sel, vg) +
                jnp.einsum('bqhk,bkhd->bqhd', p_own, v_own))

    return chunk_restore(lax.map(chunk, xs))[:, :s]


def hybrid_layer(x, positions, norm_g, w_in, q_norm_a, k_norm_a, q_norm_b, k_norm_b, q_norm_c, k_norm_c,
                 cmp_pos, cmp_k_w1, cmp_k_w2, cmp_v_w1, cmp_v_w2, w_br_a, w_br_b, w_br_c, w_out):
    b, s, _ = x.shape
    hn = rms_norm(x, norm_g)
    proj = hn @ w_in
    points = np.cumsum(IN_SIZES)[:-1].tolist()
    (qa, ka, va, za, qb, kcb, vcb, ksb, vsb, kwb, vwb, gb, zb,
     qc, kc, vc, zc, g_a, g_b, g_c) = jnp.split(proj, points, axis=-1)

    def heads(t, n):
        return t.reshape(b, s, n, HEAD_DIM)

    def qk(t, n, g):
        return partial_rope(rms_norm(heads(t, n), g), positions)

    def single_key(t):
        return partial_rope(rms_norm(t, k_norm_b)[:, :, None], positions)[:, :, 0]

    o_a = dilated_mixture_attention(qk(qa, A_HEADS, q_norm_a), qk(ka, A_HEADS, k_norm_a), heads(va, A_HEADS))
    u_a = (o_a.reshape(b, s, A_WIDTH) * jax.nn.silu(za)) @ w_br_a

    o_b = nsa_attention(qk(qb, B_HEADS, q_norm_b), single_key(kcb), vcb, single_key(ksb), vsb,
                        single_key(kwb), vwb, gb.reshape(b, s, 3, B_HEADS),
                        cmp_pos, cmp_k_w1, cmp_k_w2, cmp_v_w1, cmp_v_w2)
    u_b = (o_b.reshape(b, s, B_WIDTH) * jax.nn.silu(zb)) @ w_br_b

    o_c = moba_attention(qk(qc, C_HEADS, q_norm_c), qk(kc, C_HEADS, k_norm_c), heads(vc, C_HEADS))
    u_c = (o_c.reshape(b, s, C_WIDTH) * jax.nn.silu(zc)) @ w_br_c

    y = jax.nn.sigmoid(g_a) * u_a + jax.nn.sigmoid(g_b) * u_b + jax.nn.sigmoid(g_c) * u_c
    return x + y @ w_out


def setup_inputs(seed: int = 0) -> dict:
    key = jax.random.key(seed)
    ks = jax.random.split(key, 20)

    def nrm(k, shape, fan_in):
        return jax.random.normal(k, shape, jnp.float32) * fan_in ** -0.5

    def gain(k, shape):
        return 1.0 + 0.05 * jax.random.normal(k, shape, jnp.float32)

    return {
        'x': jax.random.normal(ks[0], (BATCH, SEQ, D_MODEL), jnp.float32),
        'positions': jnp.broadcast_to(jnp.arange(SEQ, dtype=jnp.int32)[None, :], (BATCH, SEQ)),
        'norm_g': gain(ks[1], (DEPTH, D_MODEL)),
        'w_in': nrm(ks[2], (DEPTH, D_MODEL, IN_WIDTH), D_MODEL),
        'q_norm_a': gain(ks[3], (DEPTH, HEAD_DIM)),
        'k_norm_a': gain(ks[4], (DEPTH, HEAD_DIM)),
        'q_norm_b': gain(ks[5], (DEPTH, HEAD_DIM)),
        'k_norm_b': gain(ks[6], (DEPTH, HEAD_DIM)),
        'q_norm_c': gain(ks[7], (DEPTH, HEAD_DIM)),
        'k_norm_c': gain(ks[8], (DEPTH, HEAD_DIM)),
        'cmp_pos': 0.1 * jax.random.normal(ks[9], (DEPTH, CMP_BLOCK, HEAD_DIM), jnp.float32),
        'cmp_k_w1': nrm(ks[10], (DEPTH, CMP_BLOCK * HEAD_DIM, CMP_HIDDEN), CMP_BLOCK * HEAD_DIM),
        'cmp_k_w2': nrm(ks[11], (DEPTH, CMP_HIDDEN, HEAD_DIM), CMP_HIDDEN),
        'cmp_v_w1': nrm(ks[12], (DEPTH, CMP_BLOCK * HEAD_DIM, CMP_HIDDEN), CMP_BLOCK * HEAD_DIM),
        'cmp_v_w2': nrm(ks[13], (DEPTH, CMP_HIDDEN, HEAD_DIM), CMP_HIDDEN),
        'w_br_a': nrm(ks[14], (DEPTH, A_WIDTH, D_MODEL), A_WIDTH),
        'w_br_b': nrm(ks[15], (DEPTH, B_WIDTH, D_MODEL), B_WIDTH),
        'w_br_c': nrm(ks[16], (DEPTH, C_WIDTH, D_MODEL), C_WIDTH),
        'w_out': nrm(ks[17], (DEPTH, D_MODEL, D_MODEL), D_MODEL),
    }


def reference(x, positions, norm_g, w_in, q_norm_a, k_norm_a, q_norm_b, k_norm_b, q_norm_c, k_norm_c,
              cmp_pos, cmp_k_w1, cmp_k_w2, cmp_v_w1, cmp_v_w2, w_br_a, w_br_b, w_br_c, w_out):
    for l in range(DEPTH):
        x = hybrid_layer(x, positions, norm_g[l], w_in[l], q_norm_a[l], k_norm_a[l], q_norm_b[l], k_norm_b[l],
                         q_norm_c[l], k_norm_c[l], cmp_pos[l], cmp_k_w1[l], cmp_k_w2[l], cmp_v_w1[l],
                         cmp_v_w2[l], w_br_a[l], w_br_b[l], w_br_c[l], w_out[l])
    return x
```

```cpp
#include <hip/hip_runtime.h>
#include <hip/hip_cooperative_groups.h>
#include <cstdio>
namespace cg = cooperative_groups;

typedef unsigned short u16;
typedef __attribute__((ext_vector_type(8))) short bf16x8;
typedef __attribute__((ext_vector_type(16))) float f32x16;
#define DI __device__ __forceinline__

constexpr int NP = 3584;
constexpr int INW = 6540;
constexpr int C_QA = 0, C_KA = 384, C_VA = 768, C_ZA = 1152, C_QB = 1536, C_KCB = 1792, C_VCB = 1856,
              C_KSB = 1920, C_VSB = 1984, C_KWB = 2048, C_VWB = 2112, C_ZB = 2176, C_QC = 2432, C_KC = 2688,
              C_VC = 2944, C_ZC = 3200, C_GB = 3456;
constexpr int SMEM_MAIN = 73728;
constexpr int SMEM_BYTES = SMEM_MAIN + 16;

struct Params {
  const float* x; const int* pos; const float* norm_g; const float* w_in;
  const float* qna; const float* kna; const float* qnb; const float* knb; const float* qnc; const float* knc;
  const float* cmp_pos; const float* ckw1; const float* ckw2; const float* cvw1; const float* cvw2;
  const float* wbra; const float* wbrb; const float* wbrc; const float* wout;
  float* out;
  u16* xb; u16* proj; u16* y; u16* Wt1; u16* Wg; u16* Wbr; u16* Wout; u16* W1t; u16* W2t;
  float* bias1; u16* kc; u16* vcF; u16* VA1; u16* VA4; u16* VA16; u16* VS; u16* VW; u16* VC; u16* kmean;
  float* rope; u16* obuf; unsigned* bar; float* mlA;
  u16* selm16; u16* mlist; int* mcnt; float* mlC;
};

__device__ const float c_freq[8] = {1.0f, 0.19392274474868576f, 0.03760603093086393f, 0.007292664737217109f,
                                    0.001414213562373095f, 0.0002742481756762073f, 5.318295896944988e-05f,
                                    1.031338537721246e-05f};

DI u16 f2bf(float f) { __bf16 b = (__bf16)f; return __builtin_bit_cast(u16, b); }
DI float bf2f(u16 h) { return __uint_as_float(((unsigned)h) << 16); }
DI unsigned pack2(float a, float b) { return (unsigned)f2bf(a) | ((unsigned)f2bf(b) << 16); }
DI f32x16 mfma32(bf16x8 a, bf16x8 b, f32x16 c) { return __builtin_amdgcn_mfma_f32_32x32x16_bf16(a, b, c, 0, 0, 0); }
DI f32x16 zero16() { f32x16 z;
#pragma unroll
  for (int i = 0; i < 16; ++i) z[i] = 0.f; return z; }
DI float sigmoidf_(float x) { return 1.f / (1.f + __expf(-x)); }
DI float siluf_(float x) { return x / (1.f + __expf(-x)); }

typedef __attribute__((ext_vector_type(2))) unsigned u32x2_t;
DI float xor32_max(float x) {
  const u32x2_t r = __builtin_amdgcn_permlane32_swap(__float_as_uint(x), __float_as_uint(x), false, false);
  return __builtin_amdgcn_fmed3f(__uint_as_float(r[0]), __uint_as_float(r[1]), __builtin_inff());
}
DI float xor32_sum(float x) {
  const u32x2_t r = __builtin_amdgcn_permlane32_swap(__float_as_uint(x), __float_as_uint(x), false, false);
  return __uint_as_float(r[0]) + __uint_as_float(r[1]);
}
DI float xor32_get(float x, int lh) {
  const u32x2_t r = __builtin_amdgcn_permlane32_swap(__float_as_uint(x), __float_as_uint(x), false, false);
  return __uint_as_float(lh ? r[0] : r[1]);
}
DI unsigned xor32_or(unsigned x) {
  const u32x2_t r = __builtin_amdgcn_permlane32_swap(x, x, false, false);
  return r[0] | r[1];
}


DI int tid_() { int t = threadIdx.x; asm volatile("" : "+v"(t)); return t; }
template <class T> DI T* as_global(T* ptr) { return (T*)(__attribute__((address_space(1))) T*)ptr; }
#define LAU(f) do { asm volatile("" : "+s"(q.f)); q.f = as_global(q.f); } while (0)
DI Params launder(const Params& p) {
  Params q = p;
  return q;
}

struct TDesc { const float* src; int ld; int nvalid; u16* dst; int dld; };
DI void tconv_pair(const TDesc a, const TDesc b, const bool hasb, float* sm) {
  const int tid = tid_(), n = tid & 63, kq = tid >> 6;
  float va[16], vb[16];
#pragma unroll
  for (int i = 0; i < 16; ++i) { const int k = i * 4 + kq; va[i] = (n < a.nvalid) ? a.src[(size_t)k * a.ld + n] : 0.f; }
#pragma unroll
  for (int i = 0; i < 16; ++i) { const int k = i * 4 + kq; vb[i] = (hasb && n < b.nvalid) ? b.src[(size_t)k * b.ld + n] : 0.f; }
#pragma unroll
  for (int i = 0; i < 16; ++i) { const int k = i * 4 + kq; sm[k * 65 + n] = va[i]; sm[4160 + k * 65 + n] = vb[i]; }
  __syncthreads();
  const int k = tid & 63;
#pragma unroll 4
  for (int i = 0; i < 16; ++i) {
    const int nn = i * 4 + kq;
    a.dst[(size_t)nn * a.dld + k] = f2bf(sm[k * 65 + nn]);
    if (hasb) b.dst[(size_t)nn * b.dld + k] = f2bf(sm[4160 + k * 65 + nn]);
  }
  __syncthreads();
}

DI TDesc tile_desc(const Params& p, int idx) {
  constexpr int TL = 2276;
  TDesc d;
  int l = idx / TL, t = idx % TL;
  if (t < 896) {
    int cg_ = t >> 4, kg = t & 15;
    d.nvalid = cg_ < 54 ? 64 : (cg_ == 54 ? 12 : 0);
    int srccol = cg_ < 34 ? cg_ * 64 : (cg_ < 54 ? cg_ * 64 + 12 : 2176);
    d.src = p.w_in + (size_t)l * 1024 * INW + (size_t)(kg * 64) * INW + srccol; d.ld = INW;
    d.dst = p.Wt1 + (size_t)l * NP * 1024 + (size_t)(cg_ * 64) * 1024 + kg * 64; d.dld = 1024;
  } else if (t < 1664) {
    t -= 896; int cg_ = t >> 4, kg = t & 15;
    d.nvalid = 64;
    d.src = p.w_in + (size_t)l * 1024 * INW + (size_t)(kg * 64) * INW + 3468 + cg_ * 64; d.ld = INW;
    d.dst = p.Wg + (size_t)l * 3072 * 1024 + (size_t)(cg_ * 64) * 1024 + kg * 64; d.dld = 1024;
  } else if (t < 1888) {
    t -= 1664; int ng = t / 14, kg = t % 14;
    const float* src;
    if (kg < 6) src = p.wbra + (size_t)l * 384 * 1024 + (size_t)(kg * 64) * 1024;
    else if (kg < 10) src = p.wbrb + (size_t)l * 256 * 1024 + (size_t)((kg - 6) * 64) * 1024;
    else src = p.wbrc + (size_t)l * 256 * 1024 + (size_t)((kg - 10) * 64) * 1024;
    d.nvalid = 64; d.src = src + ng * 64; d.ld = 1024;
    d.dst = p.Wbr + (size_t)l * 1024 * 896 + (size_t)(ng * 64) * 896 + kg * 64; d.dld = 896;
  } else if (t < 2144) {
    t -= 1888; int ng = t >> 4, kg = t & 15;
    d.nvalid = 64; d.src = p.wout + (size_t)l * 1024 * 1024 + (size_t)(kg * 64) * 1024 + ng * 64; d.ld = 1024;
    d.dst = p.Wout + (size_t)l * 1024 * 1024 + (size_t)(ng * 64) * 1024 + kg * 64; d.dld = 1024;
  } else if (t < 2272) {
    t -= 2144; int kv = t >> 6; t &= 63; int ng = t >> 5, kg = t & 31;
    const float* w = kv ? p.cvw1 : p.ckw1;
    d.nvalid = 64; d.src = w + (size_t)l * 2048 * 128 + (size_t)(kg * 64) * 128 + ng * 64; d.ld = 128;
    d.dst = p.W1t + ((size_t)(l * 2 + kv) * 128 + ng * 64) * 2048 + kg * 64; d.dld = 2048;
  } else {
    t -= 2272; int kv = t >> 1, kg = t & 1;
    const float* w = kv ? p.cvw2 : p.ckw2;
    d.nvalid = 64; d.src = w + (size_t)l * 128 * 64 + (size_t)(kg * 64) * 64; d.ld = 64;
    d.dst = p.W2t + ((size_t)(l * 2 + kv) * 64) * 128 + kg * 64; d.dld = 128;
  }
  return d;
}

DI void prep_weights(const Params& p_in, float* sm) {
  const Params p = launder(p_in);
  constexpr int TL = 2276;
  for (int idx = blockIdx.x; idx < 2 * TL; idx += 2 * gridDim.x) {
    const int idx2 = idx + gridDim.x;
    const bool hasb = idx2 < 2 * TL;
    const TDesc a = tile_desc(p, idx);
    const TDesc b = tile_desc(p, hasb ? idx2 : idx);
    tconv_pair(a, b, hasb, sm);
  }
}

DI void prep_misc(const Params& p_in) {
  const Params p = launder(p_in);
  const int gtid = blockIdx.x * 256 + tid_(), gsz = gridDim.x * 256;
  for (int i = gtid; i < 32768 * 8; i += gsz) {
    int tok = i >> 3, d = i & 7;
    float a = (float)p.pos[tok] * c_freq[d];
    double rev = (double)a * 0.15915494309189535;
    rev -= floor(rev);
    float fr = (float)rev;
    p.rope[tok * 16 + d] = __builtin_amdgcn_cosf(fr);
    p.rope[tok * 16 + 8 + d] = __builtin_amdgcn_sinf(fr);
  }
  {
    const int lane = tid_() & 63;
    const int gw = blockIdx.x * 4 + (tid_() >> 6);
    if (gw < 512) {
      const int l = gw >> 8, kv = (gw >> 7) & 1, n = gw & 127;
      const float* w = (kv ? p.cvw1 : p.ckw1) + (size_t)l * 2048 * 128 + n;
      const float* cp = p.cmp_pos + l * 2048;
      float s = 0.f;
#pragma unroll 8
      for (int i = 0; i < 32; ++i) { const int k = lane + 64 * i; s += cp[k] * w[(size_t)k * 128]; }
#pragma unroll
      for (int o = 32; o >= 1; o >>= 1) s += __shfl_xor(s, o);
      if (lane == 0) p.bias1[gw] = s;
    }
  }
}

DI void rmsnorm_rows(const float* __restrict__ xin, const float* __restrict__ g, u16* __restrict__ xb) {
  const int lane = tid_() & 63, wid = tid_() >> 6;
  for (int row = (blockIdx.x * 4 + wid) * 2; row < 32768; row += gridDim.x * 8) {
    const float4* xr0 = (const float4*)(xin + (size_t)row * 1024);
    const float4* xr1 = xr0 + 256;
    float4 v0[4], v1[4];
#pragma unroll
    for (int i = 0; i < 4; ++i) { v0[i] = xr0[lane + i * 64]; v1[i] = xr1[lane + i * 64]; }
    float s0 = 0.f, s1 = 0.f;
#pragma unroll
    for (int i = 0; i < 4; ++i) {
      s0 += v0[i].x * v0[i].x + v0[i].y * v0[i].y + v0[i].z * v0[i].z + v0[i].w * v0[i].w;
      s1 += v1[i].x * v1[i].x + v1[i].y * v1[i].y + v1[i].z * v1[i].z + v1[i].w * v1[i].w;
    }
#pragma unroll
    for (int o = 32; o >= 1; o >>= 1) { s0 += __shfl_xor(s0, o); s1 += __shfl_xor(s1, o); }
    const float r0 = rsqrtf(s0 * (1.f / 1024.f) + 1e-6f), r1 = rsqrtf(s1 * (1.f / 1024.f) + 1e-6f);
#pragma unroll
    for (int i = 0; i < 4; ++i) {
      const float4 gg = ((const float4*)g)[lane + i * 64];
      uint2 o; o.x = pack2(v0[i].x * r0 * gg.x, v0[i].y * r0 * gg.y); o.y = pack2(v0[i].z * r0 * gg.z, v0[i].w * r0 * gg.w);
      *(uint2*)(xb + (size_t)row * 1024 + (lane + i * 64) * 4) = o;
      uint2 q; q.x = pack2(v1[i].x * r1 * gg.x, v1[i].y * r1 * gg.y); q.y = pack2(v1[i].z * r1 * gg.z, v1[i].w * r1 * gg.w);
      *(uint2*)(xb + (size_t)(row + 1) * 1024 + (lane + i * 64) * 4) = q;
    }
  }
}

#define WAITVL(n) asm volatile("s_waitcnt vmcnt(" #n ") lgkmcnt(0)" ::: "memory")
template <int MT, int NT, int NS, bool SWAP>
DI void gemm_loop(const u16* __restrict__ A, int lda, const u16* __restrict__ Bt, int ldb, int K,
                  f32x16 (&acc)[MT][NT], u16* sm16) {
  constexpr int BN = 64 * NT, BM = 64 * MT;
  constexpr int A_BYTES = BM * 64, B_BYTES = BN * 64, STAGE = A_BYTES + B_BYTES;
  constexpr int NLD = MT + NT;
  char* sm = (char*)sm16;
  const int tid = tid_(), lane = tid & 63, wid = tid >> 6, wm = wid >> 1, wn = wid & 1;
  const int lr = lane & 31, lh = lane >> 5;
  const int row0 = tid >> 2, kc0 = ((tid & 3) ^ ((row0 >> 2) & 3)) * 8;
  const u16* ag = A + (size_t)row0 * lda + kc0;
  const u16* bg = Bt + (size_t)row0 * ldb + kc0;
  const size_t a64 = (size_t)64 * lda, b64 = (size_t)64 * ldb;
  const int nk = K >> 5;
  auto issue = [&](int kt) {
    char* d = sm + (kt % NS) * STAGE + tid * 16;
    const int ko = kt * 32;
#pragma unroll
    for (int i = 0; i < MT; ++i)
      __builtin_amdgcn_global_load_lds((const unsigned*)(ag + i * a64 + ko), (unsigned*)(d + i * 4096), 16, 0, 0);
#pragma unroll
    for (int i = 0; i < NT; ++i)
      __builtin_amdgcn_global_load_lds((const unsigned*)(bg + i * b64 + ko), (unsigned*)(d + A_BYTES + i * 4096), 16, 0, 0);
  };
  auto wait_bar = [&](int after) {
    if (NLD == 4) { if (after >= 2) WAITVL(8); else if (after == 1) WAITVL(4); else WAITVL(0); }
    else if (NLD == 3) { if (after >= 2) WAITVL(6); else if (after == 1) WAITVL(3); else WAITVL(0); }
    else { if (after >= 2) WAITVL(12); else if (after == 1) WAITVL(6); else WAITVL(0); }
    __builtin_amdgcn_s_barrier();
    asm volatile("" ::: "memory");
  };
  const int sw = (lr >> 2) & 3;
  const int aoff = (wm * 32 * MT + lr) * 64, boff = A_BYTES + (wn * 32 * NT + lr) * 64;
  const int c0 = ((0 + lh) ^ sw) * 16, c1 = ((2 + lh) ^ sw) * 16;
  auto ldk = [&](int kt, int ks, bf16x8 (&af)[MT], bf16x8 (&bfv)[NT]) {
    const char* sb = sm + (kt % NS) * STAGE + (ks ? c1 : c0);
#pragma unroll
    for (int mi = 0; mi < MT; ++mi) af[mi] = *(const bf16x8*)(sb + aoff + mi * 2048);
#pragma unroll
    for (int ni = 0; ni < NT; ++ni) bfv[ni] = *(const bf16x8*)(sb + boff + ni * 2048);
  };
  auto mmak = [&](const bf16x8 (&af)[MT], const bf16x8 (&bfv)[NT]) {
#pragma unroll
    for (int mi = 0; mi < MT; ++mi)
#pragma unroll
      for (int ni = 0; ni < NT; ++ni)
        acc[mi][ni] = SWAP ? mfma32(bfv[ni], af[mi], acc[mi][ni]) : mfma32(af[mi], bfv[ni], acc[mi][ni]);
  };
  __syncthreads();
#pragma unroll
  for (int i = 0; i < NS - 1; ++i) if (i < nk) issue(i);
  { const int after = nk - 1 < NS - 2 ? nk - 1 : NS - 2; wait_bar(after); }
  if (nk > NS - 1) issue(NS - 1);
  bf16x8 fa_a[MT], fa_b[NT], fb_a[MT], fb_b[NT];
  ldk(0, 0, fa_a, fa_b);
  for (int kt = 0; kt < nk; ++kt) {
    ldk(kt, 1, fb_a, fb_b);
    mmak(fa_a, fa_b);
    if (kt + 1 < nk) {
      { const int r = nk - 2 - kt; wait_bar(r < NS - 2 ? r : NS - 2); }
      if (kt + NS < nk) issue(kt + NS);
      ldk(kt + 1, 0, fa_a, fa_b);
    }
    mmak(fb_a, fb_b);
  }
}

struct BlkMap { int x, j, per; };
DI bool tile_map(const BlkMap bm, int k, int MTL, int NTL, int& mt, int& nt) {
  const int x = bm.x, j = bm.j, per = bm.per;
  const int u = j + per * k;
  if (u >= (MTL >> 3) * NTL) return false;
  const int q = u / (8 * NTL), rem = u - q * (8 * NTL);
  nt = rem >> 3; mt = (x + 8 * q) * 8 + (rem & 7);
  return true;
}


template <int MT>
DI void tile_store_bf16(const f32x16 (&acc)[MT][2], u16* __restrict__ dst  , int ld, char* sm) {
  const int tid = tid_(), lane = tid & 63, wid = tid >> 6, wm = wid >> 1, wn = wid & 1;
  const int lr = lane & 31, lh = lane >> 5;
  __syncthreads();
#pragma unroll
  for (int mi = 0; mi < MT; ++mi) {
    char* rowp = sm + (wm * 32 * MT + mi * 32 + lr) * 272 + (wn * 64 + 4 * lh) * 2;
#pragma unroll
    for (int ni = 0; ni < 2; ++ni)
#pragma unroll
      for (int i = 0; i < 4; ++i) {
        uint2 o; o.x = pack2(acc[mi][ni][i * 4 + 0], acc[mi][ni][i * 4 + 1]);
        o.y = pack2(acc[mi][ni][i * 4 + 2], acc[mi][ni][i * 4 + 3]);
        *(uint2*)(rowp + (ni * 32 + 8 * i) * 2) = o;
      }
  }
  __syncthreads();
  const int c = tid & 15, r0 = tid >> 4;
#pragma unroll
  for (int j = 0; j < 4 * MT; ++j) {
    const int row = r0 + 16 * j;
    typedef __attribute__((ext_vector_type(4))) unsigned u32x4s;
    const u32x4s v = *(const u32x4s*)(sm + row * 272 + c * 16);
    __builtin_nontemporal_store(v, (u32x4s*)(dst + (size_t)row * ld + c * 8));
  }
}

DI void phase_inproj(const Params& p_in, const BlkMap bm, int l, u16* sm) {
  const Params p = launder(p_in);
  const int tid = tid_(), lane = tid & 63, wid = tid >> 6, wm = wid >> 1, wn = wid & 1;
  const int lr = lane & 31, lh = lane >> 5;
  const u16* Wt = p.Wt1 + (size_t)l * NP * 1024;
  for (int k = 0;; ++k) {
    int mt, nt;
    if (!tile_map(bm, k, 128, 28, mt, nt)) break;
    const int m0 = mt * 256, n0 = nt * 128;
    f32x16 acc[4][2];
#pragma unroll
    for (int a = 0; a < 4; ++a)
#pragma unroll
      for (int b = 0; b < 2; ++b) acc[a][b] = zero16();
    gemm_loop<4, 2, 3, true>(p.xb + (size_t)m0 * 1024, 1024, Wt + (size_t)n0 * 1024, 1024, 1024, acc, sm);
    const int cg_ = (n0 + wn * 64) >> 6;
    const float* gain = p.qna; bool has = true, isq = false;
    if (cg_ < 6) { gain = p.qna; isq = true; }
    else if (cg_ < 12) gain = p.kna;
    else if (cg_ >= 24 && cg_ < 28) { gain = p.qnb; isq = true; }
    else if (cg_ == 28 || cg_ == 30 || cg_ == 32) gain = p.knb;
    else if (cg_ >= 38 && cg_ < 42) { gain = p.qnc; isq = true; }
    else if (cg_ >= 42 && cg_ < 46) gain = p.knc;
    else has = false;
    if (has) {
      gain += l * 64;
      float4 g4[2][4], c4[4], s4[4];
#pragma unroll
      for (int ni = 0; ni < 2; ++ni)
#pragma unroll
        for (int i = 0; i < 4; ++i) g4[ni][i] = *(const float4*)(gain + ni * 32 + 4 * lh + 8 * i);
#pragma unroll
      for (int mi = 0; mi < 4; ++mi) {
        const int token = m0 + wm * 128 + mi * 32 + lr;
        c4[mi] = *(const float4*)(p.rope + (size_t)token * 16 + 4 * lh);
        s4[mi] = *(const float4*)(p.rope + (size_t)token * 16 + 8 + 4 * lh);
      }
      const float qs = isq ? 0.18033688011112042f : 1.f;
#pragma unroll
      for (int mi = 0; mi < 4; ++mi) {
        float ss = 0.f;
#pragma unroll
        for (int ni = 0; ni < 2; ++ni)
#pragma unroll
          for (int r = 0; r < 16; ++r) ss += acc[mi][ni][r] * acc[mi][ni][r];
        ss = xor32_sum(ss);
        const float rs = rsqrtf(ss * (1.f / 64.f) + 1e-6f);
#pragma unroll
        for (int ni = 0; ni < 2; ++ni)
#pragma unroll
          for (int i = 0; i < 4; ++i) {
            acc[mi][ni][i * 4 + 0] *= rs * g4[ni][i].x; acc[mi][ni][i * 4 + 1] *= rs * g4[ni][i].y;
            acc[mi][ni][i * 4 + 2] *= rs * g4[ni][i].z; acc[mi][ni][i * 4 + 3] *= rs * g4[ni][i].w;
          }
        const float cc[4] = {c4[mi].x, c4[mi].y, c4[mi].z, c4[mi].w}, sn[4] = {s4[mi].x, s4[mi].y, s4[mi].z, s4[mi].w};
#pragma unroll
        for (int j = 0; j < 4; ++j) {
          const float x1 = acc[mi][0][j], x2 = acc[mi][0][4 + j];
          acc[mi][0][j] = x1 * cc[j] - x2 * sn[j];
          acc[mi][0][4 + j] = x2 * cc[j] + x1 * sn[j];
        }
        if (isq) {
#pragma unroll
          for (int ni = 0; ni < 2; ++ni)
#pragma unroll
            for (int r = 0; r < 16; ++r) acc[mi][ni][r] *= qs;
        }
      }
    }
    tile_store_bf16<4>(acc, p.proj + (size_t)m0 * NP + n0, NP, (char*)sm);
  }
}

DI void compress_item(const Params& p, int l, int kv, int rt, char* smraw) {
  const int tid = tid_(), lane = tid & 63, w = tid >> 6, lr = lane & 31, lh = lane >> 5;
  const u16* W1 = p.W1t + (size_t)((l * 2 + kv) * 128 + w * 32 + lr) * 2048 + lh * 8;
  const int col = kv ? C_VCB : C_KCB;
  const int R = rt * 32 + lr;
  f32x16 H = zero16();
#pragma unroll 1
  for (int ks0 = 0; ks0 < 128; ks0 += 8) {
    bf16x8 af[8], wf[8];
#pragma unroll
    for (int u = 0; u < 8; ++u) {
      const int ks = ks0 + u, tt = ks >> 2, d = (ks & 3) * 16 + lh * 8;
      int tokrow = R * 16 + tt; tokrow = tokrow > 32767 ? 32767 : tokrow;
      af[u] = *(const bf16x8*)(p.proj + (size_t)tokrow * NP + col + d);
      wf[u] = *(const bf16x8*)(W1 + ks * 16);
    }
#pragma unroll
    for (int u = 0; u < 8; ++u) H = mfma32(wf[u], af[u], H);
  }
  {
    const float* b1 = p.bias1 + (l * 2 + kv) * 128 + w * 32 + 4 * lh;
    unsigned hw[8];
    float4 bb4[4];
#pragma unroll
    for (int i = 0; i < 4; ++i) bb4[i] = *(const float4*)(b1 + 8 * i);
#pragma unroll
    for (int i = 0; i < 4; ++i) {
      const float4 bb = bb4[i];
      hw[i * 2] = pack2(siluf_(H[i * 4] + bb.x), siluf_(H[i * 4 + 1] + bb.y));
      hw[i * 2 + 1] = pack2(siluf_(H[i * 4 + 2] + bb.z), siluf_(H[i * 4 + 3] + bb.w));
    }
    uint4* hs = (uint4*)smraw;
    hs[(w * 2 + 0) * 64 + lane] = make_uint4(hw[0], hw[1], hw[2], hw[3]);
    hs[(w * 2 + 1) * 64 + lane] = make_uint4(hw[4], hw[5], hw[6], hw[7]);
  }
  __syncthreads();
  if (w < 2) {
    const int dt = w;
    const u16* W2 = p.W2t + (size_t)((l * 2 + kv) * 64 + dt * 32 + lr) * 128 + 4 * lh;
    const uint4* hs = (const uint4*)smraw;
    f32x16 o2 = zero16();
    uint2 wlo[8], whi[8];
#pragma unroll
    for (int ht = 0; ht < 4; ++ht)
#pragma unroll
      for (int s = 0; s < 2; ++s) {
        const u16* wp = W2 + ht * 32 + 16 * s;
        wlo[ht * 2 + s] = *(const uint2*)wp; whi[ht * 2 + s] = *(const uint2*)(wp + 8);
      }
#pragma unroll
    for (int ht = 0; ht < 4; ++ht)
#pragma unroll
      for (int s = 0; s < 2; ++s) {
        const uint2 lo = wlo[ht * 2 + s], hi = whi[ht * 2 + s];
        union { uint4 u; bf16x8 v; } cw, ch; cw.u = make_uint4(lo.x, lo.y, hi.x, hi.y);
        ch.u = hs[(ht * 2 + s) * 64 + lane];
        o2 = kv ? mfma32(ch.v, cw.v, o2) : mfma32(cw.v, ch.v, o2);
      }
    if (kv == 0) {
#pragma unroll
      for (int i = 0; i < 4; ++i) {
        uint2 o; o.x = pack2(o2[i * 4], o2[i * 4 + 1]); o.y = pack2(o2[i * 4 + 2], o2[i * 4 + 3]);
        *(uint2*)(p.kc + (size_t)R * 64 + dt * 32 + 4 * lh + 8 * i) = o;
      }
    } else {
      uint4 a, b;
      a.x = pack2(o2[0], o2[1]); a.y = pack2(o2[2], o2[3]); a.z = pack2(o2[4], o2[5]); a.w = pack2(o2[6], o2[7]);
      b.x = pack2(o2[8], o2[9]); b.y = pack2(o2[10], o2[11]); b.z = pack2(o2[12], o2[13]); b.w = pack2(o2[14], o2[15]);
      u16* dst = p.vcF + (size_t)(rt * 2 + dt) * 1024 + lane * 16;
      *(uint4*)dst = a; *(uint4*)(dst + 8) = b;
    }
  }
  __syncthreads();
}

DI void relayout_decode(const Params& p, int idx, int lr, u16*& dstbase, int& col, int& tokbase, int& tstride) {
  if (idx < 36864) {
    const int which = idx / 12288, id = idx % 12288;
    const int dt = id & 1, bh = id >> 8, b = bh / 6, h = bh % 6;
    col = C_VA + h * 64 + dt * 32 + lr;
    if (which == 0) { const int kt = (id >> 1) & 127; tokbase = b * 4096 + kt * 32; tstride = 1; dstbase = p.VA1; }
    else if (which == 1) { const int lt = (id >> 1) & 31, r4 = (id >> 6) & 3; tokbase = b * 4096 + lt * 128 + r4; tstride = 4; dstbase = p.VA4; }
    else { const int lt = (id >> 1) & 7, r = (id >> 4) & 15; tokbase = b * 4096 + lt * 512 + r; tstride = 16; dstbase = p.VA16; }
    dstbase += (size_t)id * 1024;
  } else if (idx < 40960) {
    const int which = (idx - 36864) >> 11, id = (idx - 36864) & 2047;
    const int dt = id & 1, kt = (id >> 1) & 127, b = id >> 8;
    col = (which ? C_VWB : C_VSB) + dt * 32 + lr; tokbase = b * 4096 + kt * 32; tstride = 1;
    dstbase = (which ? p.VW : p.VS) + (size_t)id * 1024;
  } else {
    const int id = idx - 40960;
    const int dt = id & 1, kt = (id >> 1) & 127, bh = id >> 8, b = bh >> 2, h = bh & 3;
    col = C_VC + h * 64 + dt * 32 + lr; tokbase = b * 4096 + kt * 32; tstride = 1;
    dstbase = p.VC + (size_t)id * 1024;
  }
}
DI void relayout4(const Params& p, int idx0) {
  const int lane = tid_() & 63, lr = lane & 31, lh = lane >> 5;
  u16* dst[4]; unsigned w[4][8];
#pragma unroll
  for (int t = 0; t < 4; ++t) {
    int col, tokbase, tstride;
    relayout_decode(p, idx0 + t, lr, dst[t], col, tokbase, tstride);
#pragma unroll
    for (int i = 0; i < 4; ++i)
#pragma unroll
      for (int jp = 0; jp < 2; ++jp) {
        const int kk = 4 * lh + 8 * i + 2 * jp;
        const unsigned oa = (unsigned)((tokbase + kk * tstride) * NP + col), ob = (unsigned)((tokbase + (kk + 1) * tstride) * NP + col);
        const u16 a = p.proj[oa];
        const u16 b = p.proj[ob];
        w[t][i * 2 + jp] = (unsigned)a | ((unsigned)b << 16);
      }
  }
#pragma unroll
  for (int t = 0; t < 4; ++t) {
    u16* d = dst[t] + lane * 16;
    *(uint4*)d = make_uint4(w[t][0], w[t][1], w[t][2], w[t][3]);
    *(uint4*)(d + 8) = make_uint4(w[t][4], w[t][5], w[t][6], w[t][7]);
  }
}

DI void kmean_item(const Params& p, int idx) {
  const int lane = tid_() & 63;
  const int blk = idx & 15, bh = idx >> 4, b = bh >> 2, h = bh & 3;
  const unsigned o0 = (unsigned)((b * 4096 + blk * 256) * NP + C_KC + h * 64 + lane);
  float s0 = 0.f, s1 = 0.f, s2 = 0.f, s3 = 0.f;
#pragma unroll 1
  for (int i = 0; i < 256; i += 16) {
    u16 v[16];
#pragma unroll
    for (int u = 0; u < 16; ++u) v[u] = p.proj[o0 + (unsigned)((i + u) * NP)];
#pragma unroll
    for (int u = 0; u < 16; u += 4) { s0 += bf2f(v[u]); s1 += bf2f(v[u + 1]); s2 += bf2f(v[u + 2]); s3 += bf2f(v[u + 3]); }
  }
  p.kmean[(size_t)idx * 64 + lane] = f2bf(((s0 + s1) + (s2 + s3)) * (1.f / 256.f));
}

DI void phase_mid(const Params& p_in, int l, char* smraw) {
  const Params p = launder(p_in);
  const int wid = tid_() >> 6;
  constexpr int N_CMP = 128, N_KM = 128, N_REL = 3072;
  for (int it = blockIdx.x; it < N_CMP + N_KM + N_REL; it += gridDim.x) {
    if (it < N_CMP) compress_item(p, l, it >> 6, it & 63, smraw);
    else if (it < N_CMP + N_KM) kmean_item(p, (it - N_CMP) * 4 + wid);
    else relayout4(p, (it - N_CMP - N_KM) * 16 + wid * 4);
  }
}

DI void attn_loadk(const u16* __restrict__ kp, bf16x8 (&kf)[4]) {
#pragma unroll
  for (int ks = 0; ks < 4; ++ks) kf[ks] = *(const bf16x8*)(kp + ks * 16);
}

typedef __attribute__((ext_vector_type(2))) float f32x2;
DI float fmax_nc(float a, float b) { return __builtin_amdgcn_fmed3f(a, b, __builtin_inff()); }
DI void attn_core(const bf16x8 (&qf)[4], const bf16x8 (&kf)[4], const bf16x8 (&vf)[2][2], const int lo, const int hi,
                   float& m, float& l, f32x16 (&O)[2], const int lh) {
  f32x16 sc = zero16();
#pragma unroll
  for (int ks = 0; ks < 4; ++ks) sc = mfma32(kf[ks], qf[ks], sc);
  const bool empty = hi < lo;
  const bool partial = !empty && (lo > 0 || hi < 31);
  if (__builtin_amdgcn_ballot_w64(partial) != 0ull) {
    const unsigned span = (unsigned)(hi - lo);
    const int base = 4 * lh - lo;
#pragma unroll
    for (int r = 0; r < 16; ++r) {
      const unsigned rel = (unsigned)(base + 8 * (r >> 2) + (r & 3));
      sc[r] = (rel <= span) ? sc[r] : -1e30f;
    }
  }
  float mx = fmax_nc(fmax_nc(fmax_nc(sc[0], sc[1]), fmax_nc(sc[2], sc[3])), fmax_nc(fmax_nc(sc[4], sc[5]), fmax_nc(sc[6], sc[7])));
  mx = fmax_nc(mx, fmax_nc(fmax_nc(fmax_nc(sc[8], sc[9]), fmax_nc(sc[10], sc[11])), fmax_nc(fmax_nc(sc[12], sc[13]), fmax_nc(sc[14], sc[15]))));
  mx = empty ? -1e30f : mx;
  mx = xor32_max(mx);
  if (__builtin_amdgcn_ballot_w64(mx > m + 16.f) != 0ull) {
    const float mn = (mx > m + 16.f) ? mx : m;
    const float alpha = __builtin_amdgcn_exp2f(m - mn);
    l *= alpha; m = mn;
#pragma unroll
    for (int dt = 0; dt < 2; ++dt)
#pragma unroll
      for (int r = 0; r < 16; ++r) O[dt][r] *= alpha;
  }
  const float meff = empty ? 3e38f : m;
  const f32x2 m2 = {meff, meff};
  f32x2 ps2 = {0.f, 0.f}; float pv[16];
#pragma unroll
  for (int r = 0; r < 16; r += 2) {
    const f32x2 s2 = {sc[r], sc[r + 1]};
    const f32x2 d2 = s2 - m2;
    const f32x2 e2 = {__builtin_amdgcn_exp2f(d2.x), __builtin_amdgcn_exp2f(d2.y)};
    pv[r] = e2.x; pv[r + 1] = e2.y; ps2 += e2;
  }
  const float ps = xor32_sum(ps2.x + ps2.y);
  l += ps;
  bf16x8 pb[2];
#pragma unroll
  for (int s = 0; s < 2; ++s)
#pragma unroll
    for (int j = 0; j < 8; ++j) pb[s][j] = (short)f2bf(pv[8 * s + j]);
#pragma unroll
  for (int dt = 0; dt < 2; ++dt)
#pragma unroll
    for (int s = 0; s < 2; ++s) O[dt] = mfma32(vf[dt][s], pb[s], O[dt]);
}

DI void attn_compute(const bf16x8 (&qf)[4], const bf16x8 (&kf)[4], const u16* __restrict__ vp, const int lo, const int hi,
                     float& m, float& l, f32x16 (&O)[2], const int lh) {
  bf16x8 vf[2][2];
#pragma unroll
  for (int dt = 0; dt < 2; ++dt)
#pragma unroll
    for (int s = 0; s < 2; ++s) vf[dt][s] = *(const bf16x8*)(vp + dt * 1024 + s * 8);
  attn_core(qf, kf, vf, lo, hi, m, l, O, lh);
}

template <class NF, class DF, class BF>
DI void attn_run_shared(const bf16x8 (&qf)[4], NF next, DF desc, BF band, float& m, float& l, f32x16 (&O)[2], char* lds) {
  const int tid = tid_(), lane = tid & 63, lr = lane & 31, lh = lane >> 5;
  int cur = next(-1);
  if (cur < 0) return;
  const int krow = tid >> 3, kc = tid & 7;
  const int kdst = krow * 128 + ((kc ^ ((krow >> 1) & 7)) * 16);
  const int vdst = 4096 + ((((tid >> 7) * 2 + (tid & 1)) * 64 + ((tid >> 1) & 63)) * 16);
  const int ksw = (lr >> 1) & 7;
  uint4 kreg, vreg;
  {
    const u16 *kb, *vt; int kst; desc(cur, kb, kst, vt);
    kreg = *(const uint4*)(kb + (size_t)krow * kst + kc * 8);
    vreg = *(const uint4*)(vt + tid * 8);
  }
  int st = 0;
#pragma unroll 1
  while (true) {
    char* buf = lds + st * 8192;
    *(uint4*)(buf + kdst) = kreg;
    *(uint4*)(buf + vdst) = vreg;
    __syncthreads();
    const int nx = next(cur);
    {
      const u16 *kb, *vt; int kst; desc(nx >= 0 ? nx : cur, kb, kst, vt);
      kreg = *(const uint4*)(kb + (size_t)krow * kst + kc * 8);
      vreg = *(const uint4*)(vt + tid * 8);
    }
    bf16x8 kf[4], vf[2][2];
#pragma unroll
    for (int ks = 0; ks < 4; ++ks) kf[ks] = *(const bf16x8*)(buf + lr * 128 + (((ks * 2 + lh) ^ ksw) * 16));
#pragma unroll
    for (int dt = 0; dt < 2; ++dt)
#pragma unroll
      for (int s2 = 0; s2 < 2; ++s2) vf[dt][s2] = *(const bf16x8*)(buf + 4096 + ((dt * 2 + s2) * 64 + lane) * 16);
    { int lo, hi; band(cur, lo, hi); attn_core(qf, kf, vf, lo, hi, m, l, O, lh); }
    if (nx < 0) break;
    st ^= 1; cur = nx;
  }
  __syncthreads();
}

DI void attn_loadv(const u16* __restrict__ vp, bf16x8 (&vf)[2][2]) {
#pragma unroll
  for (int dt = 0; dt < 2; ++dt)
#pragma unroll
    for (int s = 0; s < 2; ++s) vf[dt][s] = *(const bf16x8*)(vp + dt * 1024 + s * 8);
}
template <class NF, class DF, class BF>
DI void attn_run(const bf16x8 (&qf)[4], NF next, DF desc, BF band, float& m, float& l, f32x16 (&O)[2], const int lh) {
  int cur = next(-1);
  if (cur < 0) return;
  bf16x8 ka[4], kb[4], va[2][2], vb[2][2];
  { const u16 *kp, *vp; desc(cur, kp, vp); attn_loadk(kp, ka); attn_loadv(vp, va); }
#pragma unroll 1
  while (true) {
    const int nx = next(cur);
    { const u16 *kp, *vp; desc(nx >= 0 ? nx : cur, kp, vp); attn_loadk(kp, kb); attn_loadv(vp, vb); }
    { int lo, hi; band(cur, lo, hi); attn_core(qf, ka, va, lo, hi, m, l, O, lh); }
    if (nx < 0) break;
    const int nn = next(nx);
    { const u16 *kp, *vp; desc(nn >= 0 ? nn : nx, kp, vp); attn_loadk(kp, ka); attn_loadv(vp, va); }
    { int lo, hi; band(nx, lo, hi); attn_core(qf, kb, vb, lo, hi, m, l, O, lh); }
    if (nn < 0) break;
    cur = nn;
  }
}

template <class NF, class BF>
DI void attn_run_shared2(const bf16x8 (&qf)[4], NF next, const u16* __restrict__ kbase, const u16* __restrict__ vbase,
                         const int ntile_max, BF band2, float& m, float& l, f32x16 (&O)[2], char* lds) {
  const int tid = tid_(), lane = tid & 63, lr = lane & 31, lh = lane >> 5;
  int cur = next(-1);
  if (cur < 0) return;
  const int krow = tid >> 3, kc = tid & 7;
  const int kdst = krow * 128 + ((kc ^ ((krow >> 1) & 7)) * 16);
  const int vdst = 4096 + ((((tid >> 7) * 2 + (tid & 1)) * 64 + ((tid >> 1) & 63)) * 16);
  const int ksw = (lr >> 1) & 7;
  uint4 k0, k1, v0, v1;
  auto fetch = [&](int J) {
    const u16* kp = kbase + ((size_t)(64 * J + krow)) * NP + kc * 8;
    k0 = *(const uint4*)kp; k1 = *(const uint4*)(kp + (size_t)32 * NP);
    const u16* vp = vbase + (size_t)(2 * J) * 2048 + tid * 8;
    v0 = *(const uint4*)vp; v1 = *(const uint4*)(vp + 2048);
  };
  fetch(cur);
  int st = 0;
#pragma unroll 1
  while (true) {
    char* buf = lds + st * 16384;
    *(uint4*)(buf + kdst) = k0; *(uint4*)(buf + vdst) = v0;
    *(uint4*)(buf + 8192 + kdst) = k1; *(uint4*)(buf + 8192 + vdst) = v1;
    __syncthreads();
    const int nx = next(cur);
    fetch(nx >= 0 ? nx : cur);
#pragma unroll 1
    for (int half = 0; half < 2; ++half) {
      if (2 * cur + half > ntile_max) break;
      const char* tb = buf + half * 8192;
      bf16x8 kf[4], vf[2][2];
#pragma unroll
      for (int ks = 0; ks < 4; ++ks) kf[ks] = *(const bf16x8*)(tb + lr * 128 + (((ks * 2 + lh) ^ ksw) * 16));
#pragma unroll
      for (int dt = 0; dt < 2; ++dt)
#pragma unroll
        for (int s2 = 0; s2 < 2; ++s2) vf[dt][s2] = *(const bf16x8*)(tb + 4096 + ((dt * 2 + s2) * 64 + lane) * 16);
      int lo, hi; band2(cur, half, lo, hi);
      attn_core(qf, kf, vf, lo, hi, m, l, O, lh);
    }
    if (nx < 0) break;
    st ^= 1; cur = nx;
  }
  __syncthreads();
}
#define M_INIT (-1e4f)
#define BIG 100000

DI void store_gated(const u16* zrow  , u16* orow  , const f32x16 (&O)[2]) {
  uint2 z[2][4];
#pragma unroll
  for (int dt = 0; dt < 2; ++dt)
#pragma unroll
    for (int i = 0; i < 4; ++i) z[dt][i] = *(const uint2*)(zrow + dt * 32 + 8 * i);
#pragma unroll
  for (int dt = 0; dt < 2; ++dt)
#pragma unroll
    for (int i = 0; i < 4; ++i) {
      const uint2 zz = z[dt][i];
      const float z0 = bf2f((u16)(zz.x & 0xffff)), z1 = bf2f((u16)(zz.x >> 16)), z2 = bf2f((u16)(zz.y & 0xffff)), z3 = bf2f((u16)(zz.y >> 16));
      uint2 o; o.x = pack2(O[dt][i * 4] * siluf_(z0), O[dt][i * 4 + 1] * siluf_(z1));
      o.y = pack2(O[dt][i * 4 + 2] * siluf_(z2), O[dt][i * 4 + 3] * siluf_(z3));
      *(uint2*)(orow + dt * 32 + 8 * i) = o;
    }
}

DI void mixA_far_item(const Params& p, int b, int h, int T0, int r) {
  const int lane = tid_() & 63, lr = lane & 31, lh = lane >> 5;
  const int tq = T0 + r + 16 * lr;
  const size_t rowq = (size_t)b * 4096 + tq;
  const u16* proj = p.proj;
  bf16x8 qf[4];
  {
    const u16* qp = proj + rowq * NP + C_QA + h * 64 + lh * 8;
#pragma unroll
    for (int ks = 0; ks < 4; ++ks) qf[ks] = *(const bf16x8*)(qp + ks * 16);
  }
  float m = M_INIT, l = 0.f; f32x16 O[2]; O[0] = zero16(); O[1] = zero16();
  const int kcol = C_KA + h * 64 + lh * 8;
  {
    const size_t bh = (size_t)(b * 6 + h);
    auto lbase_of = [&](int id) { return (T0 >> 4) - 128 + 32 * (4 - id); };
    auto next = [&](int prev) {
      int id = prev + 1;
      while (id < 5 && lbase_of(id) < 0) ++id;
      return id < 5 ? id : -1;
    };
    auto desc = [&](int id, const u16*& kp, const u16*& vp) {
      const int lbase = lbase_of(id);
      const int tk = (lbase + lr) * 16 + r;
      vp = p.VA16 + (((bh * 16 + r) * 8 + (size_t)(lbase >> 5)) * 2) * 1024 + lane * 16;
      kp = proj + ((size_t)b * 4096 + tk) * NP + kcol;
    };
    auto band = [&](int id, int& lo, int& hi) { hi = (T0 >> 4) + lr - lbase_of(id); lo = hi - 128; };
    attn_run(qf, next, desc, band, m, l, O, lh);
  }
  if (lh == 0) { float2 ml; ml.x = m; ml.y = l; *(float2*)(p.mlA + (rowq * 6 + h) * 2) = ml; }
  u16* orow = p.obuf + rowq * 896 + h * 64 + 4 * lh;
#pragma unroll
  for (int dt = 0; dt < 2; ++dt)
#pragma unroll
    for (int i = 0; i < 4; ++i) {
      uint2 o; o.x = pack2(O[dt][i * 4], O[dt][i * 4 + 1]); o.y = pack2(O[dt][i * 4 + 2], O[dt][i * 4 + 3]);
      *(uint2*)(orow + dt * 32 + 8 * i) = o;
    }
}

DI void mixA_item(const Params& p, int b, int h, int T0, int r4) {
  const int lane = tid_() & 63, lr = lane & 31, lh = lane >> 5;
  const int tq = T0 + r4 + 4 * lr;
  const size_t rowq = (size_t)b * 4096 + tq;
  const u16* proj = p.proj;
  bf16x8 qf[4];
  {
    const u16* qp = proj + rowq * NP + C_QA + h * 64 + lh * 8;
#pragma unroll
    for (int ks = 0; ks < 4; ++ks) qf[ks] = *(const bf16x8*)(qp + ks * 16);
  }
  float m, l; f32x16 O[2];
  {
    const float2 ml = *(const float2*)(p.mlA + (rowq * 6 + h) * 2);
    m = ml.x; l = ml.y;
    const u16* orow = p.obuf + rowq * 896 + h * 64 + 4 * lh;
#pragma unroll
    for (int dt = 0; dt < 2; ++dt)
#pragma unroll
      for (int i = 0; i < 4; ++i) {
        const uint2 o = *(const uint2*)(orow + dt * 32 + 8 * i);
        O[dt][i * 4] = bf2f((u16)(o.x & 0xffff)); O[dt][i * 4 + 1] = bf2f((u16)(o.x >> 16));
        O[dt][i * 4 + 2] = bf2f((u16)(o.y & 0xffff)); O[dt][i * 4 + 3] = bf2f((u16)(o.y >> 16));
      }
  }
  const int kcol = C_KA + h * 64 + lh * 8;
  {
    const size_t bh = (size_t)(b * 6 + h);
    auto lbase_of = [&](int id) { return id < 5 ? (T0 >> 2) - 128 + 32 * id : T0 - 128 + 32 * (id - 5); };
    auto next = [&](int prev) {
      int id = prev + 1;
      while (id < 13 && lbase_of(id) < 0) ++id;
      return id < 13 ? id : -1;
    };
    auto desc = [&](int id, const u16*& kp, const u16*& vp) {
      const int lbase = lbase_of(id);
      const size_t lt = (size_t)(lbase >> 5);
      int tk;
      if (id < 5) { tk = (lbase + lr) * 4 + r4; vp = p.VA4 + (((bh * 4 + r4) * 32 + lt) * 2) * 1024 + lane * 16; }
      else { tk = lbase + lr; vp = p.VA1 + ((bh * 128 + lt) * 2) * 1024 + lane * 16; }
      kp = proj + ((size_t)b * 4096 + tk) * NP + kcol;
    };
    auto band = [&](int id, int& lo, int& hi) {
      hi = (id < 5 ? (T0 >> 2) + lr : tq) - lbase_of(id);
      lo = hi - 128;
    };
    attn_run(qf, next, desc, band, m, l, O, lh);
  }
  const float inv = 1.f / l;
#pragma unroll
  for (int dt = 0; dt < 2; ++dt)
#pragma unroll
    for (int rr = 0; rr < 16; ++rr) O[dt][rr] *= inv;
  store_gated(p.proj + rowq * NP + C_ZA + h * 64 + 4 * lh, p.obuf + rowq * 896 + h * 64 + 4 * lh, O);
}

DI int moba_seg_col(int h, int k) {
  const int s = h * 3 + k;
  return s < 6 ? C_VA + 64 * s : (s < 10 ? C_VC + 64 * (s - 6) : (s == 10 ? C_VSB : C_VWB));
}

DI unsigned moba_select(const Params& p, const bf16x8 (&qf)[4], int b, int h, int bo, int lr, int lh) {
  const u16* kmp = p.kmean + ((size_t)(b * 4 + h) * 16 + (lr & 15)) * 64 + lh * 8;
  f32x16 s = zero16();
#pragma unroll
  for (int ks = 0; ks < 4; ++ks) s = mfma32(*(const bf16x8*)(kmp + ks * 16), qf[ks], s);
  float own[8], oth[8];
#pragma unroll
  for (int x = 0; x < 8; ++x) {
    const int n = 8 * (x >> 2) + 4 * lh + (x & 3);
    own[x] = n < bo ? s[x] : -1e30f;
  }
#pragma unroll
  for (int x = 0; x < 8; ++x) oth[x] = xor32_get(own[x], lh);
  unsigned mymask = 0;
#pragma unroll
  for (int x = 0; x < 8; ++x) {
    const int nx = 8 * (x >> 2) + 4 * lh + (x & 3);
    int rank = 0;
#pragma unroll
    for (int y = 0; y < 8; ++y) {
      const int ny = 8 * (y >> 2) + 4 * lh + (y & 3);
      const int no = 8 * (y >> 2) + 4 * (1 - lh) + (y & 3);
      if (y != x) rank += (own[y] > own[x]) || (own[y] == own[x] && ny < nx);
      rank += (oth[y] > own[x]) || (oth[y] == own[x] && no < nx);
    }
    if (rank < 3 && nx < bo) mymask |= 1u << nx;
  }
  mymask = xor32_or(mymask);
  return mymask;
}

DI void moba_mask_item(const Params& p, int b, int h, int qt) {
  const int lane = tid_() & 63, lr = lane & 31, lh = lane >> 5;
  const int bo = qt >> 3;
  unsigned mask = 0;
  if (bo > 0) {
    bf16x8 qf[4];
    const u16* qp = p.proj + ((size_t)b * 4096 + qt * 32 + lr) * NP + C_QC + h * 64 + lh * 8;
#pragma unroll
    for (int ks = 0; ks < 4; ++ks) qf[ks] = *(const bf16x8*)(qp + ks * 16);
    mask = moba_select(p, qf, b, h, bo, lr, lh);
  }
  if (lh == 0) p.selm16[(size_t)(b * 4 + h) * 4096 + qt * 32 + lr] = (u16)mask;
}

DI void moba_list_item(const Params& p, int b, int h, int n) {
  const int lane = tid_() & 63;
  const u16* selm = p.selm16 + (size_t)(b * 4 + h) * 4096;
  u16* lst = p.mlist + ((size_t)(b * 4 + h) * 16 + n) * 4096;
  int base = 0;
#pragma unroll 1
  for (int t0 = 256 * (n + 1); t0 < 4096; t0 += 512) {
    unsigned mk[8];
#pragma unroll
    for (int i = 0; i < 8; ++i) { const int t = t0 + 64 * i + lane; mk[i] = t < 4096 ? (unsigned)selm[t] : 0u; }
#pragma unroll
    for (int i = 0; i < 8; ++i) {
      const bool f = (mk[i] >> n) & 1u;
      const unsigned long long bal = __ballot(f);
      const int pos = base + __popcll(bal & ((1ull << lane) - 1ull));
      if (f) lst[pos] = (u16)(t0 + 64 * i + lane);
      base += __popcll(bal);
    }
  }
  if (lane == 0) p.mcnt[(b * 4 + h) * 16 + n] = base;
}

DI int moba_part_token(const Params& p, int bh, int n, int c, int cntn) {
  const int lr = tid_() & 31;
  const u16* lst = p.mlist + ((size_t)bh * 16 + n) * 4096;
  const int idx = c * 32 + lr;
  return (int)lst[idx < cntn ? idx : cntn - 1];
}
DI void moba_part_item(const Params& p, int b, int h, int n, int c, const int cntn, const int t) {
  const int lane = tid_() & 63, lr = lane & 31, lh = lane >> 5;
  const bool valid = c * 32 + lr < cntn;
  const size_t rowq = (size_t)b * 4096 + t;
  const unsigned mk = p.selm16[(size_t)(b * 4 + h) * 4096 + t];
  const u16* proj = p.proj;
  bf16x8 qf[4];
  {
    const u16* qp = proj + rowq * NP + C_QC + h * 64 + lh * 8;
#pragma unroll
    for (int ks = 0; ks < 4; ++ks) qf[ks] = *(const bf16x8*)(qp + ks * 16);
  }
  float m = M_INIT, l = 0.f; f32x16 O[2]; O[0] = zero16(); O[1] = zero16();
  {
    const size_t krow0 = (size_t)b * 4096;
    const int kcol = C_KC + h * 64 + lh * 8;
    const u16* vbase = p.VC + ((size_t)(b * 4 + h) * 128 * 2) * 1024 + lane * 16;
    const int kt0 = n * 8;
    attn_run(qf, [&](int prev) { return prev < 0 ? kt0 : (prev + 1 < kt0 + 8 ? prev + 1 : -1); },
             [&](int kt, const u16*& kp, const u16*& vp) { kp = proj + (krow0 + kt * 32 + lr) * NP + kcol; vp = vbase + (size_t)kt * 2048; },
             [&](int, int& lo, int& hi) { lo = -BIG; hi = BIG; }, m, l, O, lh);
  }
  const int k = __popc(mk & ((1u << n) - 1u));
  if (valid) {
    if (lh == 0) { float2 ml; ml.x = m; ml.y = l; *(float2*)(p.mlC + ((rowq * 4 + h) * 3 + k) * 2) = ml; }
    u16* orow = p.proj + rowq * NP + moba_seg_col(h, k) + 4 * lh;
#pragma unroll
    for (int dt = 0; dt < 2; ++dt)
#pragma unroll
      for (int i = 0; i < 4; ++i) {
        uint2 o; o.x = pack2(O[dt][i * 4], O[dt][i * 4 + 1]); o.y = pack2(O[dt][i * 4 + 2], O[dt][i * 4 + 3]);
        *(uint2*)(orow + dt * 32 + 8 * i) = o;
      }
  }
}

DI void moba_item(const Params& p, int b, int h, int qt) {
  const int lane = tid_() & 63, lr = lane & 31, lh = lane >> 5;
  const int t0 = qt * 32, bo = qt >> 3, tq = t0 + lr;
  const size_t rowq = (size_t)b * 4096 + tq;
  const u16* proj = p.proj;
  bf16x8 qf[4];
  {
    const u16* qp = proj + rowq * NP + C_QC + h * 64 + lh * 8;
#pragma unroll
    for (int ks = 0; ks < 4; ++ks) qf[ks] = *(const bf16x8*)(qp + ks * 16);
  }
  float m = M_INIT, l = 0.f; f32x16 O[2]; O[0] = zero16(); O[1] = zero16();
  if (bo > 0) {
    const unsigned mk = p.selm16[(size_t)(b * 4 + h) * 4096 + tq];
    const int nsel = __popc(mk);
#pragma unroll
    for (int k = 0; k < 3; ++k) {
      const bool has = k < nsel;
      const float2 ml = *(const float2*)(p.mlC + ((rowq * 4 + h) * 3 + k) * 2);
      const float mk_ = has ? ml.x : -1e30f, lk = has ? ml.y : 0.f;
      const float mn = fmaxf(m, mk_);
      const float a = __builtin_amdgcn_exp2f(m - mn), bs = has ? __builtin_amdgcn_exp2f(mk_ - mn) : 0.f;
      l = l * a + lk * bs; m = mn;
      const u16* orow = proj + rowq * NP + moba_seg_col(h, k) + 4 * lh;
#pragma unroll
      for (int dt = 0; dt < 2; ++dt)
#pragma unroll
        for (int i = 0; i < 4; ++i) {
          const uint2 o = *(const uint2*)(orow + dt * 32 + 8 * i);
          const float o0 = has ? bf2f((u16)(o.x & 0xffff)) : 0.f, o1 = has ? bf2f((u16)(o.x >> 16)) : 0.f;
          const float o2 = has ? bf2f((u16)(o.y & 0xffff)) : 0.f, o3 = has ? bf2f((u16)(o.y >> 16)) : 0.f;
          O[dt][i * 4] = O[dt][i * 4] * a + o0 * bs; O[dt][i * 4 + 1] = O[dt][i * 4 + 1] * a + o1 * bs;
          O[dt][i * 4 + 2] = O[dt][i * 4 + 2] * a + o2 * bs; O[dt][i * 4 + 3] = O[dt][i * 4 + 3] * a + o3 * bs;
        }
    }
  }
  {
    const size_t krow0 = (size_t)b * 4096;
    const int kcol = C_KC + h * 64 + lh * 8;
    const u16* vbase = p.VC + ((size_t)(b * 4 + h) * 128 * 2) * 1024 + lane * 16;
    attn_run(qf, [&](int prev) { return prev < 0 ? qt : (prev == qt ? (bo * 8 < qt ? bo * 8 : -1) : (prev + 1 < qt ? prev + 1 : -1)); },
             [&](int kt, const u16*& kp, const u16*& vp) { kp = proj + (krow0 + kt * 32 + lr) * NP + kcol; vp = vbase + (size_t)kt * 2048; },
             [&](int kt, int& lo, int& hi) { lo = -BIG; hi = kt == qt ? lr : BIG; }, m, l, O, lh);
  }
  const float inv = 1.f / l;
#pragma unroll
  for (int dt = 0; dt < 2; ++dt)
#pragma unroll
    for (int rr = 0; rr < 16; ++rr) O[dt][rr] *= inv;
  store_gated(p.proj + rowq * NP + C_ZC + h * 64 + 4 * lh, p.obuf + rowq * 896 + 640 + h * 64 + 4 * lh, O);
}

DI void nsa_item(const Params& p, int b, int qt, char* smraw) {
  float* pslc = (float*)smraw;
  unsigned* selm = (unsigned*)(smraw + 33280);
  const int tid = tid_(), lane = tid & 63, g = tid >> 6, lr = lane & 31, lh = lane >> 5;
  const int t0 = qt * 32, tq = t0 + lr;
  const size_t rowq = (size_t)b * 4096 + tq;
  const u16* proj = p.proj;
  bf16x8 qf[4];
  {
    const u16* qp = proj + rowq * NP + C_QB + g * 64 + lh * 8;
#pragma unroll
    for (int ks = 0; ks < 4; ++ks) qf[ks] = *(const bf16x8*)(qp + ks * 16);
  }
  const int nvq = tq >= 31 ? ((tq - 31) >> 4) + 1 : 0;
  const int nct = ((t0 >> 4) + 1 + 31) >> 5;
  float m_c = M_INIT, l_c = 0.f; f32x16 Oc[2]; Oc[0] = zero16(); Oc[1] = zero16();
  const u16* kcb = p.kc + (size_t)b * 256 * 64 + lh * 8;
  const u16* vcb = p.vcF + (size_t)b * 16 * 1024 + lane * 16;
  char* kvlds = smraw + 34816;
  attn_run_shared(qf, [&](int prev) { return prev + 1 < nct ? prev + 1 : -1; },
                  [&](int ct, const u16*& kb, int& kst, const u16*& vt) {
                    kb = p.kc + ((size_t)b * 256 + ct * 32) * 64; kst = 64; vt = p.vcF + ((size_t)b * 8 + ct) * 2048;
                  },
                  [&](int ct, int& lo, int& hi) { lo = -BIG; hi = nvq - 1 - ct * 32; }, m_c, l_c, Oc, kvlds);
  const float invc = l_c > 0.f ? 1.f / l_c : 0.f;
  const u16* gp = proj + rowq * NP + C_GB + g;
  const u16 gq0 = gp[0], gq1 = gp[4], gq2 = gp[8];
  unsigned Opk[2][8];
  {
    const float g0 = sigmoidf_(bf2f(gq0)) * invc;
#pragma unroll
    for (int dt = 0; dt < 2; ++dt)
#pragma unroll
      for (int rr = 0; rr < 8; ++rr) Opk[dt][rr] = pack2(g0 * Oc[dt][2 * rr], g0 * Oc[dt][2 * rr + 1]);
  }
  {
    float carry = 0.f;
    const int ptid = tid_(), krow = ptid >> 3, kc = ptid & 7;
    const int kdst = krow * 128 + ((kc ^ ((krow >> 1) & 7)) * 16);
    const int ksw = (lr >> 1) & 7;
    const u16* kcg = p.kc + (size_t)b * 256 * 64 + (size_t)krow * 64 + kc * 8;
    uint4 kreg = *(const uint4*)kcg;
#pragma unroll 1
    for (int ct = 0; ct < 8; ++ct) {
      float tot[4] = {0.f, 0.f, 0.f, 0.f};
      if (ct < nct) {
        char* buf = kvlds + (ct & 1) * 8192;
        *(uint4*)(buf + kdst) = kreg;
        __syncthreads();
        kreg = *(const uint4*)(kcg + (size_t)(ct + 1 < nct ? ct + 1 : ct) * 32 * 64);
        f32x16 sc = zero16();
#pragma unroll
        for (int ks = 0; ks < 4; ++ks)
          sc = mfma32(*(const bf16x8*)(buf + lr * 128 + (((ks * 2 + lh) ^ ksw) * 16)), qf[ks], sc);
        float gs[4], sp[4];
#pragma unroll
        for (int i = 0; i < 4; ++i) {
          float s4 = 0.f, last = 0.f;
#pragma unroll
          for (int j = 0; j < 4; ++j) {
            const int c = ct * 32 + 4 * lh + 8 * i + j;
            const float e = (c < nvq) ? __builtin_amdgcn_exp2f(sc[i * 4 + j] - m_c) * invc : 0.f;
            s4 += e; last = e;
          }
          gs[i] = s4; sp[i] = last;
        }
        float ps[4];
#pragma unroll
        for (int i = 0; i < 4; ++i) ps[i] = xor32_get(sp[i], lh);
        if (lh) {
#pragma unroll
          for (int i = 0; i < 4; ++i) tot[i] = gs[i] + ps[i];
        } else {
          tot[0] = gs[0] + carry; tot[1] = gs[1] + ps[0]; tot[2] = gs[2] + ps[1]; tot[3] = gs[3] + ps[2];
          carry = ps[3];
        }
      } else {
        if (!lh) { tot[0] = carry; carry = 0.f; }
      }
#pragma unroll
      for (int i = 0; i < 4; ++i) pslc[(g * 32 + lr) * 65 + ct * 8 + 2 * i + lh] = tot[i];
    }
  }
  __syncthreads();
#pragma unroll 1
  for (int qi = 0; qi < 8; ++qi) {
    const int q = g * 8 + qi, J = lane, tqq = t0 + q, cur = tqq >> 6;
    const bool forced = (J == 0) || (J == cur) || (J == cur - 1);
    const bool valid = (J * 64 <= tqq);
    const float psum = ((pslc[(0 * 32 + q) * 65 + J] + pslc[(1 * 32 + q) * 65 + J]) + pslc[(2 * 32 + q) * 65 + J]) + pslc[(3 * 32 + q) * 65 + J];
    const float scv = forced ? 1e4f : (valid ? psum : -1e30f);
    int rank = 0;
#pragma unroll 4
    for (int j2 = 0; j2 < 64; ++j2) {
      const float o = __int_as_float(__builtin_amdgcn_readlane(__float_as_int(scv), j2));
      rank += ((o > scv) || (o == scv && j2 < J)) ? 1 : 0;
    }
    const bool sel = (rank < 16) && valid;
    const unsigned long long mk = __ballot(sel);
    if (lane == 0) { selm[q * 2] = (unsigned)mk; selm[q * 2 + 1] = (unsigned)(mk >> 32); }
  }
  __syncthreads();
  const unsigned mlo = selm[lr * 2], mhi = selm[lr * 2 + 1];
  unsigned alo = mlo, ahi = mhi;
#pragma unroll
  for (int o = 1; o < 32; o <<= 1) { alo |= __shfl_xor(alo, o); ahi |= __shfl_xor(ahi, o); }
  alo = __builtin_amdgcn_readfirstlane(alo); ahi = __builtin_amdgcn_readfirstlane(ahi);
  float m_s = M_INIT, l_s = 0.f; f32x16 Os[2]; Os[0] = zero16(); Os[1] = zero16();
  {
    const u16* vb = p.VS + ((size_t)b * 128 * 2) * 1024 + lane * 16;
    const unsigned long long any64 = ((unsigned long long)ahi << 32) | alo;
    const unsigned long long my64 = ((unsigned long long)mhi << 32) | mlo;
    const int Jmax = qt >> 1;
    auto next = [&](int prevJ) {
      const int J0 = prevJ + 1;
      if (J0 > Jmax) return -1;
      const unsigned long long mk = any64 >> J0;
      if (!mk) return -1;
      const int J = J0 + __builtin_ctzll(mk);
      return J <= Jmax ? J : -1;
    };
    auto band2 = [&](int J, int half, int& lo, int& hi) {
      lo = -BIG; hi = ((my64 >> J) & 1ull) ? tq - (2 * J + half) * 32 : -2 * BIG;
    };
    attn_run_shared2(qf, next, proj + ((size_t)b * 4096) * NP + C_KSB, p.VS + ((size_t)b * 128) * 2048, qt, band2, m_s, l_s, Os, kvlds);
  }
  {
    const float g1 = sigmoidf_(bf2f(gq1)) / l_s;
#pragma unroll
    for (int dt = 0; dt < 2; ++dt)
#pragma unroll
      for (int rr = 0; rr < 8; ++rr)
        Opk[dt][rr] = pack2(bf2f((u16)(Opk[dt][rr] & 0xffff)) + g1 * Os[dt][2 * rr], bf2f((u16)(Opk[dt][rr] >> 16)) + g1 * Os[dt][2 * rr + 1]);
  }
  m_s = M_INIT; l_s = 0.f; Os[0] = zero16(); Os[1] = zero16();
  {
    const u16* vb = p.VW + ((size_t)b * 128 * 2) * 1024 + lane * 16;
    const int klo = qt - 16 < 0 ? 0 : qt - 16;
    const int Jhi = qt >> 1, Jlo = klo >> 1;
    attn_run_shared2(qf, [&](int prev) { return prev < 0 ? Jhi : (prev - 1 >= Jlo ? prev - 1 : -1); },
                     proj + ((size_t)b * 4096) * NP + C_KWB, p.VW + ((size_t)b * 128) * 2048, qt,
                     [&](int J, int half, int& lo, int& hi) { hi = tq - (2 * J + half) * 32; lo = hi - 511; }, m_s, l_s, Os, kvlds);
  }
  {
    const float g2 = sigmoidf_(bf2f(gq2)) / l_s;
#pragma unroll
    for (int dt = 0; dt < 2; ++dt)
#pragma unroll
      for (int rr = 0; rr < 8; ++rr) {
        Os[dt][2 * rr] = bf2f((u16)(Opk[dt][rr] & 0xffff)) + g2 * Os[dt][2 * rr];
        Os[dt][2 * rr + 1] = bf2f((u16)(Opk[dt][rr] >> 16)) + g2 * Os[dt][2 * rr + 1];
      }
  }
  store_gated(p.proj + rowq * NP + C_ZB + g * 64 + 4 * lh, p.obuf + rowq * 896 + 384 + g * 64 + 4 * lh, Os);
  __syncthreads();
}

DI void phase_attn_far(const Params& p_in, const BlkMap bm) {
  const Params p = launder(p_in);
  const int wid = tid_() >> 6;
  for (int it = bm.j * 4 + wid; it < 512; it += bm.per * 4) {
    const int bh = bm.x + 8 * (it >> 7);
    moba_mask_item(p, bh >> 2, bh & 3, it & 127);
  }
  for (int w = bm.j; w < 192; w += bm.per) {
    const int bh = bm.x + 8 * (w >> 5), sub = w & 31;
    mixA_far_item(p, bh / 6, bh % 6, (sub >> 2) * 512, (sub & 3) * 4 + wid);
  }
}

DI void phase_attn_lists(const Params& p_in, const BlkMap bm) {
  const Params p = launder(p_in);
  const int wid = tid_() >> 6;
  for (int it = bm.j * 4 + wid; it < 60; it += bm.per * 4) {
    const int bh = bm.x + 8 * (it / 15);
    moba_list_item(p, bh >> 2, bh & 3, it % 15);
  }
}

DI void phase_attn(const Params& p_in, const BlkMap bm, char* smraw) {
  const Params p = launder(p_in);
  const int wid = tid_() >> 6;
  for (int w = bm.j; w < 128; w += bm.per) {
    const int qt = w < 64 ? 127 - w : w - 64;
    nsa_item(p, bm.x, qt, smraw);
  }
  for (int w = bm.j; w < 192; w += bm.per) {
    const int bh = bm.x + 8 * (w >> 5), sub = w & 31;
    mixA_item(p, bh / 6, bh % 6, sub * 128, wid);
  }
  {
    const int nwv = bm.per * 4;
    int tot[4];
#pragma unroll
    for (int i = 0; i < 4; ++i) {
      const int* cnt = p.mcnt + (bm.x + 8 * i) * 16;
      int tt = 0;
#pragma unroll 1
      for (int n = 0; n < 15; ++n) tt += (cnt[n] + 31) >> 5;
      tot[i] = tt;
    }
    const int ntot = tot[0] + tot[1] + tot[2] + tot[3];
    auto decode = [&](int it, int& bh, int& n, int& c, int& cntn) {
      int f = it, i = 0;
      if (f >= tot[0]) { f -= tot[0]; i = 1; if (f >= tot[1]) { f -= tot[1]; i = 2; if (f >= tot[2]) { f -= tot[2]; i = 3; } } }
      bh = bm.x + 8 * i;
      const int* cnt = p.mcnt + bh * 16;
      n = 0; cntn = cnt[0];
#pragma unroll 1
      for (; n < 14; ++n) { const int ch = (cntn + 31) >> 5; if (f < ch) break; f -= ch; cntn = cnt[n + 1]; }
      c = f;
    };
    int it = bm.j * 4 + wid;
    if (it < ntot) {
      int bh, n, c, cntn; decode(it, bh, n, c, cntn);
      int t = moba_part_token(p, bh, n, c, cntn);
#pragma unroll 1
      while (true) {
        const int it2 = it + nwv;
        const bool more = it2 < ntot;
        int bh2 = bh, n2 = n, c2 = c, cntn2 = cntn;
        if (more) decode(it2, bh2, n2, c2, cntn2);
        const int t2 = moba_part_token(p, bh2, n2, c2, cntn2);
        moba_part_item(p, bh >> 2, bh & 3, n, c, cntn, t);
        if (!more) break;
        it = it2; bh = bh2; n = n2; c = c2; cntn = cntn2; t = t2;
      }
    }
  }
}

DI void phase_attn_fin(const Params& p_in, const BlkMap bm) {
  const Params p = launder(p_in);
  const int wid = tid_() >> 6;
  for (int w = bm.j; w < 128; w += bm.per) {
    const int bh = bm.x + 8 * (w >> 5), qg = w & 31;
    moba_item(p, bh >> 2, bh & 3, qg * 4 + wid);
  }
}

DI void phase_merge(const Params& p_in, const BlkMap bm, int l, u16* sm) {
  const Params p = launder(p_in);
  const int tid = tid_(), lane = tid & 63, wid = tid >> 6, wm = wid >> 1, wn = wid & 1;
  const int lr = lane & 31, lh = lane >> 5;
  const u16* Wbr = p.Wbr + (size_t)l * 1024 * 896;
  const u16* Wg = p.Wg + (size_t)l * 3072 * 1024;
  for (int k = 0;; ++k) {
    int mt, nt;
    if (!tile_map(bm, k, 256, 8, mt, nt)) break;
    const int m0 = mt * 128, n0 = nt * 128;
    f32x16 yacc[2][2];
#pragma unroll
    for (int a = 0; a < 2; ++a)
#pragma unroll
      for (int b = 0; b < 2; ++b) yacc[a][b] = zero16();
#pragma unroll 1
    for (int br = 0; br < 3; ++br) {
      const int kofs = br == 0 ? 0 : (br == 1 ? 384 : 640);
      const int Kb = br == 0 ? 384 : 256;
      unsigned sg[2][2][8];
      {
        f32x16 gg[2][2];
#pragma unroll
        for (int a = 0; a < 2; ++a)
#pragma unroll
          for (int b = 0; b < 2; ++b) gg[a][b] = zero16();
        gemm_loop<2, 2, 4, true>(p.xb + (size_t)m0 * 1024, 1024, Wg + (size_t)(br * 1024 + n0) * 1024, 1024, 1024, gg, sm);
#pragma unroll
        for (int a = 0; a < 2; ++a)
#pragma unroll
          for (int b = 0; b < 2; ++b)
#pragma unroll
            for (int r = 0; r < 8; ++r) sg[a][b][r] = pack2(sigmoidf_(gg[a][b][2 * r]), sigmoidf_(gg[a][b][2 * r + 1]));
      }
      f32x16 u[2][2];
#pragma unroll
      for (int a = 0; a < 2; ++a)
#pragma unroll
        for (int b = 0; b < 2; ++b) u[a][b] = zero16();
      gemm_loop<2, 2, 4, true>(p.obuf + (size_t)m0 * 896 + kofs, 896, Wbr + (size_t)n0 * 896 + kofs, 896, Kb, u, sm);
#pragma unroll
      for (int a = 0; a < 2; ++a)
#pragma unroll
        for (int b = 0; b < 2; ++b)
#pragma unroll
          for (int r = 0; r < 8; ++r) {
            yacc[a][b][2 * r] += bf2f((u16)(sg[a][b][r] & 0xffff)) * u[a][b][2 * r];
            yacc[a][b][2 * r + 1] += bf2f((u16)(sg[a][b][r] >> 16)) * u[a][b][2 * r + 1];
          }
    }
    tile_store_bf16<2>(yacc, p.y + (size_t)m0 * 1024 + n0, 1024, (char*)sm);
  }
}

DI void phase_out(const Params& p_in, const BlkMap bm, int l, const float* xres, u16* sm) {
  const Params p = launder(p_in);
  const int tid = tid_(), lane = tid & 63, wid = tid >> 6, wm = wid >> 1, wn = wid & 1;
  const int lr = lane & 31, lh = lane >> 5;
  const u16* Wo = p.Wout + (size_t)l * 1024 * 1024;
  for (int k = 0;; ++k) {
    int mt, nt;
    if (!tile_map(bm, k, 128, 8, mt, nt)) break;
    const int m0 = mt * 256, n0 = nt * 128;
    f32x16 acc[4][2];
#pragma unroll
    for (int a = 0; a < 4; ++a)
#pragma unroll
      for (int b = 0; b < 2; ++b) acc[a][b] = zero16();
    gemm_loop<4, 2, 3, false>(p.y + (size_t)m0 * 1024, 1024, Wo + (size_t)n0 * 1024, 1024, 1024, acc, sm);
#pragma unroll
    for (int mi = 0; mi < 4; ++mi) {
      float res[2][16];
#pragma unroll
      for (int ni = 0; ni < 2; ++ni)
#pragma unroll
        for (int r = 0; r < 16; ++r) {
          const int row = m0 + wm * 128 + mi * 32 + 4 * lh + 8 * (r >> 2) + (r & 3);
          res[ni][r] = __builtin_nontemporal_load(xres + (size_t)row * 1024 + n0 + wn * 64 + ni * 32 + lr);
        }
#pragma unroll
      for (int ni = 0; ni < 2; ++ni)
#pragma unroll
        for (int r = 0; r < 16; ++r) {
          const int row = m0 + wm * 128 + mi * 32 + 4 * lh + 8 * (r >> 2) + (r & 3);
          __builtin_nontemporal_store(res[ni][r] + acc[mi][ni][r], p.out + (size_t)row * 1024 + n0 + wn * 64 + ni * 32 + lr);
        }
    }
  }
}

#define XB_TMO      128
#define XB_XCNT(j)  (256  + 64 * (j))
#define XB_XSUB(j)  (1280 + 64 * (j))
#define XB_XGEN(j)  (2304 + 64 * (j))
#define XB_TOP      3328
#define XB_TOPGEN   3392
#define XB_RANK(j)  (3456 + 64 * (j))
#define XCD_BAR_WORDS 4480
#define XB_SPIN_CAP (1u << 18)
#define LAS __attribute__((address_space(3)))
DI unsigned xb_ld(unsigned* p) { return __hip_atomic_load(p, __ATOMIC_RELAXED, __HIP_MEMORY_SCOPE_AGENT); }
DI unsigned xb_add(unsigned* p, unsigned v) { return __hip_atomic_fetch_add(p, v, __ATOMIC_RELAXED, __HIP_MEMORY_SCOPE_AGENT); }
DI unsigned xb_xcc_id() { return (unsigned)__builtin_amdgcn_s_getreg((3 << 11) | 20) & 0xFu; }
#define XB_SPIN(cond, bar) do { unsigned _sp = 0; while (cond) { __builtin_amdgcn_s_sleep(1); \
    if ((++_sp & 255u) == 0u) { if (xb_ld(&(bar)[XB_TMO])) break; if (_sp > XB_SPIN_CAP) { atomicAdd(&(bar)[XB_TMO], 1u); break; } } } } while (0)
struct XcdBarrier { unsigned* bar; unsigned x; volatile LAS unsigned* st; };
DI XcdBarrier xcd_barrier_post(unsigned* bar, volatile LAS unsigned* st) {
  XcdBarrier b; b.bar = bar; b.x = xb_xcc_id(); b.st = st;
  if (threadIdx.x == 0) (void)xb_add(&bar[XB_XCNT(b.x)], 1u);
  return b;
}
DI void xcd_barrier_complete(unsigned* bar, unsigned x, unsigned& nloc, unsigned& nx) {
  const unsigned G = gridDim.x * gridDim.y * gridDim.z;
  unsigned sum, cnt, mine, sp = 0u;
  for (;;) {
    sum = 0u; cnt = 0u; mine = 0u;
#pragma unroll
    for (unsigned j = 0; j < 16; ++j) { const unsigned c = xb_ld(&bar[XB_XCNT(j)]); sum += c; cnt += (c > 0u) ? 1u : 0u; mine = (j == x) ? c : mine; }
    if (sum == G) break;
    __builtin_amdgcn_s_sleep(1);
    if ((++sp & 255u) == 0u) { if (xb_ld(&bar[XB_TMO])) break; if (sp > XB_SPIN_CAP) { atomicAdd(&bar[XB_TMO], 1u); break; } }
  }
  nloc = mine > 0u ? mine : 1u; nx = cnt > 0u ? cnt : 1u;
}
DI void xcd_barrier(const XcdBarrier& b) {
  asm volatile("s_waitcnt vmcnt(0)" ::: "memory");
  __syncthreads();
  if (threadIdx.x == 0) {
    unsigned* bar = b.bar;
    __builtin_amdgcn_s_waitcnt(0);
    unsigned nloc = b.st[0], nx = b.st[1];
    if (nloc == 0u) { xcd_barrier_complete(bar, b.x, nloc, nx); b.st[0] = nloc; b.st[1] = nx; }
    const unsigned old = xb_add(&bar[XB_XSUB(b.x)], 1u);
    const unsigned gen = old / nloc;
    if (old + 1u == (gen + 1u) * nloc) {
      __builtin_amdgcn_fence(__ATOMIC_RELEASE, "agent");
      asm volatile("s_waitcnt vmcnt(0)" ::: "memory");
      const unsigned og = xb_add(&bar[XB_TOP], 1u);
      const unsigned tg = og / nx;
      if (og + 1u == (tg + 1u) * nx) xb_add(&bar[XB_TOPGEN], 1u);
      else XB_SPIN(xb_ld(&bar[XB_TOPGEN]) == tg, bar);
      __builtin_amdgcn_fence(__ATOMIC_ACQUIRE, "agent");
      xb_add(&bar[XB_XGEN(b.x)], 1u);
      asm volatile("s_waitcnt vmcnt(0)" ::: "memory");
    } else {
      XB_SPIN(xb_ld(&bar[XB_XGEN(b.x)]) == gen, bar);
      __builtin_amdgcn_fence(__ATOMIC_ACQUIRE, "agent");
      asm volatile("s_waitcnt vmcnt(0)" ::: "memory");
    }
  }
  __syncthreads();
}

__global__ void __launch_bounds__(256, 2) hybrid_megakernel(Params p) {
  extern __shared__ __attribute__((aligned(16))) char smraw[];
  cg::grid_group grid = cg::this_grid();
  volatile LAS unsigned* xst = (volatile LAS unsigned*)(smraw + SMEM_MAIN);
  if (threadIdx.x == 0) { xst[0] = 0u; xst[1] = 0u; }
  __syncthreads();
  const XcdBarrier xb = xcd_barrier_post(p.bar, xst);
  if (threadIdx.x == 0) xst[2] = xb_add(&p.bar[XB_RANK(xb.x)], 1u);
  if (p.out == nullptr) grid.sync();
  prep_weights(p, (float*)smraw);
  prep_misc(p);
  rmsnorm_rows(p.x, p.norm_g, p.xb);
  xcd_barrier(xb);
  BlkMap bm;
  {
    bool ok = true; unsigned mine = 0;
#pragma unroll
    for (unsigned j = 0; j < 16; ++j) {
      const unsigned c = xb_ld(&p.bar[XB_XCNT(j)]);
      ok = ok && (j < 8 ? c > 0u : c == 0u);
      mine = (j == xb.x) ? c : mine;
    }
    const unsigned rank = xst[2];
    bm.x = ok ? (int)xb.x : (int)(blockIdx.x & 7);
    bm.j = ok ? (int)rank : (int)(blockIdx.x >> 3);
    bm.per = ok ? (int)mine : (int)(gridDim.x >> 3);
    bm.x = __builtin_amdgcn_readfirstlane(bm.x); bm.j = __builtin_amdgcn_readfirstlane(bm.j); bm.per = __builtin_amdgcn_readfirstlane(bm.per);
  }
#pragma unroll 1
  for (int l = 0; l < 2; ++l) {
    const float* xin = l == 0 ? p.x : p.out;
    phase_inproj(p, bm, l, (u16*)smraw);
    xcd_barrier(xb);
    phase_mid(p, l, smraw);
    xcd_barrier(xb);
    phase_attn_far(p, bm);
    xcd_barrier(xb);
    phase_attn_lists(p, bm);
    xcd_barrier(xb);
    phase_attn(p, bm, smraw);
    xcd_barrier(xb);
    phase_attn_fin(p, bm);
    xcd_barrier(xb);
    phase_merge(p, bm, l, (u16*)smraw);
    xcd_barrier(xb);
    phase_out(p, bm, l, xin, (u16*)smraw);
    if (l == 0) {
      xcd_barrier(xb);
      rmsnorm_rows(p.out, p.norm_g + 1024, p.xb);
      xcd_barrier(xb);
    }
  }
}

extern "C" void kernel_launch(void* const* d_in, const int* in_sizes, int n_in, void* d_out, int out_size,
                              void* d_ws, size_t ws_size, hipStream_t stream) {
  Params p{};
  p.x = (const float*)d_in[0]; p.pos = (const int*)d_in[1]; p.norm_g = (const float*)d_in[2]; p.w_in = (const float*)d_in[3];
  p.qna = (const float*)d_in[4]; p.kna = (const float*)d_in[5]; p.qnb = (const float*)d_in[6]; p.knb = (const float*)d_in[7];
  p.qnc = (const float*)d_in[8]; p.knc = (const float*)d_in[9]; p.cmp_pos = (const float*)d_in[10];
  p.ckw1 = (const float*)d_in[11]; p.ckw2 = (const float*)d_in[12]; p.cvw1 = (const float*)d_in[13]; p.cvw2 = (const float*)d_in[14];
  p.wbra = (const float*)d_in[15]; p.wbrb = (const float*)d_in[16]; p.wbrc = (const float*)d_in[17]; p.wout = (const float*)d_in[18];
  p.out = (float*)d_out;
  char* ws = (char*)d_ws; size_t off = 0;
  auto take = [&](size_t bytes) { char* r = ws + off; off += (bytes + 255) & ~(size_t)255; return r; };
  p.xb = (u16*)take((size_t)32768 * 1024 * 2);
  p.proj = (u16*)take((size_t)32768 * NP * 2);
  p.Wt1 = (u16*)take((size_t)2 * NP * 1024 * 2);
  p.Wg = (u16*)take((size_t)2 * 3072 * 1024 * 2);
  p.Wbr = (u16*)take((size_t)2 * 1024 * 896 * 2);
  p.Wout = (u16*)take((size_t)2 * 1024 * 1024 * 2);
  p.W1t = (u16*)take((size_t)4 * 128 * 2048 * 2);
  p.W2t = (u16*)take((size_t)4 * 64 * 128 * 2);
  p.bias1 = (float*)take(512 * 4);
  p.kc = (u16*)take((size_t)2048 * 64 * 2);
  p.vcF = (u16*)take((size_t)2048 * 64 * 2);
  p.VS = (u16*)take((size_t)2048 * 1024 * 2);
  p.VW = (u16*)take((size_t)2048 * 1024 * 2);
  p.VC = (u16*)take((size_t)8192 * 1024 * 2);
  p.kmean = (u16*)take((size_t)512 * 64 * 2);
  p.rope = (float*)take((size_t)32768 * 16 * 4);
  p.obuf = (u16*)take((size_t)32768 * 896 * 2);
  p.bar = (unsigned*)take((size_t)XCD_BAR_WORDS * 4);
  p.mlA = (float*)take((size_t)32768 * 6 * 2 * 4);
  p.selm16 = (u16*)take((size_t)32 * 4096 * 2);
  p.mlist = (u16*)take((size_t)32 * 16 * 4096 * 2);
  p.mcnt = (int*)take((size_t)32 * 16 * 4);
  p.mlC = (float*)take((size_t)32768 * 4 * 3 * 2 * 4);
  char* va = take((size_t)3 * 12288 * 1024 * 2);
  p.VA1 = (u16*)va; p.VA4 = (u16*)(va + (size_t)12288 * 1024 * 2); p.VA16 = (u16*)(va + (size_t)2 * 12288 * 1024 * 2);
  p.y = (u16*)va;
  if (off > ws_size) { fprintf(stderr, "workspace too small: need %zu have %zu\n", off, ws_size); return; }

  static int grid_blocks = 0;
  if (!grid_blocks) {
    int dev = 0, cus = 0, per_cu = 0;
    hipGetDevice(&dev);
    hipDeviceGetAttribute(&cus, hipDeviceAttributeMultiprocessorCount, dev);
    hipFuncSetAttribute((const void*)hybrid_megakernel, hipFuncAttributeMaxDynamicSharedMemorySize, SMEM_BYTES);
    hipOccupancyMaxActiveBlocksPerMultiprocessor(&per_cu, hybrid_megakernel, 256, SMEM_BYTES);
    if (per_cu > 2) per_cu = 2;
    if (per_cu < 1) per_cu = 1;
    if (cus < 8) cus = 8;
    grid_blocks = cus * per_cu;
  }
  hipMemsetAsync(p.bar, 0, (size_t)XCD_BAR_WORDS * 4, stream);
  void* args[] = {&p};
  hipError_t e = hipLaunchCooperativeKernel((void*)hybrid_megakernel, dim3(grid_blocks), dim3(256), args, SMEM_BYTES, stream);
  if (e != hipSuccess) fprintf(stderr, "cooperative launch failed: %s (grid %d)\n", hipGetErrorString(e), grid_blocks);
}
```

```cpp
#include <hip/hip_runtime.h>
#include <hip/hip_cooperative_groups.h>
#include <cstdio>
namespace cg = cooperative_groups;

typedef unsigned short u16;
typedef __attribute__((ext_vector_type(8))) short bf16x8;
typedef __attribute__((ext_vector_type(16))) float f32x16;
#define DI __device__ __forceinline__

constexpr int NP = 3584;
constexpr int INW = 6540;
constexpr int C_QA = 0, C_KA = 384, C_VA = 768, C_ZA = 1152, C_QB = 1536, C_KCB = 1792, C_VCB = 1856,
              C_KSB = 1920, C_VSB = 1984, C_KWB = 2048, C_VWB = 2112, C_ZB = 2176, C_QC = 2432, C_KC = 2688,
              C_VC = 2944, C_ZC = 3200, C_GB = 3456;
constexpr int SMEM_MAIN = 73728;
constexpr int SMEM_BYTES = SMEM_MAIN + 16;

struct Params {
  const float* x; const int* pos; const float* norm_g; const float* w_in;
  const float* qna; const float* kna; const float* qnb; const float* knb; const float* qnc; const float* knc;
  const float* cmp_pos; const float* ckw1; const float* ckw2; const float* cvw1; const float* cvw2;
  const float* wbra; const float* wbrb; const float* wbrc; const float* wout;
  float* out;
  u16* xb; u16* proj; u16* y; u16* Wt1; u16* Wg; u16* Wbr; u16* Wout; u16* W1t; u16* W2t;
  float* bias1; u16* kc; u16* vcF; u16* VA1; u16* VA4; u16* VA16; u16* VS; u16* VW; u16* VC; u16* kmean;
  float* rope; u16* obuf; unsigned* bar; float* mlA;
  u16* selm16; u16* mlist; int* mcnt; float* mlC;
};

__device__ const float c_freq[8] = {1.0f, 0.19392274474868576f, 0.03760603093086393f, 0.007292664737217109f,
                                    0.001414213562373095f, 0.0002742481756762073f, 5.318295896944988e-05f,
                                    1.031338537721246e-05f};

DI u16 f2bf(float f) { __bf16 b = (__bf16)f; return __builtin_bit_cast(u16, b); }
DI float bf2f(u16 h) { return __uint_as_float(((unsigned)h) << 16); }
DI unsigned pack2(float a, float b) { return (unsigned)f2bf(a) | ((unsigned)f2bf(b) << 16); }
DI f32x16 mfma32(bf16x8 a, bf16x8 b, f32x16 c) { return __builtin_amdgcn_mfma_f32_32x32x16_bf16(a, b, c, 0, 0, 0); }
DI f32x16 zero16() { f32x16 z;
#pragma unroll
  for (int i = 0; i < 16; ++i) z[i] = 0.f; return z; }
DI float sigmoidf_(float x) { return 1.f / (1.f + __expf(-x)); }
DI float siluf_(float x) { return x / (1.f + __expf(-x)); }

typedef __attribute__((ext_vector_type(2))) unsigned u32x2_t;
DI float xor32_max(float x) {
  const u32x2_t r = __builtin_amdgcn_permlane32_swap(__float_as_uint(x), __float_as_uint(x), false, false);
  return __builtin_amdgcn_fmed3f(__uint_as_float(r[0]), __uint_as_float(r[1]), __builtin_inff());
}
DI float xor32_sum(float x) {
  const u32x2_t r = __builtin_amdgcn_permlane32_swap(__float_as_uint(x), __float_as_uint(x), false, false);
  return __uint_as_float(r[0]) + __uint_as_float(r[1]);
}
DI float xor32_get(float x, int lh) {
  const u32x2_t r = __builtin_amdgcn_permlane32_swap(__float_as_uint(x), __float_as_uint(x), false, false);
  return __uint_as_float(lh ? r[0] : r[1]);
}
DI unsigned xor32_or(unsigned x) {
  const u32x2_t r = __builtin_amdgcn_permlane32_swap(x, x, false, false);
  return r[0] | r[1];
}


DI int tid_() { int t = threadIdx.x; asm volatile("" : "+v"(t)); return t; }
template <class T> DI T* as_global(T* ptr) { return (T*)(__attribute__((address_space(1))) T*)ptr; }
#define LAU(f) do { asm volatile("" : "+s"(q.f)); q.f = as_global(q.f); } while (0)
DI Params launder(const Params& p) {
  Params q = p;
  return q;
}

struct TDesc { const float* src; int ld; int nvalid; u16* dst; int dld; };
DI void tconv_pair(const TDesc a, const TDesc b, const bool hasb, float* sm) {
  const int tid = tid_(), n = tid & 63, kq = tid >> 6;
  float va[16], vb[16];
#pragma unroll
  for (int i = 0; i < 16; ++i) { const int k = i * 4 + kq; va[i] = (n < a.nvalid) ? a.src[(size_t)k * a.ld + n] : 0.f; }
#pragma unroll
  for (int i = 0; i < 16; ++i) { const int k = i * 4 + kq; vb[i] = (hasb && n < b.nvalid) ? b.src[(size_t)k * b.ld + n] : 0.f; }
#pragma unroll
  for (int i = 0; i < 16; ++i) { const int k = i * 4 + kq; sm[k * 65 + n] = va[i]; sm[4160 + k * 65 + n] = vb[i]; }
  __syncthreads();
  const int k = tid & 63;
#pragma unroll 4
  for (int i = 0; i < 16; ++i) {
    const int nn = i * 4 + kq;
    a.dst[(size_t)nn * a.dld + k] = f2bf(sm[k * 65 + nn]);
    if (hasb) b.dst[(size_t)nn * b.dld + k] = f2bf(sm[4160 + k * 65 + nn]);
  }
  __syncthreads();
}

DI TDesc tile_desc(const Params& p, int idx) {
  constexpr int TL = 2276;
  TDesc d;
  int l = idx / TL, t = idx % TL;
  if (t < 896) {
    int cg_ = t >> 4, kg = t & 15;
    d.nvalid = cg_ < 54 ? 64 : (cg_ == 54 ? 12 : 0);
    int srccol = cg_ < 34 ? cg_ * 64 : (cg_ < 54 ? cg_ * 64 + 12 : 2176);
    d.src = p.w_in + (size_t)l * 1024 * INW + (size_t)(kg * 64) * INW + srccol; d.ld = INW;
    d.dst = p.Wt1 + (size_t)l * NP * 1024 + (size_t)(cg_ * 64) * 1024 + kg * 64; d.dld = 1024;
  } else if (t < 1664) {
    t -= 896; int cg_ = t >> 4, kg = t & 15;
    d.nvalid = 64;
    d.src = p.w_in + (size_t)l * 1024 * INW + (size_t)(kg * 64) * INW + 3468 + cg_ * 64; d.ld = INW;
    d.dst = p.Wg + (size_t)l * 3072 * 1024 + (size_t)(cg_ * 64) * 1024 + kg * 64; d.dld = 1024;
  } else if (t < 1888) {
    t -= 1664; int ng = t / 14, kg = t % 14;
    const float* src;
    if (kg < 6) src = p.wbra + (size_t)l * 384 * 1024 + (size_t)(kg * 64) * 1024;
    else if (kg < 10) src = p.wbrb + (size_t)l * 256 * 1024 + (size_t)((kg - 6) * 64) * 1024;
    else src = p.wbrc + (size_t)l * 256 * 1024 + (size_t)((kg - 10) * 64) * 1024;
    d.nvalid = 64; d.src = src + ng * 64; d.ld = 1024;
    d.dst = p.Wbr + (size_t)l * 1024 * 896 + (size_t)(ng * 64) * 896 + kg * 64; d.dld = 896;
  } else if (t < 2144) {
    t -= 1888; int ng = t >> 4, kg = t & 15;
    d.nvalid = 64; d.src = p.wout + (size_t)l * 1024 * 1024 + (size_t)(kg * 64) * 1024 + ng * 64; d.ld = 1024;
    d.dst = p.Wout + (size_t)l * 1024 * 1024 + (size_t)(ng * 64) * 1024 + kg * 64; d.dld = 1024;
  } else if (t < 2272) {
    t -= 2144; int kv = t >> 6; t &= 63; int ng = t >> 5, kg = t & 31;
    const float* w = kv ? p.cvw1 : p.ckw1;
    d.nvalid = 64; d.src = w + (size_t)l * 2048 * 128 + (size_t)(kg * 64) * 128 + ng * 64; d.ld = 128;
    d.dst = p.W1t + ((size_t)(l * 2 + kv) * 128 + ng * 64) * 2048 + kg * 64; d.dld = 2048;
  } else {
    t -= 2272; int kv = t >> 1, kg = t & 1;
    const float* w = kv ? p.cvw2 : p.ckw2;
    d.nvalid = 64; d.src = w + (size_t)l * 128 * 64 + (size_t)(kg * 64) * 64; d.ld = 64;
    d.dst = p.W2t + ((size_t)(l * 2 + kv) * 64) * 128 + kg * 64; d.dld = 128;
  }
  return d;
}

DI void prep_weights(const Params& p_in, float* sm) {
  const Params p = launder(p_in);
  constexpr int TL = 2276;
  for (int idx = blockIdx.x; idx < 2 * TL; idx += 2 * gridDim.x) {
    const int idx2 = idx + gridDim.x;
    const bool hasb = idx2 < 2 * TL;
    const TDesc a = tile_desc(p, idx);
    const TDesc b = tile_desc(p, hasb ? idx2 : idx);
    tconv_pair(a, b, hasb, sm);
  }
}

DI void prep_misc(const Params& p_in) {
  const Params p = launder(p_in);
  const int gtid = blockIdx.x * 256 + tid_(), gsz = gridDim.x * 256;
  for (int i = gtid; i < 32768 * 8; i += gsz) {
    int tok = i >> 3, d = i & 7;
    float a = (float)p.pos[tok] * c_freq[d];
    double rev = (double)a * 0.15915494309189535;
    rev -= floor(rev);
    float fr = (float)rev;
    p.rope[tok * 16 + d] = __builtin_amdgcn_cosf(fr);
    p.rope[tok * 16 + 8 + d] = __builtin_amdgcn_sinf(fr);
  }
  {
    const int lane = tid_() & 63;
    const int gw = blockIdx.x * 4 + (tid_() >> 6);
    if (gw < 512) {
      const int l = gw >> 8, kv = (gw >> 7) & 1, n = gw & 127;
      const float* w = (kv ? p.cvw1 : p.ckw1) + (size_t)l * 2048 * 128 + n;
      const float* cp = p.cmp_pos + l * 2048;
      float s = 0.f;
#pragma unroll 8
      for (int i = 0; i < 32; ++i) { const int k = lane + 64 * i; s += cp[k] * w[(size_t)k * 128]; }
#pragma unroll
      for (int o = 32; o >= 1; o >>= 1) s += __shfl_xor(s, o);
      if (lane == 0) p.bias1[gw] = s;
    }
  }
}

DI void rmsnorm_rows(const float* __restrict__ xin, const float* __restrict__ g, u16* __restrict__ xb) {
  const int lane = tid_() & 63, wid = tid_() >> 6;
  for (int row = (blockIdx.x * 4 + wid) * 2; row < 32768; row += gridDim.x * 8) {
    const float4* xr0 = (const float4*)(xin + (size_t)row * 1024);
    const float4* xr1 = xr0 + 256;
    float4 v0[4], v1[4];
#pragma unroll
    for (int i = 0; i < 4; ++i) { v0[i] = xr0[lane + i * 64]; v1[i] = xr1[lane + i * 64]; }
    float s0 = 0.f, s1 = 0.f;
#pragma unroll
    for (int i = 0; i < 4; ++i) {
      s0 += v0[i].x * v0[i].x + v0[i].y * v0[i].y + v0[i].z * v0[i].z + v0[i].w * v0[i].w;
      s1 += v1[i].x * v1[i].x + v1[i].y * v1[i].y + v1[i].z * v1[i].z + v1[i].w * v1[i].w;
    }
#pragma unroll
    for (int o = 32; o >= 1; o >>= 1) { s0 += __shfl_xor(s0, o); s1 += __shfl_xor(s1, o); }
    const float r0 = rsqrtf(s0 * (1.f / 1024.f) + 1e-6f), r1 = rsqrtf(s1 * (1.f / 1024.f) + 1e-6f);
#pragma unroll
    for (int i = 0; i < 4; ++i) {
      const float4 gg = ((const float4*)g)[lane + i * 64];
      uint2 o; o.x = pack2(v0[i].x * r0 * gg.x, v0[i].y * r0 * gg.y); o.y = pack2(v0[i].z * r0 * gg.z, v0[i].w * r0 * gg.w);
      *(uint2*)(xb + (size_t)row * 1024 + (lane + i * 64) * 4) = o;
      uint2 q; q.x = pack2(v1[i].x * r1 * gg.x, v1[i].y * r1 * gg.y); q.y = pack2(v1[i].z * r1 * gg.z, v1[i].w * r1 * gg.w);
      *(uint2*)(xb + (size_t)(row + 1) * 1024 + (lane + i * 64) * 4) = q;
    }
  }
}

#define WAITVL(n) asm volatile("s_waitcnt vmcnt(" #n ") lgkmcnt(0)" ::: "memory")
template <int MT, int NT, int NS, bool SWAP>
DI void gemm_loop(const u16* __restrict__ A, int lda, const u16* __restrict__ Bt, int ldb, int K,
                  f32x16 (&acc)[MT][NT], u16* sm16) {
  constexpr int BN = 64 * NT, BM = 64 * MT;
  constexpr int A_BYTES = BM * 64, B_BYTES = BN * 64, STAGE = A_BYTES + B_BYTES;
  constexpr int NLD = MT + NT;
  char* sm = (char*)sm16;
  const int tid = tid_(), lane = tid & 63, wid = tid >> 6, wm = wid >> 1, wn = wid & 1;
  const int lr = lane & 31, lh = lane >> 5;
  const int row0 = tid >> 2, kc0 = ((tid & 3) ^ ((row0 >> 2) & 3)) * 8;
  const u16* ag = A + (size_t)row0 * lda + kc0;
  const u16* bg = Bt + (size_t)row0 * ldb + kc0;
  const size_t a64 = (size_t)64 * lda, b64 = (size_t)64 * ldb;
  const int nk = K >> 5;
  auto issue = [&](int kt) {
    char* d = sm + (kt % NS) * STAGE + tid * 16;
    const int ko = kt * 32;
#pragma unroll
    for (int i = 0; i < MT; ++i)
      __builtin_amdgcn_global_load_lds((const unsigned*)(ag + i * a64 + ko), (unsigned*)(d + i * 4096), 16, 0, 0);
#pragma unroll
    for (int i = 0; i < NT; ++i)
      __builtin_amdgcn_global_load_lds((const unsigned*)(bg + i * b64 + ko), (unsigned*)(d + A_BYTES + i * 4096), 16, 0, 0);
  };
  auto wait_bar = [&](int after) {
    if (NLD == 4) { if (after >= 2) WAITVL(8); else if (after == 1) WAITVL(4); else WAITVL(0); }
    else if (NLD == 3) { if (after >= 2) WAITVL(6); else if (after == 1) WAITVL(3); else WAITVL(0); }
    else { if (after >= 2) WAITVL(12); else if (after == 1) WAITVL(6); else WAITVL(0); }
    __builtin_amdgcn_s_barrier();
    asm volatile("" ::: "memory");
  };
  const int sw = (lr >> 2) & 3;
  const int aoff = (wm * 32 * MT + lr) * 64, boff = A_BYTES + (wn * 32 * NT + lr) * 64;
  const int c0 = ((0 + lh) ^ sw) * 16, c1 = ((2 + lh) ^ sw) * 16;
  auto ldk = [&](int kt, int ks, bf16x8 (&af)[MT], bf16x8 (&bfv)[NT]) {
    const char* sb = sm + (kt % NS) * STAGE + (ks ? c1 : c0);
#pragma unroll
    for (int mi = 0; mi < MT; ++mi) af[mi] = *(const bf16x8*)(sb + aoff + mi * 2048);
#pragma unroll
    for (int ni = 0; ni < NT; ++ni) bfv[ni] = *(const bf16x8*)(sb + boff + ni * 2048);
  };
  auto mmak = [&](const bf16x8 (&af)[MT], const bf16x8 (&bfv)[NT]) {
#pragma unroll
    for (int mi = 0; mi < MT; ++mi)
#pragma unroll
      for (int ni = 0; ni < NT; ++ni)
        acc[mi][ni] = SWAP ? mfma32(bfv[ni], af[mi], acc[mi][ni]) : mfma32(af[mi], bfv[ni], acc[mi][ni]);
  };
  __syncthreads();
#pragma unroll
  for (int i = 0; i < NS - 1; ++i) if (i < nk) issue(i);
  { const int after = nk - 1 < NS - 2 ? nk - 1 : NS - 2; wait_bar(after); }
  if (nk > NS - 1) issue(NS - 1);
  bf16x8 fa_a[MT], fa_b[NT], fb_a[MT], fb_b[NT];
  ldk(0, 0, fa_a, fa_b);
  for (int kt = 0; kt < nk; ++kt) {
    ldk(kt, 1, fb_a, fb_b);
    mmak(fa_a, fa_b);
    if (kt + 1 < nk) {
      { const int r = nk - 2 - kt; wait_bar(r < NS - 2 ? r : NS - 2); }
      if (kt + NS < nk) issue(kt + NS);
      ldk(kt + 1, 0, fa_a, fa_b);
    }
    mmak(fb_a, fb_b);
  }
}

struct BlkMap { int x, j, per; };
DI bool tile_map(const BlkMap bm, int k, int MTL, int NTL, int& mt, int& nt) {
  const int x = bm.x, j = bm.j, per = bm.per;
  const int u = j + per * k;
  if (u >= (MTL >> 3) * NTL) return false;
  const int q = u / (8 * NTL), rem = u - q * (8 * NTL);
  nt = rem >> 3; mt = (x + 8 * q) * 8 + (rem & 7);
  return true;
}


template <int MT>
DI void tile_store_bf16(const f32x16 (&acc)[MT][2], u16* __restrict__ dst  , int ld, char* sm) {
  const int tid = tid_(), lane = tid & 63, wid = tid >> 6, wm = wid >> 1, wn = wid & 1;
  const int lr = lane & 31, lh = lane >> 5;
  __syncthreads();
#pragma unroll
  for (int mi = 0; mi < MT; ++mi) {
    char* rowp = sm + (wm * 32 * MT + mi * 32 + lr) * 272 + (wn * 64 + 4 * lh) * 2;
#pragma unroll
    for (int ni = 0; ni < 2; ++ni)
#pragma unroll
      for (int i = 0; i < 4; ++i) {
        uint2 o; o.x = pack2(acc[mi][ni][i * 4 + 0], acc[mi][ni][i * 4 + 1]);
        o.y = pack2(acc[mi][ni][i * 4 + 2], acc[mi][ni][i * 4 + 3]);
        *(uint2*)(rowp + (ni * 32 + 8 * i) * 2) = o;
      }
  }
  __syncthreads();
  const int c = tid & 15, r0 = tid >> 4;
#pragma unroll
  for (int j = 0; j < 4 * MT; ++j) {
    const int row = r0 + 16 * j;
    typedef __attribute__((ext_vector_type(4))) unsigned u32x4s;
    const u32x4s v = *(const u32x4s*)(sm + row * 272 + c * 16);
    __builtin_nontemporal_store(v, (u32x4s*)(dst + (size_t)row * ld + c * 8));
  }
}

DI void phase_inproj(const Params& p_in, const BlkMap bm, int l, u16* sm) {
  const Params p = launder(p_in);
  const int tid = tid_(), lane = tid & 63, wid = tid >> 6, wm = wid >> 1, wn = wid & 1;
  const int lr = lane & 31, lh = lane >> 5;
  const u16* Wt = p.Wt1 + (size_t)l * NP * 1024;
  for (int k = 0;; ++k) {
    int mt, nt;
    if (!tile_map(bm, k, 128, 28, mt, nt)) break;
    const int m0 = mt * 256, n0 = nt * 128;
    f32x16 acc[4][2];
#pragma unroll
    for (int a = 0; a < 4; ++a)
#pragma unroll
      for (int b = 0; b < 2; ++b) acc[a][b] = zero16();
    gemm_loop<4, 2, 3, true>(p.xb + (size_t)m0 * 1024, 1024, Wt + (size_t)n0 * 1024, 1024, 1024, acc, sm);
    const int cg_ = (n0 + wn * 64) >> 6;
    const float* gain = p.qna; bool has = true, isq = false;
    if (cg_ < 6) { gain = p.qna; isq = true; }
    else if (cg_ < 12) gain = p.kna;
    else if (cg_ >= 24 && cg_ < 28) { gain = p.qnb; isq = true; }
    else if (cg_ == 28 || cg_ == 30 || cg_ == 32) gain = p.knb;
    else if (cg_ >= 38 && cg_ < 42) { gain = p.qnc; isq = true; }
    else if (cg_ >= 42 && cg_ < 46) gain = p.knc;
    else has = false;
    if (has) {
      gain += l * 64;
      float4 g4[2][4], c4[4], s4[4];
#pragma unroll
      for (int ni = 0; ni < 2; ++ni)
#pragma unroll
        for (int i = 0; i < 4; ++i) g4[ni][i] = *(const float4*)(gain + ni * 32 + 4 * lh + 8 * i);
#pragma unroll
      for (int mi = 0; mi < 4; ++mi) {
        const int token = m0 + wm * 128 + mi * 32 + lr;
        c4[mi] = *(const float4*)(p.rope + (size_t)token * 16 + 4 * lh);
        s4[mi] = *(const float4*)(p.rope + (size_t)token * 16 + 8 + 4 * lh);
      }
      const float qs = isq ? 0.18033688011112042f : 1.f;
#pragma unroll
      for (int mi = 0; mi < 4; ++mi) {
        float ss = 0.f;
#pragma unroll
        for (int ni = 0; ni < 2; ++ni)
#pragma unroll
          for (int r = 0; r < 16; ++r) ss += acc[mi][ni][r] * acc[mi][ni][r];
        ss = xor32_sum(ss);
        const float rs = rsqrtf(ss * (1.f / 64.f) + 1e-6f);
#pragma unroll
        for (int ni = 0; ni < 2; ++ni)
#pragma unroll
          for (int i = 0; i < 4; ++i) {
            acc[mi][ni][i * 4 + 0] *= rs * g4[ni][i].x; acc[mi][ni][i * 4 + 1] *= rs * g4[ni][i].y;
            acc[mi][ni][i * 4 + 2] *= rs * g4[ni][i].z; acc[mi][ni][i * 4 + 3] *= rs * g4[ni][i].w;
          }
        const float cc[4] = {c4[mi].x, c4[mi].y, c4[mi].z, c4[mi].w}, sn[4] = {s4[mi].x, s4[mi].y, s4[mi].z, s4[mi].w};
#pragma unroll
        for (int j = 0; j < 4; ++j) {
          const float x1 = acc[mi][0][j], x2 = acc[mi][0][4 + j];
          acc[mi][0][j] = x1 * cc[j] - x2 * sn[j];
          acc[mi][0][4 + j] = x2 * cc[j] + x1 * sn[j];
        }
        if (isq) {
#pragma unroll
          for (int ni = 0; ni < 2; ++ni)
#pragma unroll
            for (int r = 0; r < 16; ++r) acc[mi][ni][r] *= qs;
        }
      }
    }
    tile_store_bf16<4>(acc, p.proj + (size_t)m0 * NP + n0, NP, (char*)sm);
  }
}

DI void compress_item(const Params& p, int l, int kv, int rt, char* smraw) {
  const int tid = tid_(), lane = tid & 63, w = tid >> 6, lr = lane & 31, lh = lane >> 5;
  const u16* W1 = p.W1t + (size_t)((l * 2 + kv) * 128 + w * 32 + lr) * 2048 + lh * 8;
  const int col = kv ? C_VCB : C_KCB;
  const int R = rt * 32 + lr;
  f32x16 H = zero16();
#pragma unroll 1
  for (int ks0 = 0; ks0 < 128; ks0 += 8) {
    bf16x8 af[8], wf[8];
#pragma unroll
    for (int u = 0; u < 8; ++u) {
      const int ks = ks0 + u, tt = ks >> 2, d = (ks & 3) * 16 + lh * 8;
      int tokrow = R * 16 + tt; tokrow = tokrow > 32767 ? 32767 : tokrow;
      af[u] = *(const bf16x8*)(p.proj + (size_t)tokrow * NP + col + d);
      wf[u] = *(const bf16x8*)(W1 + ks * 16);
    }
#pragma unroll
    for (int u = 0; u < 8; ++u) H = mfma32(wf[u], af[u], H);
  }
  {
    const float* b1 = p.bias1 + (l * 2 + kv) * 128 + w * 32 + 4 * lh;
    unsigned hw[8];
    float4 bb4[4];
#pragma unroll
    for (int i = 0; i < 4; ++i) bb4[i] = *(const float4*)(b1 + 8 * i);
#pragma unroll
    for (int i = 0; i < 4; ++i) {
      const float4 bb = bb4[i];
      hw[i * 2] = pack2(siluf_(H[i * 4] + bb.x), siluf_(H[i * 4 + 1] + bb.y));
      hw[i * 2 + 1] = pack2(siluf_(H[i * 4 + 2] + bb.z), siluf_(H[i * 4 + 3] + bb.w));
    }
    uint4* hs = (uint4*)smraw;
    hs[(w * 2 + 0) * 64 + lane] = make_uint4(hw[0], hw[1], hw[2], hw[3]);
    hs[(w * 2 + 1) * 64 + lane] = make_uint4(hw[4], hw[5], hw[6], hw[7]);
  }
  __syncthreads();
  if (w < 2) {
    const int dt = w;
    const u16* W2 = p.W2t + (size_t)((l * 2 + kv) * 64 + dt * 32 + lr) * 128 + 4 * lh;
    const uint4* hs = (const uint4*)smraw;
    f32x16 o2 = zero16();
    uint2 wlo[8], whi[8];
#pragma unroll
    for (int ht = 0; ht < 4; ++ht)
#pragma unroll
      for (int s = 0; s < 2; ++s) {
        const u16* wp = W2 + ht * 32 + 16 * s;
        wlo[ht * 2 + s] = *(const uint2*)wp; whi[ht * 2 + s] = *(const uint2*)(wp + 8);
      }
#pragma unroll
    for (int ht = 0; ht < 4; ++ht)
#pragma unroll
      for (int s = 0; s < 2; ++s) {
        const uint2 lo = wlo[ht * 2 + s], hi = whi[ht * 2 + s];
        union { uint4 u; bf16x8 v; } cw, ch; cw.u = make_uint4(lo.x, lo.y, hi.x, hi.y);
        ch.u = hs[(ht * 2 + s) * 64 + lane];
        o2 = kv ? mfma32(ch.v, cw.v, o2) : mfma32(cw.v, ch.v, o2);
      }
    if (kv == 0) {
#pragma unroll
      for (int i = 0; i < 4; ++i) {
        uint2 o; o.x = pack2(o2[i * 4], o2[i * 4 + 1]); o.y = pack2(o2[i * 4 + 2], o2[i * 4 + 3]);
        *(uint2*)(p.kc + (size_t)R * 64 + dt * 32 + 4 * lh + 8 * i) = o;
      }
    } else {
      uint4 a, b;
      a.x = pack2(o2[0], o2[1]); a.y = pack2(o2[2], o2[3]); a.z = pack2(o2[4], o2[5]); a.w = pack2(o2[6], o2[7]);
      b.x = pack2(o2[8], o2[9]); b.y = pack2(o2[10], o2[11]); b.z = pack2(o2[12], o2[13]); b.w = pack2(o2[14], o2[15]);
      u16* dst = p.vcF + (size_t)(rt * 2 + dt) * 1024 + lane * 16;
      *(uint4*)dst = a; *(uint4*)(dst + 8) = b;
    }
  }
  __syncthreads();
}

DI void relayout_decode(const Params& p, int idx, int lr, u16*& dstbase, int& col, int& tokbase, int& tstride) {
  if (idx < 36864) {
    const int which = idx / 12288, id = idx % 12288;
    const int dt = id & 1, bh = id >> 8, b = bh / 6, h = bh % 6;
    col = C_VA + h * 64 + dt * 32 + lr;
    if (which == 0) { const int kt = (id >> 1) & 127; tokbase = b * 4096 + kt * 32; tstride = 1; dstbase = p.VA1; }
    else if (which == 1) { const int lt = (id >> 1) & 31, r4 = (id >> 6) & 3; tokbase = b * 4096 + lt * 128 + r4; tstride = 4; dstbase = p.VA4; }
    else { const int lt = (id >> 1) & 7, r = (id >> 4) & 15; tokbase = b * 4096 + lt * 512 + r; tstride = 16; dstbase = p.VA16; }
    dstbase += (size_t)id * 1024;
  } else if (idx < 40960) {
    const int which = (idx - 36864) >> 11, id = (idx - 36864) & 2047;
    const int dt = id & 1, kt = (id >> 1) & 127, b = id >> 8;
    col = (which ? C_VWB : C_VSB) + dt * 32 + lr; tokbase = b * 4096 + kt * 32; tstride = 1;
    dstbase = (which ? p.VW : p.VS) + (size_t)id * 1024;
  } else {
    const int id = idx - 40960;
    const int dt = id & 1, kt = (id >> 1) & 127, bh = id >> 8, b = bh >> 2, h = bh & 3;
    col = C_VC + h * 64 + dt * 32 + lr; tokbase = b * 4096 + kt * 32; tstride = 1;
    dstbase = p.VC + (size_t)id * 1024;
  }
}
DI void relayout4(const Params& p, int idx0) {
  const int lane = tid_() & 63, lr = lane & 31, lh = lane >> 5;
  u16* dst[4]; unsigned w[4][8];
#pragma unroll
  for (int t = 0; t < 4; ++t) {
    int col, tokbase, tstride;
    relayout_decode(p, idx0 + t, lr, dst[t], col, tokbase, tstride);
#pragma unroll
    for (int i = 0; i < 4; ++i)
#pragma unroll
      for (int jp = 0; jp < 2; ++jp) {
        const int kk = 4 * lh + 8 * i + 2 * jp;
        const unsigned oa = (unsigned)((tokbase + kk * tstride) * NP + col), ob = (unsigned)((tokbase + (kk + 1) * tstride) * NP + col);
        const u16 a = p.proj[oa];
        const u16 b = p.proj[ob];
        w[t][i * 2 + jp] = (unsigned)a | ((unsigned)b << 16);
      }
  }
#pragma unroll
  for (int t = 0; t < 4; ++t) {
    u16* d = dst[t] + lane * 16;
    *(uint4*)d = make_uint4(w[t][0], w[t][1], w[t][2], w[t][3]);
    *(uint4*)(d + 8) = make_uint4(w[t][4], w[t][5], w[t][6], w[t][7]);
  }
}

DI void kmean_item(const Params& p, int idx) {
  const int lane = tid_() & 63;
  const int blk = idx & 15, bh = idx >> 4, b = bh >> 2, h = bh & 3;
  const unsigned o0 = (unsigned)((b * 4096 + blk * 256) * NP + C_KC + h * 64 + lane);
  float s0 = 0.f, s1 = 0.f, s2 = 0.f, s3 = 0.f;
#pragma unroll 1
  for (int i = 0; i < 256; i += 16) {
    u16 v[16];
#pragma unroll
    for (int u = 0; u < 16; ++u) v[u] = p.proj[o0 + (unsigned)((i + u) * NP)];
#pragma unroll
    for (int u = 0; u < 16; u += 4) { s0 += bf2f(v[u]); s1 += bf2f(v[u + 1]); s2 += bf2f(v[u + 2]); s3 += bf2f(v[u + 3]); }
  }
  p.kmean[(size_t)idx * 64 + lane] = f2bf(((s0 + s1) + (s2 + s3)) * (1.f / 256.f));
}

DI void phase_mid(const Params& p_in, int l, char* smraw) {
  const Params p = launder(p_in);
  const int wid = tid_() >> 6;
  constexpr int N_CMP = 128, N_KM = 128, N_REL = 3072;
  for (int it = blockIdx.x; it < N_CMP + N_KM + N_REL; it += gridDim.x) {
    if (it < N_CMP) compress_item(p, l, it >> 6, it & 63, smraw);
    else if (it < N_CMP + N_KM) kmean_item(p, (it - N_CMP) * 4 + wid);
    else relayout4(p, (it - N_CMP - N_KM) * 16 + wid * 4);
  }
}

DI void attn_loadk(const u16* __restrict__ kp, bf16x8 (&kf)[4]) {
#pragma unroll
  for (int ks = 0; ks < 4; ++ks) kf[ks] = *(const bf16x8*)(kp + ks * 16);
}

typedef __attribute__((ext_vector_type(2))) float f32x2;
DI float fmax_nc(float a, float b) { return __builtin_amdgcn_fmed3f(a, b, __builtin_inff()); }
DI void attn_core(const bf16x8 (&qf)[4], const bf16x8 (&kf)[4], const bf16x8 (&vf)[2][2], const int lo, const int hi,
                   float& m, float& l, f32x16 (&O)[2], const int lh) {
  f32x16 sc = zero16();
#pragma unroll
  for (int ks = 0; ks < 4; ++ks) sc = mfma32(kf[ks], qf[ks], sc);
  const bool empty = hi < lo;
  const bool partial = !empty && (lo > 0 || hi < 31);
  if (__builtin_amdgcn_ballot_w64(partial) != 0ull) {
    const unsigned span = (unsigned)(hi - lo);
    const int base = 4 * lh - lo;
#pragma unroll
    for (int r = 0; r < 16; ++r) {
      const unsigned rel = (unsigned)(base + 8 * (r >> 2) + (r & 3));
      sc[r] = (rel <= span) ? sc[r] : -1e30f;
    }
  }
  float mx = fmax_nc(fmax_nc(fmax_nc(sc[0], sc[1]), fmax_nc(sc[2], sc[3])), fmax_nc(fmax_nc(sc[4], sc[5]), fmax_nc(sc[6], sc[7])));
  mx = fmax_nc(mx, fmax_nc(fmax_nc(fmax_nc(sc[8], sc[9]), fmax_nc(sc[10], sc[11])), fmax_nc(fmax_nc(sc[12], sc[13]), fmax_nc(sc[14], sc[15]))));
  mx = empty ? -1e30f : mx;
  mx = xor32_max(mx);
  if (__builtin_amdgcn_ballot_w64(mx > m + 16.f) != 0ull) {
    const float mn = (mx > m + 16.f) ? mx : m;
    const float alpha = __builtin_amdgcn_exp2f(m - mn);
    l *= alpha; m = mn;
#pragma unroll
    for (int dt = 0; dt < 2; ++dt)
#pragma unroll
      for (int r = 0; r < 16; ++r) O[dt][r] *= alpha;
  }
  const float meff = empty ? 3e38f : m;
  const f32x2 m2 = {meff, meff};
  f32x2 ps2 = {0.f, 0.f}; float pv[16];
#pragma unroll
  for (int r = 0; r < 16; r += 2) {
    const f32x2 s2 = {sc[r], sc[r + 1]};
    const f32x2 d2 = s2 - m2;
    const f32x2 e2 = {__builtin_amdgcn_exp2f(d2.x), __builtin_amdgcn_exp2f(d2.y)};
    pv[r] = e2.x; pv[r + 1] = e2.y; ps2 += e2;
  }
  const float ps = xor32_sum(ps2.x + ps2.y);
  l += ps;
  bf16x8 pb[2];
#pragma unroll
  for (int s = 0; s < 2; ++s)
#pragma unroll
    for (int j = 0; j < 8; ++j) pb[s][j] = (short)f2bf(pv[8 * s + j]);
#pragma unroll
  for (int dt = 0; dt < 2; ++dt)
#pragma unroll
    for (int s = 0; s < 2; ++s) O[dt] = mfma32(vf[dt][s], pb[s], O[dt]);
}

DI void attn_compute(const bf16x8 (&qf)[4], const bf16x8 (&kf)[4], const u16* __restrict__ vp, const int lo, const int hi,
                     float& m, float& l, f32x16 (&O)[2], const int lh) {
  bf16x8 vf[2][2];
#pragma unroll
  for (int dt = 0; dt < 2; ++dt)
#pragma unroll
    for (int s = 0; s < 2; ++s) vf[dt][s] = *(const bf16x8*)(vp + dt * 1024 + s * 8);
  attn_core(qf, kf, vf, lo, hi, m, l, O, lh);
}

template <class NF, class DF, class BF>
DI void attn_run_shared(const bf16x8 (&qf)[4], NF next, DF desc, BF band, float& m, float& l, f32x16 (&O)[2], char* lds) {
  const int tid = tid_(), lane = tid & 63, lr = lane & 31, lh = lane >> 5;
  int cur = next(-1);
  if (cur < 0) return;
  const int krow = tid >> 3, kc = tid & 7;
  const int kdst = krow * 128 + ((kc ^ ((krow >> 1) & 7)) * 16);
  const int vdst = 4096 + ((((tid >> 7) * 2 + (tid & 1)) * 64 + ((tid >> 1) & 63)) * 16);
  const int ksw = (lr >> 1) & 7;
  uint4 kreg, vreg;
  {
    const u16 *kb, *vt; int kst; desc(cur, kb, kst, vt);
    kreg = *(const uint4*)(kb + (size_t)krow * kst + kc * 8);
    vreg = *(const uint4*)(vt + tid * 8);
  }
  int st = 0;
#pragma unroll 1
  while (true) {
    char* buf = lds + st * 8192;
    *(uint4*)(buf + kdst) = kreg;
    *(uint4*)(buf + vdst) = vreg;
    __syncthreads();
    const int nx = next(cur);
    {
      const u16 *kb, *vt; int kst; desc(nx >= 0 ? nx : cur, kb, kst, vt);
      kreg = *(const uint4*)(kb + (size_t)krow * kst + kc * 8);
      vreg = *(const uint4*)(vt + tid * 8);
    }
    bf16x8 kf[4], vf[2][2];
#pragma unroll
    for (int ks = 0; ks < 4; ++ks) kf[ks] = *(const bf16x8*)(buf + lr * 128 + (((ks * 2 + lh) ^ ksw) * 16));
#pragma unroll
    for (int dt = 0; dt < 2; ++dt)
#pragma unroll
      for (int s2 = 0; s2 < 2; ++s2) vf[dt][s2] = *(const bf16x8*)(buf + 4096 + ((dt * 2 + s2) * 64 + lane) * 16);
    { int lo, hi; band(cur, lo, hi); attn_core(qf, kf, vf, lo, hi, m, l, O, lh); }
    if (nx < 0) break;
    st ^= 1; cur = nx;
  }
  __syncthreads();
}

DI void attn_loadv(const u16* __restrict__ vp, bf16x8 (&vf)[2][2]) {
#pragma unroll
  for (int dt = 0; dt < 2; ++dt)
#pragma unroll
    for (int s = 0; s < 2; ++s) vf[dt][s] = *(const bf16x8*)(vp + dt * 1024 + s * 8);
}
template <class NF, class DF, class BF>
DI void attn_run(const bf16x8 (&qf)[4], NF next, DF desc, BF band, float& m, float& l, f32x16 (&O)[2], const int lh) {
  int cur = next(-1);
  if (cur < 0) return;
  bf16x8 ka[4], kb[4], va[2][2], vb[2][2];
  { const u16 *kp, *vp; desc(cur, kp, vp); attn_loadk(kp, ka); attn_loadv(vp, va); }
#pragma unroll 1
  while (true) {
    const int nx = next(cur);
    { const u16 *kp, *vp; desc(nx >= 0 ? nx : cur, kp, vp); attn_loadk(kp, kb); attn_loadv(vp, vb); }
    { int lo, hi; band(cur, lo, hi); attn_core(qf, ka, va, lo, hi, m, l, O, lh); }
    if (nx < 0) break;
    const int nn = next(nx);
    { const u16 *kp, *vp; desc(nn >= 0 ? nn : nx, kp, vp); attn_loadk(kp, ka); attn_loadv(vp, va); }
    { int lo, hi; band(nx, lo, hi); attn_core(qf, kb, vb, lo, hi, m, l, O, lh); }
    if (nn < 0) break;
    cur = nn;
  }
}

template <class NF, class BF>
DI void attn_run_shared2(const bf16x8 (&qf)[4], NF next, const u16* __restrict__ kbase, const u16* __restrict__ vbase,
                         const int ntile_max, BF band2, float& m, float& l, f32x16 (&O)[2], char* lds) {
  const int tid = tid_(), lane = tid & 63, lr = lane & 31, lh = lane >> 5;
  int cur = next(-1);
  if (cur < 0) return;
  const int krow = tid >> 3, kc = tid & 7;
  const int kdst = krow * 128 + ((kc ^ ((krow >> 1) & 7)) * 16);
  const int vdst = 4096 + ((((tid >> 7) * 2 + (tid & 1)) * 64 + ((tid >> 1) & 63)) * 16);
  const int ksw = (lr >> 1) & 7;
  uint4 k0, k1, v0, v1;
  auto fetch = [&](int J) {
    const u16* kp = kbase + ((size_t)(64 * J + krow)) * NP + kc * 8;
    k0 = *(const uint4*)kp; k1 = *(const uint4*)(kp + (size_t)32 * NP);
    const u16* vp = vbase + (size_t)(2 * J) * 2048 + tid * 8;
    v0 = *(const uint4*)vp; v1 = *(const uint4*)(vp + 2048);
  };
  fetch(cur);
  int st = 0;
#pragma unroll 1
  while (true) {
    char* buf = lds + st * 16384;
    *(uint4*)(buf + kdst) = k0; *(uint4*)(buf + vdst) = v0;
    *(uint4*)(buf + 8192 + kdst) = k1; *(uint4*)(buf + 8192 + vdst) = v1;
    __syncthreads();
    const int nx = next(cur);
    fetch(nx >= 0 ? nx : cur);
#pragma unroll 1
    for (int half = 0; half < 2; ++half) {
      if (2 * cur + half > ntile_max) break;
      const char* tb = buf + half * 8192;
      bf16x8 kf[4], vf[2][2];
#pragma unroll
      for (int ks = 0; ks < 4; ++ks) kf[ks] = *(const bf16x8*)(tb + lr * 128 + (((ks * 2 + lh) ^ ksw) * 16));
#pragma unroll
      for (int dt = 0; dt < 2; ++dt)
#pragma unroll
        for (int s2 = 0; s2 < 2; ++s2) vf[dt][s2] = *(const bf16x8*)(tb + 4096 + ((dt * 2 + s2) * 64 + lane) * 16);
      int lo, hi; band2(cur, half, lo, hi);
      attn_core(qf, kf, vf, lo, hi, m, l, O, lh);
    }
    if (nx < 0) break;
    st ^= 1; cur = nx;
  }
  __syncthreads();
}
#define M_INIT (-1e4f)
#define BIG 100000

DI void store_gated(const u16* zrow  , u16* orow  , const f32x16 (&O)[2]) {
  uint2 z[2][4];
#pragma unroll
  for (int dt = 0; dt < 2; ++dt)
#pragma unroll
    for (int i = 0; i < 4; ++i) z[dt][i] = *(const uint2*)(zrow + dt * 32 + 8 * i);
#pragma unroll
  for (int dt = 0; dt < 2; ++dt)
#pragma unroll
    for (int i = 0; i < 4; ++i) {
      const uint2 zz = z[dt][i];
      const float z0 = bf2f((u16)(zz.x & 0xffff)), z1 = bf2f((u16)(zz.x >> 16)), z2 = bf2f((u16)(zz.y & 0xffff)), z3 = bf2f((u16)(zz.y >> 16));
      uint2 o; o.x = pack2(O[dt][i * 4] * siluf_(z0), O[dt][i * 4 + 1] * siluf_(z1));
      o.y = pack2(O[dt][i * 4 + 2] * siluf_(z2), O[dt][i * 4 + 3] * siluf_(z3));
      *(uint2*)(orow + dt * 32 + 8 * i) = o;
    }
}

DI void mixA_far_item(const Params& p, int b, int h, int T0, int r) {
  const int lane = tid_() & 63, lr = lane & 31, lh = lane >> 5;
  const int tq = T0 + r + 16 * lr;
  const size_t rowq = (size_t)b * 4096 + tq;
  const u16* proj = p.proj;
  bf16x8 qf[4];
  {
    const u16* qp = proj + rowq * NP + C_QA + h * 64 + lh * 8;
#pragma unroll
    for (int ks = 0; ks < 4; ++ks) qf[ks] = *(const bf16x8*)(qp + ks * 16);
  }
  float m = M_INIT, l = 0.f; f32x16 O[2]; O[0] = zero16(); O[1] = zero16();
  const int kcol = C_KA + h * 64 + lh * 8;
  {
    const size_t bh = (size_t)(b * 6 + h);
    auto lbase_of = [&](int id) { return (T0 >> 4) - 128 + 32 * (4 - id); };
    auto next = [&](int prev) {
      int id = prev + 1;
      while (id < 5 && lbase_of(id) < 0) ++id;
      return id < 5 ? id : -1;
    };
    auto desc = [&](int id, const u16*& kp, const u16*& vp) {
      const int lbase = lbase_of(id);
      const int tk = (lbase + lr) * 16 + r;
      vp = p.VA16 + (((bh * 16 + r) * 8 + (size_t)(lbase >> 5)) * 2) * 1024 + lane * 16;
      kp = proj + ((size_t)b * 4096 + tk) * NP + kcol;
    };
    auto band = [&](int id, int& lo, int& hi) { hi = (T0 >> 4) + lr - lbase_of(id); lo = hi - 128; };
    attn_run(qf, next, desc, band, m, l, O, lh);
  }
  if (lh == 0) { float2 ml; ml.x = m; ml.y = l; *(float2*)(p.mlA + (rowq * 6 + h) * 2) = ml; }
  u16* orow = p.obuf + rowq * 896 + h * 64 + 4 * lh;
#pragma unroll
  for (int dt = 0; dt < 2; ++dt)
#pragma unroll
    for (int i = 0; i < 4; ++i) {
      uint2 o; o.x = pack2(O[dt][i * 4], O[dt][i * 4 + 1]); o.y = pack2(O[dt][i * 4 + 2], O[dt][i * 4 + 3]);
      *(uint2*)(orow + dt * 32 + 8 * i) = o;
    }
}

DI void mixA_item(const Params& p, int b, int h, int T0, int r4) {
  const int lane = tid_() & 63, lr = lane & 31, lh = lane >> 5;
  const int tq = T0 + r4 + 4 * lr;
  const size_t rowq = (size_t)b * 4096 + tq;
  const u16* proj = p.proj;
  bf16x8 qf[4];
  {
    const u16* qp = proj + rowq * NP + C_QA + h * 64 + lh * 8;
#pragma unroll
    for (int ks = 0; ks < 4; ++ks) qf[ks] = *(const bf16x8*)(qp + ks * 16);
  }
  float m, l; f32x16 O[2];
  {
    const float2 ml = *(const float2*)(p.mlA + (rowq * 6 + h) * 2);
    m = ml.x; l = ml.y;
    const u16* orow = p.obuf + rowq * 896 + h * 64 + 4 * lh;
#pragma unroll
    for (int dt = 0; dt < 2; ++dt)
#pragma unroll
      for (int i = 0; i < 4; ++i) {
        const uint2 o = *(const uint2*)(orow + dt * 32 + 8 * i);
        O[dt][i * 4] = bf2f((u16)(o.x & 0xffff)); O[dt][i * 4 + 1] = bf2f((u16)(o.x >> 16));
        O[dt][i * 4 + 2] = bf2f((u16)(o.y & 0xffff)); O[dt][i * 4 + 3] = bf2f((u16)(o.y >> 16));
      }
  }
  const int kcol = C_KA + h * 64 + lh * 8;
  {
    const size_t bh = (size_t)(b * 6 + h);
    auto lbase_of = [&](int id) { return id < 5 ? (T0 >> 2) - 128 + 32 * id : T0 - 128 + 32 * (id - 5); };
    auto next = [&](int prev) {
      int id = prev + 1;
      while (id < 13 && lbase_of(id) < 0) ++id;
      return id < 13 ? id : -1;
    };
    auto desc = [&](int id, const u16*& kp, const u16*& vp) {
      const int lbase = lbase_of(id);
      const size_t lt = (size_t)(lbase >> 5);
      int tk;
      if (id < 5) { tk = (lbase + lr) * 4 + r4; vp = p.VA4 + (((bh * 4 + r4) * 32 + lt) * 2) * 1024 + lane * 16; }
      else { tk = lbase + lr; vp = p.VA1 + ((bh * 128 + lt) * 2) * 1024 + lane * 16; }
      kp = proj + ((size_t)b * 4096 + tk) * NP + kcol;
    };
    auto band = [&](int id, int& lo, int& hi) {
      hi = (id < 5 ? (T0 >> 2) + lr : tq) - lbase_of(id);
      lo = hi - 128;
    };
    attn_run(qf, next, desc, band, m, l, O, lh);
  }
  const float inv = 1.f / l;
#pragma unroll
  for (int dt = 0; dt < 2; ++dt)
#pragma unroll
    for (int rr = 0; rr < 16; ++rr) O[dt][rr] *= inv;
  store_gated(p.proj + rowq * NP + C_ZA + h * 64 + 4 * lh, p.obuf + rowq * 896 + h * 64 + 4 * lh, O);
}

DI int moba_seg_col(int h, int k) {
  const int s = h * 3 + k;
  return s < 6 ? C_VA + 64 * s : (s < 10 ? C_VC + 64 * (s - 6) : (s == 10 ? C_VSB : C_VWB));
}

DI unsigned moba_select(const Params& p, const bf16x8 (&qf)[4], int b, int h, int bo, int lr, int lh) {
  const u16* kmp = p.kmean + ((size_t)(b * 4 + h) * 16 + (lr & 15)) * 64 + lh * 8;
  f32x16 s = zero16();
#pragma unroll
  for (int ks = 0; ks < 4; ++ks) s = mfma32(*(const bf16x8*)(kmp + ks * 16), qf[ks], s);
  float own[8], oth[8];
#pragma unroll
  for (int x = 0; x < 8; ++x) {
    const int n = 8 * (x >> 2) + 4 * lh + (x & 3);
    own[x] = n < bo ? s[x] : -1e30f;
  }
#pragma unroll
  for (int x = 0; x < 8; ++x) oth[x] = xor32_get(own[x], lh);
  unsigned mymask = 0;
#pragma unroll
  for (int x = 0; x < 8; ++x) {
    const int nx = 8 * (x >> 2) + 4 * lh + (x & 3);
    int rank = 0;
#pragma unroll
    for (int y = 0; y < 8; ++y) {
      const int ny = 8 * (y >> 2) + 4 * lh + (y & 3);
      const int no = 8 * (y >> 2) + 4 * (1 - lh) + (y & 3);
      if (y != x) rank += (own[y] > own[x]) || (own[y] == own[x] && ny < nx);
      rank += (oth[y] > own[x]) || (oth[y] == own[x] && no < nx);
    }
    if (rank < 3 && nx < bo) mymask |= 1u << nx;
  }
  mymask = xor32_or(mymask);
  return mymask;
}

DI void moba_mask_item(const Params& p, int b, int h, int qt) {
  const int lane = tid_() & 63, lr = lane & 31, lh = lane >> 5;
  const int bo = qt >> 3;
  unsigned mask = 0;
  if (bo > 0) {
    bf16x8 qf[4];
    const u16* qp = p.proj + ((size_t)b * 4096 + qt * 32 + lr) * NP + C_QC + h * 64 + lh * 8;
#pragma unroll
    for (int ks = 0; ks < 4; ++ks) qf[ks] = *(const bf16x8*)(qp + ks * 16);
    mask = moba_select(p, qf, b, h, bo, lr, lh);
  }
  if (lh == 0) p.selm16[(size_t)(b * 4 + h) * 4096 + qt * 32 + lr] = (u16)mask;
}

DI void moba_list_item(const Params& p, int b, int h, int n) {
  const int lane = tid_() & 63;
  const u16* selm = p.selm16 + (size_t)(b * 4 + h) * 4096;
  u16* lst = p.mlist + ((size_t)(b * 4 + h) * 16 + n) * 4096;
  int base = 0;
#pragma unroll 1
  for (int t0 = 256 * (n + 1); t0 < 4096; t0 += 512) {
    unsigned mk[8];
#pragma unroll
    for (int i = 0; i < 8; ++i) { const int t = t0 + 64 * i + lane; mk[i] = t < 4096 ? (unsigned)selm[t] : 0u; }
#pragma unroll
    for (int i = 0; i < 8; ++i) {
      const bool f = (mk[i] >> n) & 1u;
      const unsigned long long bal = __ballot(f);
      const int pos = base + __popcll(bal & ((1ull << lane) - 1ull));
      if (f) lst[pos] = (u16)(t0 + 64 * i + lane);
      base += __popcll(bal);
    }
  }
  if (lane == 0) p.mcnt[(b * 4 + h) * 16 + n] = base;
}

DI int moba_part_token(const Params& p, int bh, int n, int c, int cntn) {
  const int lr = tid_() & 31;
  const u16* lst = p.mlist + ((size_t)bh * 16 + n) * 4096;
  const int idx = c * 32 + lr;
  return (int)lst[idx < cntn ? idx : cntn - 1];
}
DI void moba_part_item(const Params& p, int b, int h, int n, int c, const int cntn, const int t) {
  const int lane = tid_() & 63, lr = lane & 31, lh = lane >> 5;
  const bool valid = c * 32 + lr < cntn;
  const size_t rowq = (size_t)b * 4096 + t;
  const unsigned mk = p.selm16[(size_t)(b * 4 + h) * 4096 + t];
  const u16* proj = p.proj;
  bf16x8 qf[4];
  {
    const u16* qp = proj + rowq * NP + C_QC + h * 64 + lh * 8;
#pragma unroll
    for (int ks = 0; ks < 4; ++ks) qf[ks] = *(const bf16x8*)(qp + ks * 16);
  }
  float m = M_INIT, l = 0.f; f32x16 O[2]; O[0] = zero16(); O[1] = zero16();
  {
    const size_t krow0 = (size_t)b * 4096;
    const int kcol = C_KC + h * 64 + lh * 8;
    const u16* vbase = p.VC + ((size_t)(b * 4 + h) * 128 * 2) * 1024 + lane * 16;
    const int kt0 = n * 8;
    attn_run(qf, [&](int prev) { return prev < 0 ? kt0 : (prev + 1 < kt0 + 8 ? prev + 1 : -1); },
             [&](int kt, const u16*& kp, const u16*& vp) { kp = proj + (krow0 + kt * 32 + lr) * NP + kcol; vp = vbase + (size_t)kt * 2048; },
             [&](int, int& lo, int& hi) { lo = -BIG; hi = BIG; }, m, l, O, lh);
  }
  const int k = __popc(mk & ((1u << n) - 1u));
  if (valid) {
    if (lh == 0) { float2 ml; ml.x = m; ml.y = l; *(float2*)(p.mlC + ((rowq * 4 + h) * 3 + k) * 2) = ml; }
    u16* orow = p.proj + rowq * NP + moba_seg_col(h, k) + 4 * lh;
#pragma unroll
    for (int dt = 0; dt < 2; ++dt)
#pragma unroll
      for (int i = 0; i < 4; ++i) {
        uint2 o; o.x = pack2(O[dt][i * 4], O[dt][i * 4 + 1]); o.y = pack2(O[dt][i * 4 + 2], O[dt][i * 4 + 3]);
        *(uint2*)(orow + dt * 32 + 8 * i) = o;
      }
  }
}

DI void moba_item(const Params& p, int b, int h, int qt) {
  const int lane = tid_() & 63, lr = lane & 31, lh = lane >> 5;
  const int t0 = qt * 32, bo = qt >> 3, tq = t0 + lr;
  const size_t rowq = (size_t)b * 4096 + tq;
  const u16* proj = p.proj;
  bf16x8 qf[4];
  {
    const u16* qp = proj + rowq * NP + C_QC + h * 64 + lh * 8;
#pragma unroll
    for (int ks = 0; ks < 4; ++ks) qf[ks] = *(const bf16x8*)(qp + ks * 16);
  }
  float m = M_INIT, l = 0.f; f32x16 O[2]; O[0] = zero16(); O[1] = zero16();
  if (bo > 0) {
    const unsigned mk = p.selm16[(size_t)(b * 4 + h) * 4096 + tq];
    const int nsel = __popc(mk);
#pragma unroll
    for (int k = 0; k < 3; ++k) {
      const bool has = k < nsel;
      const float2 ml = *(const float2*)(p.mlC + ((rowq * 4 + h) * 3 + k) * 2);
      const float mk_ = has ? ml.x : -1e30f, lk = has ? ml.y : 0.f;
      const float mn = fmaxf(m, mk_);
      const float a = __builtin_amdgcn_exp2f(m - mn), bs = has ? __builtin_amdgcn_exp2f(mk_ - mn) : 0.f;
      l = l * a + lk * bs; m = mn;
      const u16* orow = proj + rowq * NP + moba_seg_col(h, k) + 4 * lh;
#pragma unroll
      for (int dt = 0; dt < 2; ++dt)
#pragma unroll
        for (int i = 0; i < 4; ++i) {
          const uint2 o = *(const uint2*)(orow + dt * 32 + 8 * i);
          const float o0 = has ? bf2f((u16)(o.x & 0xffff)) : 0.f, o1 = has ? bf2f((u16)(o.x >> 16)) : 0.f;
          const float o2 = has ? bf2f((u16)(o.y & 0xffff)) : 0.f, o3 = has ? bf2f((u16)(o.y >> 16)) : 0.f;
          O[dt][i * 4] = O[dt][i * 4] * a + o0 * bs; O[dt][i * 4 + 1] = O[dt][i * 4 + 1] * a + o1 * bs;
          O[dt][i * 4 + 2] = O[dt][i * 4 + 2] * a + o2 * bs; O[dt][i * 4 + 3] = O[dt][i * 4 + 3] * a + o3 * bs;
        }
    }
  }
  {
    const size_t krow0 = (size_t)b * 4096;
    const int kcol = C_KC + h * 64 + lh * 8;
    const u16* vbase = p.VC + ((size_t)(b * 4 + h) * 128 * 2) * 1024 + lane * 16;
    attn_run(qf, [&](int prev) { return prev < 0 ? qt : (prev == qt ? (bo * 8 < qt ? bo * 8 : -1) : (prev + 1 < qt ? prev + 1 : -1)); },
             [&](int kt, const u16*& kp, const u16*& vp) { kp = proj + (krow0 + kt * 32 + lr) * NP + kcol; vp = vbase + (size_t)kt * 2048; },
             [&](int kt, int& lo, int& hi) { lo = -BIG; hi = kt == qt ? lr : BIG; }, m, l, O, lh);
  }
  const float inv = 1.f / l;
#pragma unroll
  for (int dt = 0; dt < 2; ++dt)
#pragma unroll
    for (int rr = 0; rr < 16; ++rr) O[dt][rr] *= inv;
  store_gated(p.proj + rowq * NP + C_ZC + h * 64 + 4 * lh, p.obuf + rowq * 896 + 640 + h * 64 + 4 * lh, O);
}

DI void nsa_item(const Params& p, int b, int qt, char* smraw) {
  float* pslc = (float*)smraw;
  unsigned* selm = (unsigned*)(smraw + 33280);
  const int tid = tid_(), lane = tid & 63, g = tid >> 6, lr = lane & 31, lh = lane >> 5;
  const int t0 = qt * 32, tq = t0 + lr;
  const size_t rowq = (size_t)b * 4096 + tq;
  const u16* proj = p.proj;
  bf16x8 qf[4];
  {
    const u16* qp = proj + rowq * NP + C_QB + g * 64 + lh * 8;
#pragma unroll
    for (int ks = 0; ks < 4; ++ks) qf[ks] = *(const bf16x8*)(qp + ks * 16);
  }
  const int nvq = tq >= 31 ? ((tq - 31) >> 4) + 1 : 0;
  const int nct = ((t0 >> 4) + 1 + 31) >> 5;
  float m_c = M_INIT, l_c = 0.f; f32x16 Oc[2]; Oc[0] = zero16(); Oc[1] = zero16();
  const u16* kcb = p.kc + (size_t)b * 256 * 64 + lh * 8;
  const u16* vcb = p.vcF + (size_t)b * 16 * 1024 + lane * 16;
  char* kvlds = smraw + 34816;
  attn_run_shared(qf, [&](int prev) { return prev + 1 < nct ? prev + 1 : -1; },
                  [&](int ct, const u16*& kb, int& kst, const u16*& vt) {
                    kb = p.kc + ((size_t)b * 256 + ct * 32) * 64; kst = 64; vt = p.vcF + ((size_t)b * 8 + ct) * 2048;
                  },
                  [&](int ct, int& lo, int& hi) { lo = -BIG; hi = nvq - 1 - ct * 32; }, m_c, l_c, Oc, kvlds);
  const float invc = l_c > 0.f ? 1.f / l_c : 0.f;
  const u16* gp = proj + rowq * NP + C_GB + g;
  const u16 gq0 = gp[0], gq1 = gp[4], gq2 = gp[8];
  unsigned Opk[2][8];
  {
    const float g0 = sigmoidf_(bf2f(gq0)) * invc;
#pragma unroll
    for (int dt = 0; dt < 2; ++dt)
#pragma unroll
      for (int rr = 0; rr < 8; ++rr) Opk[dt][rr] = pack2(g0 * Oc[dt][2 * rr], g0 * Oc[dt][2 * rr + 1]);
  }
  {
    float carry = 0.f;
    const int ptid = tid_(), krow = ptid >> 3, kc = ptid & 7;
    const int kdst = krow * 128 + ((kc ^ ((krow >> 1) & 7)) * 16);
    const int ksw = (lr >> 1) & 7;
    const u16* kcg = p.kc + (size_t)b * 256 * 64 + (size_t)krow * 64 + kc * 8;
    uint4 kreg = *(const uint4*)kcg;
#pragma unroll 1
    for (int ct = 0; ct < 8; ++ct) {
      float tot[4] = {0.f, 0.f, 0.f, 0.f};
      if (ct < nct) {
        char* buf = kvlds + (ct & 1) * 8192;
        *(uint4*)(buf + kdst) = kreg;
        __syncthreads();
        kreg = *(const uint4*)(kcg + (size_t)(ct + 1 < nct ? ct + 1 : ct) * 32 * 64);
        f32x16 sc = zero16();
#pragma unroll
        for (int ks = 0; ks < 4; ++ks)
          sc = mfma32(*(const bf16x8*)(buf + lr * 128 + (((ks * 2 + lh) ^ ksw) * 16)), qf[ks], sc);
        float gs[4], sp[4];
#pragma unroll
        for (int i = 0; i < 4; ++i) {
          float s4 = 0.f, last = 0.f;
#pragma unroll
          for (int j = 0; j < 4; ++j) {
            const int c = ct * 32 + 4 * lh + 8 * i + j;
            const float e = (c < nvq) ? __builtin_amdgcn_exp2f(sc[i * 4 + j] - m_c) * invc : 0.f;
            s4 += e; last = e;
          }
          gs[i] = s4; sp[i] = last;
        }
        float ps[4];
#pragma unroll
        for (int i = 0; i < 4; ++i) ps[i] = xor32_get(sp[i], lh);
        if (lh) {
#pragma unroll
          for (int i = 0; i < 4; ++i) tot[i] = gs[i] + ps[i];
        } else {
          tot[0] = gs[0] + carry; tot[1] = gs[1] + ps[0]; tot[2] = gs[2] + ps[1]; tot[3] = gs[3] + ps[2];
          carry = ps[3];
        }
      } else {
        if (!lh) { tot[0] = carry; carry = 0.f; }
      }
#pragma unroll
      for (int i = 0; i < 4; ++i) pslc[(g * 32 + lr) * 65 + ct * 8 + 2 * i + lh] = tot[i];
    }
  }
  __syncthreads();
#pragma unroll 1
  for (int qi = 0; qi < 8; ++qi) {
    const int q = g * 8 + qi, J = lane, tqq = t0 + q, cur = tqq >> 6;
    const bool forced = (J == 0) || (J == cur) || (J == cur - 1);
    const bool valid = (J * 64 <= tqq);
    const float psum = ((pslc[(0 * 32 + q) * 65 + J] + pslc[(1 * 32 + q) * 65 + J]) + pslc[(2 * 32 + q) * 65 + J]) + pslc[(3 * 32 + q) * 65 + J];
    const float scv = forced ? 1e4f : (valid ? psum : -1e30f);
    int rank = 0;
#pragma unroll 4
    for (int j2 = 0; j2 < 64; ++j2) {
      const float o = __int_as_float(__builtin_amdgcn_readlane(__float_as_int(scv), j2));
      rank += ((o > scv) || (o == scv && j2 < J)) ? 1 : 0;
    }
    const bool sel = (rank < 16) && valid;
    const unsigned long long mk = __ballot(sel);
    if (lane == 0) { selm[q * 2] = (unsigned)mk; selm[q * 2 + 1] = (unsigned)(mk >> 32); }
  }
  __syncthreads();
  const unsigned mlo = selm[lr * 2], mhi = selm[lr * 2 + 1];
  unsigned alo = mlo, ahi = mhi;
#pragma unroll
  for (int o = 1; o < 32; o <<= 1) { alo |= __shfl_xor(alo, o); ahi |= __shfl_xor(ahi, o); }
  alo = __builtin_amdgcn_readfirstlane(alo); ahi = __builtin_amdgcn_readfirstlane(ahi);
  float m_s = M_INIT, l_s = 0.f; f32x16 Os[2]; Os[0] = zero16(); Os[1] = zero16();
  {
    const u16* vb = p.VS + ((size_t)b * 128 * 2) * 1024 + lane * 16;
    const unsigned long long any64 = ((unsigned long long)ahi << 32) | alo;
    const unsigned long long my64 = ((unsigned long long)mhi << 32) | mlo;
    const int Jmax = qt >> 1;
    auto next = [&](int prevJ) {
      const int J0 = prevJ + 1;
      if (J0 > Jmax) return -1;
      const unsigned long long mk = any64 >> J0;
      if (!mk) return -1;
      const int J = J0 + __builtin_ctzll(mk);
      return J <= Jmax ? J : -1;
    };
    auto band2 = [&](int J, int half, int& lo, int& hi) {
      lo = -BIG; hi = ((my64 >> J) & 1ull) ? tq - (2 * J + half) * 32 : -2 * BIG;
    };
    attn_run_shared2(qf, next, proj + ((size_t)b * 4096) * NP + C_KSB, p.VS + ((size_t)b * 128) * 2048, qt, band2, m_s, l_s, Os, kvlds);
  }
  {
    const float g1 = sigmoidf_(bf2f(gq1)) / l_s;
#pragma unroll
    for (int dt = 0; dt < 2; ++dt)
#pragma unroll
      for (int rr = 0; rr < 8; ++rr)
        Opk[dt][rr] = pack2(bf2f((u16)(Opk[dt][rr] & 0xffff)) + g1 * Os[dt][2 * rr], bf2f((u16)(Opk[dt][rr] >> 16)) + g1 * Os[dt][2 * rr + 1]);
  }
  m_s = M_INIT; l_s = 0.f; Os[0] = zero16(); Os[1] = zero16();
  {
    const u16* vb = p.VW + ((size_t)b * 128 * 2) * 1024 + lane * 16;
    const int klo = qt - 16 < 0 ? 0 : qt - 16;
    attn_run_shared(qf, [&](int prev) { return prev < 0 ? qt : (prev - 1 >= klo ? prev - 1 : -1); },
                    [&](int kt, const u16*& kb, int& kst, const u16*& vt) {
                      kb = proj + ((size_t)b * 4096 + kt * 32) * NP + C_KWB; kst = NP; vt = p.VW + ((size_t)b * 128 + kt) * 2048;
                    },
                    [&](int kt, int& lo, int& hi) { hi = tq - kt * 32; lo = hi - 511; }, m_s, l_s, Os, kvlds);
  }
  {
    const float g2 = sigmoidf_(bf2f(gq2)) / l_s;
#pragma unroll
    for (int dt = 0; dt < 2; ++dt)
#pragma unroll
      for (int rr = 0; rr < 8; ++rr) {
        Os[dt][2 * rr] = bf2f((u16)(Opk[dt][rr] & 0xffff)) + g2 * Os[dt][2 * rr];
        Os[dt][2 * rr + 1] = bf2f((u16)(Opk[dt][rr] >> 16)) + g2 * Os[dt][2 * rr + 1];
      }
  }
  store_gated(p.proj + rowq * NP + C_ZB + g * 64 + 4 * lh, p.obuf + rowq * 896 + 384 + g * 64 + 4 * lh, Os);
  __syncthreads();
}

DI void phase_attn_far(const Params& p_in, const BlkMap bm) {
  const Params p = launder(p_in);
  const int wid = tid_() >> 6;
  for (int it = bm.j * 4 + wid; it < 512; it += bm.per * 4) {
    const int bh = bm.x + 8 * (it >> 7);
    moba_mask_item(p, bh >> 2, bh & 3, it & 127);
  }
  for (int w = bm.j; w < 192; w += bm.per) {
    const int bh = bm.x + 8 * (w >> 5), sub = w & 31;
    mixA_far_item(p, bh / 6, bh % 6, (sub >> 2) * 512, (sub & 3) * 4 + wid);
  }
}

DI void phase_attn_lists(const Params& p_in, const BlkMap bm) {
  const Params p = launder(p_in);
  const int wid = tid_() >> 6;
  for (int it = bm.j * 4 + wid; it < 60; it += bm.per * 4) {
    const int bh = bm.x + 8 * (it / 15);
    moba_list_item(p, bh >> 2, bh & 3, it % 15);
  }
}

DI void phase_attn(const Params& p_in, const BlkMap bm, char* smraw) {
  const Params p = launder(p_in);
  const int wid = tid_() >> 6;
  for (int w = bm.j; w < 128; w += bm.per) {
    const int qt = w < 64 ? 127 - w : w - 64;
    nsa_item(p, bm.x, qt, smraw);
  }
  for (int w = bm.j; w < 192; w += bm.per) {
    const int bh = bm.x + 8 * (w >> 5), sub = w & 31;
    mixA_item(p, bh / 6, bh % 6, sub * 128, wid);
  }
  {
    const int nwv = bm.per * 4;
    int tot[4];
#pragma unroll
    for (int i = 0; i < 4; ++i) {
      const int* cnt = p.mcnt + (bm.x + 8 * i) * 16;
      int tt = 0;
#pragma unroll 1
      for (int n = 0; n < 15; ++n) tt += (cnt[n] + 31) >> 5;
      tot[i] = tt;
    }
    const int ntot = tot[0] + tot[1] + tot[2] + tot[3];
    auto decode = [&](int it, int& bh, int& n, int& c, int& cntn) {
      int f = it, i = 0;
      if (f >= tot[0]) { f -= tot[0]; i = 1; if (f >= tot[1]) { f -= tot[1]; i = 2; if (f >= tot[2]) { f -= tot[2]; i = 3; } } }
      bh = bm.x + 8 * i;
      const int4* c4 = (const int4*)(p.mcnt + bh * 16);
      const int4 q0 = c4[0], q1 = c4[1], q2 = c4[2], q3 = c4[3];
      const int cn[15] = {q0.x, q0.y, q0.z, q0.w, q1.x, q1.y, q1.z, q1.w, q2.x, q2.y, q2.z, q2.w, q3.x, q3.y, q3.z};
      n = 14; cntn = cn[14]; c = 0;
      bool found = false;
#pragma unroll
      for (int k = 0; k < 15; ++k) {
        const int ch = (cn[k] + 31) >> 5;
        if (!found) { if (f < ch) { n = k; cntn = cn[k]; c = f; found = true; } else f -= ch; }
      }
    };
    int it = bm.j * 4 + wid;
    if (it < ntot) {
      int bh, n, c, cntn; decode(it, bh, n, c, cntn);
      int t = moba_part_token(p, bh, n, c, cntn);
#pragma unroll 1
      while (true) {
        const int it2 = it + nwv;
        const bool more = it2 < ntot;
        int bh2 = bh, n2 = n, c2 = c, cntn2 = cntn;
        if (more) decode(it2, bh2, n2, c2, cntn2);
        const int t2 = moba_part_token(p, bh2, n2, c2, cntn2);
        moba_part_item(p, bh >> 2, bh & 3, n, c, cntn, t);
        if (!more) break;
        it = it2; bh = bh2; n = n2; c = c2; cntn = cntn2; t = t2;
      }
    }
  }
}

DI void phase_attn_fin(const Params& p_in, const BlkMap bm) {
  const Params p = launder(p_in);
  const int wid = tid_() >> 6;
  for (int w = bm.j; w < 128; w += bm.per) {
    const int bh = bm.x + 8 * (w >> 5), qg = w & 31;
    moba_item(p, bh >> 2, bh & 3, qg * 4 + wid);
  }
}

DI void phase_merge(const Params& p_in, const BlkMap bm, int l, u16* sm) {
  const Params p = launder(p_in);
  const int tid = tid_(), lane = tid & 63, wid = tid >> 6, wm = wid >> 1, wn = wid & 1;
  const int lr = lane & 31, lh = lane >> 5;
  const u16* Wbr = p.Wbr + (size_t)l * 1024 * 896;
  const u16* Wg = p.Wg + (size_t)l * 3072 * 1024;
  for (int k = 0;; ++k) {
    int mt, nt;
    if (!tile_map(bm, k, 256, 8, mt, nt)) break;
    const int m0 = mt * 128, n0 = nt * 128;
    f32x16 yacc[2][2];
#pragma unroll
    for (int a = 0; a < 2; ++a)
#pragma unroll
      for (int b = 0; b < 2; ++b) yacc[a][b] = zero16();
#pragma unroll 1
    for (int br = 0; br < 3; ++br) {
      const int kofs = br == 0 ? 0 : (br == 1 ? 384 : 640);
      const int Kb = br == 0 ? 384 : 256;
      unsigned sg[2][2][8];
      {
        f32x16 gg[2][2];
#pragma unroll
        for (int a = 0; a < 2; ++a)
#pragma unroll
          for (int b = 0; b < 2; ++b) gg[a][b] = zero16();
        gemm_loop<2, 2, 4, true>(p.xb + (size_t)m0 * 1024, 1024, Wg + (size_t)(br * 1024 + n0) * 1024, 1024, 1024, gg, sm);
#pragma unroll
        for (int a = 0; a < 2; ++a)
#pragma unroll
          for (int b = 0; b < 2; ++b)
#pragma unroll
            for (int r = 0; r < 8; ++r) sg[a][b][r] = pack2(sigmoidf_(gg[a][b][2 * r]), sigmoidf_(gg[a][b][2 * r + 1]));
      }
      f32x16 u[2][2];
#pragma unroll
      for (int a = 0; a < 2; ++a)
#pragma unroll
        for (int b = 0; b < 2; ++b) u[a][b] = zero16();
      gemm_loop<2, 2, 4, true>(p.obuf + (size_t)m0 * 896 + kofs, 896, Wbr + (size_t)n0 * 896 + kofs, 896, Kb, u, sm);
#pragma unroll
      for (int a = 0; a < 2; ++a)
#pragma unroll
        for (int b = 0; b < 2; ++b)
#pragma unroll
          for (int r = 0; r < 8; ++r) {
            yacc[a][b][2 * r] += bf2f((u16)(sg[a][b][r] & 0xffff)) * u[a][b][2 * r];
            yacc[a][b][2 * r + 1] += bf2f((u16)(sg[a][b][r] >> 16)) * u[a][b][2 * r + 1];
          }
    }
    tile_store_bf16<2>(yacc, p.y + (size_t)m0 * 1024 + n0, 1024, (char*)sm);
  }
}

DI void phase_out(const Params& p_in, const BlkMap bm, int l, const float* xres, u16* sm) {
  const Params p = launder(p_in);
  const int tid = tid_(), lane = tid & 63, wid = tid >> 6, wm = wid >> 1, wn = wid & 1;
  const int lr = lane & 31, lh = lane >> 5;
  const u16* Wo = p.Wout + (size_t)l * 1024 * 1024;
  for (int k = 0;; ++k) {
    int mt, nt;
    if (!tile_map(bm, k, 128, 8, mt, nt)) break;
    const int m0 = mt * 256, n0 = nt * 128;
    f32x16 acc[4][2];
#pragma unroll
    for (int a = 0; a < 4; ++a)
#pragma unroll
      for (int b = 0; b < 2; ++b) acc[a][b] = zero16();
    gemm_loop<4, 2, 3, false>(p.y + (size_t)m0 * 1024, 1024, Wo + (size_t)n0 * 1024, 1024, 1024, acc, sm);
#pragma unroll
    for (int mi = 0; mi < 4; ++mi) {
      float res[2][16];
#pragma unroll
      for (int ni = 0; ni < 2; ++ni)
#pragma unroll
        for (int r = 0; r < 16; ++r) {
          const int row = m0 + wm * 128 + mi * 32 + 4 * lh + 8 * (r >> 2) + (r & 3);
          res[ni][r] = __builtin_nontemporal_load(xres + (size_t)row * 1024 + n0 + wn * 64 + ni * 32 + lr);
        }
#pragma unroll
      for (int ni = 0; ni < 2; ++ni)
#pragma unroll
        for (int r = 0; r < 16; ++r) {
          const int row = m0 + wm * 128 + mi * 32 + 4 * lh + 8 * (r >> 2) + (r & 3);
          __builtin_nontemporal_store(res[ni][r] + acc[mi][ni][r], p.out + (size_t)row * 1024 + n0 + wn * 64 + ni * 32 + lr);
        }
    }
  }
}

#define XB_TMO      128
#define XB_XCNT(j)  (256  + 64 * (j))
#define XB_XSUB(j)  (1280 + 64 * (j))
#define XB_XGEN(j)  (2304 + 64 * (j))
#define XB_TOP      3328
#define XB_TOPGEN   3392
#define XB_RANK(j)  (3456 + 64 * (j))
#define XCD_BAR_WORDS 4480
#define XB_SPIN_CAP (1u << 18)
#define LAS __attribute__((address_space(3)))
DI unsigned xb_ld(unsigned* p) { return __hip_atomic_load(p, __ATOMIC_RELAXED, __HIP_MEMORY_SCOPE_AGENT); }
DI unsigned xb_add(unsigned* p, unsigned v) { return __hip_atomic_fetch_add(p, v, __ATOMIC_RELAXED, __HIP_MEMORY_SCOPE_AGENT); }
DI unsigned xb_xcc_id() { return (unsigned)__builtin_amdgcn_s_getreg((3 << 11) | 20) & 0xFu; }
#define XB_SPIN(cond, bar) do { unsigned _sp = 0; while (cond) { __builtin_amdgcn_s_sleep(1); \
    if ((++_sp & 255u) == 0u) { if (xb_ld(&(bar)[XB_TMO])) break; if (_sp > XB_SPIN_CAP) { atomicAdd(&(bar)[XB_TMO], 1u); break; } } } } while (0)
struct XcdBarrier { unsigned* bar; unsigned x; volatile LAS unsigned* st; };
DI XcdBarrier xcd_barrier_post(unsigned* bar, volatile LAS unsigned* st) {
  XcdBarrier b; b.bar = bar; b.x = xb_xcc_id(); b.st = st;
  if (threadIdx.x == 0) (void)xb_add(&bar[XB_XCNT(b.x)], 1u);
  return b;
}
DI void xcd_barrier_complete(unsigned* bar, unsigned x, unsigned& nloc, unsigned& nx) {
  const unsigned G = gridDim.x * gridDim.y * gridDim.z;
  unsigned sum, cnt, mine, sp = 0u;
  for (;;) {
    sum = 0u; cnt = 0u; mine = 0u;
#pragma unroll
    for (unsigned j = 0; j < 16; ++j) { const unsigned c = xb_ld(&bar[XB_XCNT(j)]); sum += c; cnt += (c > 0u) ? 1u : 0u; mine = (j == x) ? c : mine; }
    if (sum == G) break;
    __builtin_amdgcn_s_sleep(1);
    if ((++sp & 255u) == 0u) { if (xb_ld(&bar[XB_TMO])) break; if (sp > XB_SPIN_CAP) { atomicAdd(&bar[XB_TMO], 1u); break; } }
  }
  nloc = mine > 0u ? mine : 1u; nx = cnt > 0u ? cnt : 1u;
}
DI void xcd_barrier(const XcdBarrier& b) {
  asm volatile("s_waitcnt vmcnt(0)" ::: "memory");
  __syncthreads();
  if (threadIdx.x == 0) {
    unsigned* bar = b.bar;
    __builtin_amdgcn_s_waitcnt(0);
    unsigned nloc = b.st[0], nx = b.st[1];
    if (nloc == 0u) { xcd_barrier_complete(bar, b.x, nloc, nx); b.st[0] = nloc; b.st[1] = nx; }
    const unsigned old = xb_add(&bar[XB_XSUB(b.x)], 1u);
    const unsigned gen = old / nloc;
    if (old + 1u == (gen + 1u) * nloc) {
      __builtin_amdgcn_fence(__ATOMIC_RELEASE, "agent");
      asm volatile("s_waitcnt vmcnt(0)" ::: "memory");
      const unsigned og = xb_add(&bar[XB_TOP], 1u);
      const unsigned tg = og / nx;
      if (og + 1u == (tg + 1u) * nx) xb_add(&bar[XB_TOPGEN], 1u);
      else XB_SPIN(xb_ld(&bar[XB_TOPGEN]) == tg, bar);
      __builtin_amdgcn_fence(__ATOMIC_ACQUIRE, "agent");
      xb_add(&bar[XB_XGEN(b.x)], 1u);
      asm volatile("s_waitcnt vmcnt(0)" ::: "memory");
    } else {
      XB_SPIN(xb_ld(&bar[XB_XGEN(b.x)]) == gen, bar);
      __builtin_amdgcn_fence(__ATOMIC_ACQUIRE, "agent");
      asm volatile("s_waitcnt vmcnt(0)" ::: "memory");
    }
  }
  __syncthreads();
}

__global__ void __launch_bounds__(256, 2) hybrid_megakernel(Params p) {
  extern __shared__ __attribute__((aligned(16))) char smraw[];
  cg::grid_group grid = cg::this_grid();
  volatile LAS unsigned* xst = (volatile LAS unsigned*)(smraw + SMEM_MAIN);
  if (threadIdx.x == 0) { xst[0] = 0u; xst[1] = 0u; }
  __syncthreads();
  const XcdBarrier xb = xcd_barrier_post(p.bar, xst);
  if (threadIdx.x == 0) xst[2] = xb_add(&p.bar[XB_RANK(xb.x)], 1u);
  if (p.out == nullptr) grid.sync();
  prep_weights(p, (float*)smraw);
  prep_misc(p);
  rmsnorm_rows(p.x, p.norm_g, p.xb);
  xcd_barrier(xb);
  BlkMap bm;
  {
    bool ok = true; unsigned mine = 0;
#pragma unroll
    for (unsigned j = 0; j < 16; ++j) {
      const unsigned c = xb_ld(&p.bar[XB_XCNT(j)]);
      ok = ok && (j < 8 ? c > 0u : c == 0u);
      mine = (j == xb.x) ? c : mine;
    }
    const unsigned rank = xst[2];
    bm.x = ok ? (int)xb.x : (int)(blockIdx.x & 7);
    bm.j = ok ? (int)rank : (int)(blockIdx.x >> 3);
    bm.per = ok ? (int)mine : (int)(gridDim.x >> 3);
    bm.x = __builtin_amdgcn_readfirstlane(bm.x); bm.j = __builtin_amdgcn_readfirstlane(bm.j); bm.per = __builtin_amdgcn_readfirstlane(bm.per);
  }
#pragma unroll 1
  for (int l = 0; l < 2; ++l) {
    const float* xin = l == 0 ? p.x : p.out;
    phase_inproj(p, bm, l, (u16*)smraw);
    xcd_barrier(xb);
    phase_mid(p, l, smraw);
    xcd_barrier(xb);
    phase_attn_far(p, bm);
    xcd_barrier(xb);
    phase_attn_lists(p, bm);
    xcd_barrier(xb);
    phase_attn(p, bm, smraw);
    xcd_barrier(xb);
    phase_attn_fin(p, bm);
    xcd_barrier(xb);
    phase_merge(p, bm, l, (u16*)smraw);
    xcd_barrier(xb);
    phase_out(p, bm, l, xin, (u16*)smraw);
    if (l == 0) {
      xcd_barrier(xb);
      rmsnorm_rows(p.out, p.norm_g + 1024, p.xb);
      xcd_barrier(xb);
    }
  }
}

extern "C" void kernel_launch(void* const* d_in, const int* in_sizes, int n_in, void* d_out, int out_size,
                              void* d_ws, size_t ws_size, hipStream_t stream) {
  Params p{};
  p.x = (const float*)d_in[0]; p.pos = (const int*)d_in[1]; p.norm_g = (const float*)d_in[2]; p.w_in = (const float*)d_in[3];
  p.qna = (const float*)d_in[4]; p.kna = (const float*)d_in[5]; p.qnb = (const float*)d_in[6]; p.knb = (const float*)d_in[7];
  p.qnc = (const float*)d_in[8]; p.knc = (const float*)d_in[9]; p.cmp_pos = (const float*)d_in[10];
  p.ckw1 = (const float*)d_in[11]; p.ckw2 = (const float*)d_in[12]; p.cvw1 = (const float*)d_in[13]; p.cvw2 = (const float*)d_in[14];
  p.wbra = (const float*)d_in[15]; p.wbrb = (const float*)d_in[16]; p.wbrc = (const float*)d_in[17]; p.wout = (const float*)d_in[18];
  p.out = (float*)d_out;
  char* ws = (char*)d_ws; size_t off = 0;
  auto take = [&](size_t bytes) { char* r = ws + off; off += (bytes + 255) & ~(size_t)255; return r; };
  p.xb = (u16*)take((size_t)32768 * 1024 * 2);
  p.proj = (u16*)take((size_t)32768 * NP * 2);
  p.Wt1 = (u16*)take((size_t)2 * NP * 1024 * 2);
  p.Wg = (u16*)take((size_t)2 * 3072 * 1024 * 2);
  p.Wbr = (u16*)take((size_t)2 * 1024 * 896 * 2);
  p.Wout = (u16*)take((size_t)2 * 1024 * 1024 * 2);
  p.W1t = (u16*)take((size_t)4 * 128 * 2048 * 2);
  p.W2t = (u16*)take((size_t)4 * 64 * 128 * 2);
  p.bias1 = (float*)take(512 * 4);
  p.kc = (u16*)take((size_t)2048 * 64 * 2);
  p.vcF = (u16*)take((size_t)2048 * 64 * 2);
  p.VS = (u16*)take((size_t)2048 * 1024 * 2);
  p.VW = (u16*)take((size_t)2048 * 1024 * 2);
  p.VC = (u16*)take((size_t)8192 * 1024 * 2);
  p.kmean = (u16*)take((size_t)512 * 64 * 2);
  p.rope = (float*)take((size_t)32768 * 16 * 4);
  p.obuf = (u16*)take((size_t)32768 * 896 * 2);
  p.bar = (unsigned*)take((size_t)XCD_BAR_WORDS * 4);
  p.mlA = (float*)take((size_t)32768 * 6 * 2 * 4);
  p.selm16 = (u16*)take((size_t)32 * 4096 * 2);
  p.mlist = (u16*)take((size_t)32 * 16 * 4096 * 2);
  p.mcnt = (int*)take((size_t)32 * 16 * 4);
  p.mlC = (float*)take((size_t)32768 * 4 * 3 * 2 * 4);
  char* va = take((size_t)3 * 12288 * 1024 * 2);
  p.VA1 = (u16*)va; p.VA4 = (u16*)(va + (size_t)12288 * 1024 * 2); p.VA16 = (u16*)(va + (size_t)2 * 12288 * 1024 * 2);
  p.y = (u16*)va;
  if (off > ws_size) { fprintf(stderr, "workspace too small: need %zu have %zu\n", off, ws_size); return; }

  static int grid_blocks = 0;
  if (!grid_blocks) {
    int dev = 0, cus = 0, per_cu = 0;
    hipGetDevice(&dev);
    hipDeviceGetAttribute(&cus, hipDeviceAttributeMultiprocessorCount, dev);
    hipFuncSetAttribute((const void*)hybrid_megakernel, hipFuncAttributeMaxDynamicSharedMemorySize, SMEM_BYTES);
    hipOccupancyMaxActiveBlocksPerMultiprocessor(&per_cu, hybrid_megakernel, 256, SMEM_BYTES);
    if (per_cu > 2) per_cu = 2;
    if (per_cu < 1) per_cu = 1;
    if (cus < 8) cus = 8;
    grid_blocks = cus * per_cu;
  }
  hipMemsetAsync(p.bar, 0, (size_t)XCD_BAR_WORDS * 4, stream);
  void* args[] = {&p};
  hipError_t e = hipLaunchCooperativeKernel((void*)hybrid_megakernel, dim3(grid_blocks), dim3(256), args, SMEM_BYTES, stream);
  if (e != hipSuccess) fprintf(stderr, "cooperative launch failed: %s (grid %d)\n", hipGetErrorString(e), grid_blocks);
}
```

```cpp
#include <hip/hip_runtime.h>
#include <hip/hip_cooperative_groups.h>
#include <cstdio>
namespace cg = cooperative_groups;

typedef unsigned short u16;
typedef __attribute__((ext_vector_type(8))) short bf16x8;
typedef __attribute__((ext_vector_type(16))) float f32x16;
#define DI __device__ __forceinline__

constexpr int NP = 3584;
constexpr int INW = 6540;
constexpr int C_QA = 0, C_KA = 384, C_VA = 768, C_ZA = 1152, C_QB = 1536, C_KCB = 1792, C_VCB = 1856,
              C_KSB = 1920, C_VSB = 1984, C_KWB = 2048, C_VWB = 2112, C_ZB = 2176, C_QC = 2432, C_KC = 2688,
              C_VC = 2944, C_ZC = 3200, C_GB = 3456;
constexpr int SMEM_MAIN = 73728;
constexpr int SMEM_BYTES = SMEM_MAIN + 16;

struct Params {
  const float* x; const int* pos; const float* norm_g; const float* w_in;
  const float* qna; const float* kna; const float* qnb; const float* knb; const float* qnc; const float* knc;
  const float* cmp_pos; const float* ckw1; const float* ckw2; const float* cvw1; const float* cvw2;
  const float* wbra; const float* wbrb; const float* wbrc; const float* wout;
  float* out;
  u16* xb; u16* proj; u16* y; u16* Wt1; u16* Wg; u16* Wbr; u16* Wout; u16* W1t; u16* W2t;
  float* bias1; u16* kc; u16* vcF; u16* VA1; u16* VA4; u16* VA16; u16* VS; u16* VW; u16* VC; u16* kmean;
  float* rope; u16* obuf; unsigned* bar; float* mlA;
  u16* selm16; u16* mlist; int* mcnt; float* mlC;
};

__device__ const float c_freq[8] = {1.0f, 0.19392274474868576f, 0.03760603093086393f, 0.007292664737217109f,
                                    0.001414213562373095f, 0.0002742481756762073f, 5.318295896944988e-05f,
                                    1.031338537721246e-05f};

DI u16 f2bf(float f) { __bf16 b = (__bf16)f; return __builtin_bit_cast(u16, b); }
DI float bf2f(u16 h) { return __uint_as_float(((unsigned)h) << 16); }
DI unsigned pack2(float a, float b) { return (unsigned)f2bf(a) | ((unsigned)f2bf(b) << 16); }
DI f32x16 mfma32(bf16x8 a, bf16x8 b, f32x16 c) { return __builtin_amdgcn_mfma_f32_32x32x16_bf16(a, b, c, 0, 0, 0); }
DI f32x16 zero16() { f32x16 z;
#pragma unroll
  for (int i = 0; i < 16; ++i) z[i] = 0.f; return z; }
DI float sigmoidf_(float x) { return 1.f / (1.f + __expf(-x)); }
DI float siluf_(float x) { return x / (1.f + __expf(-x)); }

typedef __attribute__((ext_vector_type(2))) unsigned u32x2_t;
DI float xor32_max(float x) {
  const u32x2_t r = __builtin_amdgcn_permlane32_swap(__float_as_uint(x), __float_as_uint(x), false, false);
  return __builtin_amdgcn_fmed3f(__uint_as_float(r[0]), __uint_as_float(r[1]), __builtin_inff());
}
DI float xor32_sum(float x) {
  const u32x2_t r = __builtin_amdgcn_permlane32_swap(__float_as_uint(x), __float_as_uint(x), false, false);
  return __uint_as_float(r[0]) + __uint_as_float(r[1]);
}
DI float xor32_get(float x, int lh) {
  const u32x2_t r = __builtin_amdgcn_permlane32_swap(__float_as_uint(x), __float_as_uint(x), false, false);
  return __uint_as_float(lh ? r[0] : r[1]);
}
DI unsigned xor32_or(unsigned x) {
  const u32x2_t r = __builtin_amdgcn_permlane32_swap(x, x, false, false);
  return r[0] | r[1];
}


DI int tid_() { int t = threadIdx.x; asm volatile("" : "+v"(t)); return t; }
template <class T> DI T* as_global(T* ptr) { return (T*)(__attribute__((address_space(1))) T*)ptr; }
#define LAU(f) do { asm volatile("" : "+s"(q.f)); q.f = as_global(q.f); } while (0)
DI Params launder(const Params& p) {
  Params q = p;
  return q;
}

struct TDesc { const float* src; int ld; int nvalid; u16* dst; int dld; };
DI void tconv_pair(const TDesc a, const TDesc b, const bool hasb, float* sm) {
  const int tid = tid_(), n = tid & 63, kq = tid >> 6;
  float va[16], vb[16];
#pragma unroll
  for (int i = 0; i < 16; ++i) { const int k = i * 4 + kq; va[i] = (n < a.nvalid) ? a.src[(size_t)k * a.ld + n] : 0.f; }
#pragma unroll
  for (int i = 0; i < 16; ++i) { const int k = i * 4 + kq; vb[i] = (hasb && n < b.nvalid) ? b.src[(size_t)k * b.ld + n] : 0.f; }
#pragma unroll
  for (int i = 0; i < 16; ++i) { const int k = i * 4 + kq; sm[k * 65 + n] = va[i]; sm[4160 + k * 65 + n] = vb[i]; }
  __syncthreads();
  const int k2 = (tid & 31) * 2, ng = tid >> 5;
#pragma unroll 4
  for (int i = 0; i < 8; ++i) {
    const int nn = i * 8 + ng;
    *(unsigned*)(a.dst + (size_t)nn * a.dld + k2) = pack2(sm[k2 * 65 + nn], sm[(k2 + 1) * 65 + nn]);
    if (hasb) *(unsigned*)(b.dst + (size_t)nn * b.dld + k2) = pack2(sm[4160 + k2 * 65 + nn], sm[4160 + (k2 + 1) * 65 + nn]);
  }
  __syncthreads();
}

DI TDesc tile_desc(const Params& p, int idx) {
  constexpr int TL = 2276;
  TDesc d;
  int l = idx / TL, t = idx % TL;
  if (t < 896) {
    int cg_ = t >> 4, kg = t & 15;
    d.nvalid = cg_ < 54 ? 64 : (cg_ == 54 ? 12 : 0);
    int srccol = cg_ < 34 ? cg_ * 64 : (cg_ < 54 ? cg_ * 64 + 12 : 2176);
    d.src = p.w_in + (size_t)l * 1024 * INW + (size_t)(kg * 64) * INW + srccol; d.ld = INW;
    d.dst = p.Wt1 + (size_t)l * NP * 1024 + (size_t)(cg_ * 64) * 1024 + kg * 64; d.dld = 1024;
  } else if (t < 1664) {
    t -= 896; int cg_ = t >> 4, kg = t & 15;
    d.nvalid = 64;
    d.src = p.w_in + (size_t)l * 1024 * INW + (size_t)(kg * 64) * INW + 3468 + cg_ * 64; d.ld = INW;
    d.dst = p.Wg + (size_t)l * 3072 * 1024 + (size_t)(cg_ * 64) * 1024 + kg * 64; d.dld = 1024;
  } else if (t < 1888) {
    t -= 1664; int ng = t / 14, kg = t % 14;
    const float* src;
    if (kg < 6) src = p.wbra + (size_t)l * 384 * 1024 + (size_t)(kg * 64) * 1024;
    else if (kg < 10) src = p.wbrb + (size_t)l * 256 * 1024 + (size_t)((kg - 6) * 64) * 1024;
    else src = p.wbrc + (size_t)l * 256 * 1024 + (size_t)((kg - 10) * 64) * 1024;
    d.nvalid = 64; d.src = src + ng * 64; d.ld = 1024;
    d.dst = p.Wbr + (size_t)l * 1024 * 896 + (size_t)(ng * 64) * 896 + kg * 64; d.dld = 896;
  } else if (t < 2144) {
    t -= 1888; int ng = t >> 4, kg = t & 15;
    d.nvalid = 64; d.src = p.wout + (size_t)l * 1024 * 1024 + (size_t)(kg * 64) * 1024 + ng * 64; d.ld = 1024;
    d.dst = p.Wout + (size_t)l * 1024 * 1024 + (size_t)(ng * 64) * 1024 + kg * 64; d.dld = 1024;
  } else if (t < 2272) {
    t -= 2144; int kv = t >> 6; t &= 63; int ng = t >> 5, kg = t & 31;
    const float* w = kv ? p.cvw1 : p.ckw1;
    d.nvalid = 64; d.src = w + (size_t)l * 2048 * 128 + (size_t)(kg * 64) * 128 + ng * 64; d.ld = 128;
    d.dst = p.W1t + ((size_t)(l * 2 + kv) * 128 + ng * 64) * 2048 + kg * 64; d.dld = 2048;
  } else {
    t -= 2272; int kv = t >> 1, kg = t & 1;
    const float* w = kv ? p.cvw2 : p.ckw2;
    d.nvalid = 64; d.src = w + (size_t)l * 128 * 64 + (size_t)(kg * 64) * 64; d.ld = 64;
    d.dst = p.W2t + ((size_t)(l * 2 + kv) * 64) * 128 + kg * 64; d.dld = 128;
  }
  return d;
}

DI void prep_weights(const Params& p_in, float* sm) {
  const Params p = launder(p_in);
  constexpr int TL = 2276;
  for (int idx = blockIdx.x; idx < 2 * TL; idx += 2 * gridDim.x) {
    const int idx2 = idx + gridDim.x;
    const bool hasb = idx2 < 2 * TL;
    const TDesc a = tile_desc(p, idx);
    const TDesc b = tile_desc(p, hasb ? idx2 : idx);
    tconv_pair(a, b, hasb, sm);
  }
}

DI void prep_misc(const Params& p_in) {
  const Params p = launder(p_in);
  const int gtid = blockIdx.x * 256 + tid_(), gsz = gridDim.x * 256;
  for (int i = gtid; i < 32768 * 8; i += gsz) {
    int tok = i >> 3, d = i & 7;
    float a = (float)p.pos[tok] * c_freq[d];
    double rev = (double)a * 0.15915494309189535;
    rev -= floor(rev);
    float fr = (float)rev;
    p.rope[tok * 16 + d] = __builtin_amdgcn_cosf(fr);
    p.rope[tok * 16 + 8 + d] = __builtin_amdgcn_sinf(fr);
  }
  {
    const int lane = tid_() & 63;
    const int gw = blockIdx.x * 4 + (tid_() >> 6);
    if (gw < 512) {
      const int l = gw >> 8, kv = (gw >> 7) & 1, n = gw & 127;
      const float* w = (kv ? p.cvw1 : p.ckw1) + (size_t)l * 2048 * 128 + n;
      const float* cp = p.cmp_pos + l * 2048;
      float s = 0.f;
#pragma unroll 8
      for (int i = 0; i < 32; ++i) { const int k = lane + 64 * i; s += cp[k] * w[(size_t)k * 128]; }
#pragma unroll
      for (int o = 32; o >= 1; o >>= 1) s += __shfl_xor(s, o);
      if (lane == 0) p.bias1[gw] = s;
    }
  }
}

DI void rmsnorm_rows(const float* __restrict__ xin, const float* __restrict__ g, u16* __restrict__ xb) {
  const int lane = tid_() & 63, wid = tid_() >> 6;
  for (int row = (blockIdx.x * 4 + wid) * 2; row < 32768; row += gridDim.x * 8) {
    const float4* xr0 = (const float4*)(xin + (size_t)row * 1024);
    const float4* xr1 = xr0 + 256;
    float4 v0[4], v1[4];
#pragma unroll
    for (int i = 0; i < 4; ++i) { v0[i] = xr0[lane + i * 64]; v1[i] = xr1[lane + i * 64]; }
    float s0 = 0.f, s1 = 0.f;
#pragma unroll
    for (int i = 0; i < 4; ++i) {
      s0 += v0[i].x * v0[i].x + v0[i].y * v0[i].y + v0[i].z * v0[i].z + v0[i].w * v0[i].w;
      s1 += v1[i].x * v1[i].x + v1[i].y * v1[i].y + v1[i].z * v1[i].z + v1[i].w * v1[i].w;
    }
#pragma unroll
    for (int o = 32; o >= 1; o >>= 1) { s0 += __shfl_xor(s0, o); s1 += __shfl_xor(s1, o); }
    const float r0 = rsqrtf(s0 * (1.f / 1024.f) + 1e-6f), r1 = rsqrtf(s1 * (1.f / 1024.f) + 1e-6f);
#pragma unroll
    for (int i = 0; i < 4; ++i) {
      const float4 gg = ((const float4*)g)[lane + i * 64];
      uint2 o; o.x = pack2(v0[i].x * r0 * gg.x, v0[i].y * r0 * gg.y); o.y = pack2(v0[i].z * r0 * gg.z, v0[i].w * r0 * gg.w);
      *(uint2*)(xb + (size_t)row * 1024 + (lane + i * 64) * 4) = o;
      uint2 q; q.x = pack2(v1[i].x * r1 * gg.x, v1[i].y * r1 * gg.y); q.y = pack2(v1[i].z * r1 * gg.z, v1[i].w * r1 * gg.w);
      *(uint2*)(xb + (size_t)(row + 1) * 1024 + (lane + i * 64) * 4) = q;
    }
  }
}

#define WAITVL(n) asm volatile("s_waitcnt vmcnt(" #n ") lgkmcnt(0)" ::: "memory")
template <int MT, int NT, int NS, bool SWAP>
DI void gemm_loop(const u16* __restrict__ A, int lda, const u16* __restrict__ Bt, int ldb, int K,
                  f32x16 (&acc)[MT][NT], u16* sm16) {
  constexpr int BN = 64 * NT, BM = 64 * MT;
  constexpr int A_BYTES = BM * 64, B_BYTES = BN * 64, STAGE = A_BYTES + B_BYTES;
  constexpr int NLD = MT + NT;
  char* sm = (char*)sm16;
  const int tid = tid_(), lane = tid & 63, wid = tid >> 6, wm = wid >> 1, wn = wid & 1;
  const int lr = lane & 31, lh = lane >> 5;
  const int row0 = tid >> 2, kc0 = ((tid & 3) ^ ((row0 >> 2) & 3)) * 8;
  const u16* ag = A + (size_t)row0 * lda + kc0;
  const u16* bg = Bt + (size_t)row0 * ldb + kc0;
  const size_t a64 = (size_t)64 * lda, b64 = (size_t)64 * ldb;
  const int nk = K >> 5;
  auto issue = [&](int kt) {
    char* d = sm + (kt % NS) * STAGE + tid * 16;
    const int ko = kt * 32;
#pragma unroll
    for (int i = 0; i < MT; ++i)
      __builtin_amdgcn_global_load_lds((const unsigned*)(ag + i * a64 + ko), (unsigned*)(d + i * 4096), 16, 0, 0);
#pragma unroll
    for (int i = 0; i < NT; ++i)
      __builtin_amdgcn_global_load_lds((const unsigned*)(bg + i * b64 + ko), (unsigned*)(d + A_BYTES + i * 4096), 16, 0, 0);
  };
  auto wait_bar = [&](int after) {
    if (NLD == 4) { if (after >= 2) WAITVL(8); else if (after == 1) WAITVL(4); else WAITVL(0); }
    else if (NLD == 3) { if (after >= 2) WAITVL(6); else if (after == 1) WAITVL(3); else WAITVL(0); }
    else { if (after >= 2) WAITVL(12); else if (after == 1) WAITVL(6); else WAITVL(0); }
    __builtin_amdgcn_s_barrier();
    asm volatile("" ::: "memory");
  };
  const int sw = (lr >> 2) & 3;
  const int aoff = (wm * 32 * MT + lr) * 64, boff = A_BYTES + (wn * 32 * NT + lr) * 64;
  const int c0 = ((0 + lh) ^ sw) * 16, c1 = ((2 + lh) ^ sw) * 16;
  auto ldk = [&](int kt, int ks, bf16x8 (&af)[MT], bf16x8 (&bfv)[NT]) {
    const char* sb = sm + (kt % NS) * STAGE + (ks ? c1 : c0);
#pragma unroll
    for (int mi = 0; mi < MT; ++mi) af[mi] = *(const bf16x8*)(sb + aoff + mi * 2048);
#pragma unroll
    for (int ni = 0; ni < NT; ++ni) bfv[ni] = *(const bf16x8*)(sb + boff + ni * 2048);
  };
  auto mmak = [&](const bf16x8 (&af)[MT], const bf16x8 (&bfv)[NT]) {
#pragma unroll
    for (int mi = 0; mi < MT; ++mi)
#pragma unroll
      for (int ni = 0; ni < NT; ++ni)
        acc[mi][ni] = SWAP ? mfma32(bfv[ni], af[mi], acc[mi][ni]) : mfma32(af[mi], bfv[ni], acc[mi][ni]);
  };
  __syncthreads();
#pragma unroll
  for (int i = 0; i < NS - 1; ++i) if (i < nk) issue(i);
  { const int after = nk - 1 < NS - 2 ? nk - 1 : NS - 2; wait_bar(after); }
  if (nk > NS - 1) issue(NS - 1);
  bf16x8 fa_a[MT], fa_b[NT], fb_a[MT], fb_b[NT];
  ldk(0, 0, fa_a, fa_b);
  for (int kt = 0; kt < nk; ++kt) {
    ldk(kt, 1, fb_a, fb_b);
    mmak(fa_a, fa_b);
    if (kt + 1 < nk) {
      { const int r = nk - 2 - kt; wait_bar(r < NS - 2 ? r : NS - 2); }
      if (kt + NS < nk) issue(kt + NS);
      ldk(kt + 1, 0, fa_a, fa_b);
    }
    mmak(fb_a, fb_b);
  }
}

struct BlkMap { int x, j, per; };
DI bool tile_map(const BlkMap bm, int k, int MTL, int NTL, int& mt, int& nt) {
  const int x = bm.x, j = bm.j, per = bm.per;
  const int u = j + per * k;
  if (u >= (MTL >> 3) * NTL) return false;
  const int q = u / (8 * NTL), rem = u - q * (8 * NTL);
  nt = rem >> 3; mt = (x + 8 * q) * 8 + (rem & 7);
  return true;
}


template <int MT>
DI void tile_store_bf16(const f32x16 (&acc)[MT][2], u16* __restrict__ dst  , int ld, char* sm) {
  const int tid = tid_(), lane = tid & 63, wid = tid >> 6, wm = wid >> 1, wn = wid & 1;
  const int lr = lane & 31, lh = lane >> 5;
  __syncthreads();
#pragma unroll
  for (int mi = 0; mi < MT; ++mi) {
    char* rowp = sm + (wm * 32 * MT + mi * 32 + lr) * 272 + (wn * 64 + 4 * lh) * 2;
#pragma unroll
    for (int ni = 0; ni < 2; ++ni)
#pragma unroll
      for (int i = 0; i < 4; ++i) {
        uint2 o; o.x = pack2(acc[mi][ni][i * 4 + 0], acc[mi][ni][i * 4 + 1]);
        o.y = pack2(acc[mi][ni][i * 4 + 2], acc[mi][ni][i * 4 + 3]);
        *(uint2*)(rowp + (ni * 32 + 8 * i) * 2) = o;
      }
  }
  __syncthreads();
  const int c = tid & 15, r0 = tid >> 4;
#pragma unroll
  for (int j = 0; j < 4 * MT; ++j) {
    const int row = r0 + 16 * j;
    typedef __attribute__((ext_vector_type(4))) unsigned u32x4s;
    const u32x4s v = *(const u32x4s*)(sm + row * 272 + c * 16);
    __builtin_nontemporal_store(v, (u32x4s*)(dst + (size_t)row * ld + c * 8));
  }
}

DI void phase_inproj(const Params& p_in, const BlkMap bm, int l, u16* sm) {
  const Params p = launder(p_in);
  const int tid = tid_(), lane = tid & 63, wid = tid >> 6, wm = wid >> 1, wn = wid & 1;
  const int lr = lane & 31, lh = lane >> 5;
  const u16* Wt = p.Wt1 + (size_t)l * NP * 1024;
  for (int k = 0;; ++k) {
    int mt, nt;
    if (!tile_map(bm, k, 128, 28, mt, nt)) break;
    const int m0 = mt * 256, n0 = nt * 128;
    f32x16 acc[4][2];
#pragma unroll
    for (int a = 0; a < 4; ++a)
#pragma unroll
      for (int b = 0; b < 2; ++b) acc[a][b] = zero16();
    gemm_loop<4, 2, 3, true>(p.xb + (size_t)m0 * 1024, 1024, Wt + (size_t)n0 * 1024, 1024, 1024, acc, sm);
    const int cg_ = (n0 + wn * 64) >> 6;
    const float* gain = p.qna; bool has = true, isq = false;
    if (cg_ < 6) { gain = p.qna; isq = true; }
    else if (cg_ < 12) gain = p.kna;
    else if (cg_ >= 24 && cg_ < 28) { gain = p.qnb; isq = true; }
    else if (cg_ == 28 || cg_ == 30 || cg_ == 32) gain = p.knb;
    else if (cg_ >= 38 && cg_ < 42) { gain = p.qnc; isq = true; }
    else if (cg_ >= 42 && cg_ < 46) gain = p.knc;
    else has = false;
    if (has) {
      gain += l * 64;
      float4 g4[2][4], c4[4], s4[4];
#pragma unroll
      for (int ni = 0; ni < 2; ++ni)
#pragma unroll
        for (int i = 0; i < 4; ++i) g4[ni][i] = *(const float4*)(gain + ni * 32 + 4 * lh + 8 * i);
#pragma unroll
      for (int mi = 0; mi < 4; ++mi) {
        const int token = m0 + wm * 128 + mi * 32 + lr;
        c4[mi] = *(const float4*)(p.rope + (size_t)token * 16 + 4 * lh);
        s4[mi] = *(const float4*)(p.rope + (size_t)token * 16 + 8 + 4 * lh);
      }
      const float qs = isq ? 0.18033688011112042f : 1.f;
#pragma unroll
      for (int mi = 0; mi < 4; ++mi) {
        float ss = 0.f;
#pragma unroll
        for (int ni = 0; ni < 2; ++ni)
#pragma unroll
          for (int r = 0; r < 16; ++r) ss += acc[mi][ni][r] * acc[mi][ni][r];
        ss = xor32_sum(ss);
        const float rs = rsqrtf(ss * (1.f / 64.f) + 1e-6f);
#pragma unroll
        for (int ni = 0; ni < 2; ++ni)
#pragma unroll
          for (int i = 0; i < 4; ++i) {
            acc[mi][ni][i * 4 + 0] *= rs * g4[ni][i].x; acc[mi][ni][i * 4 + 1] *= rs * g4[ni][i].y;
            acc[mi][ni][i * 4 + 2] *= rs * g4[ni][i].z; acc[mi][ni][i * 4 + 3] *= rs * g4[ni][i].w;
          }
        const float cc[4] = {c4[mi].x, c4[mi].y, c4[mi].z, c4[mi].w}, sn[4] = {s4[mi].x, s4[mi].y, s4[mi].z, s4[mi].w};
#pragma unroll
        for (int j = 0; j < 4; ++j) {
          const float x1 = acc[mi][0][j], x2 = acc[mi][0][4 + j];
          acc[mi][0][j] = x1 * cc[j] - x2 * sn[j];
          acc[mi][0][4 + j] = x2 * cc[j] + x1 * sn[j];
        }
        if (isq) {
#pragma unroll
          for (int ni = 0; ni < 2; ++ni)
#pragma unroll
            for (int r = 0; r < 16; ++r) acc[mi][ni][r] *= qs;
        }
      }
    }
    tile_store_bf16<4>(acc, p.proj + (size_t)m0 * NP + n0, NP, (char*)sm);
  }
}

DI void compress_item(const Params& p, int l, int kv, int rt, char* smraw) {
  const int tid = tid_(), lane = tid & 63, w = tid >> 6, lr = lane & 31, lh = lane >> 5;
  const u16* W1 = p.W1t + (size_t)((l * 2 + kv) * 128 + w * 32 + lr) * 2048 + lh * 8;
  const int col = kv ? C_VCB : C_KCB;
  const int R = rt * 32 + lr;
  f32x16 H = zero16();
#pragma unroll 1
  for (int ks0 = 0; ks0 < 128; ks0 += 8) {
    bf16x8 af[8], wf[8];
#pragma unroll
    for (int u = 0; u < 8; ++u) {
      const int ks = ks0 + u, tt = ks >> 2, d = (ks & 3) * 16 + lh * 8;
      int tokrow = R * 16 + tt; tokrow = tokrow > 32767 ? 32767 : tokrow;
      af[u] = *(const bf16x8*)(p.proj + (size_t)tokrow * NP + col + d);
      wf[u] = *(const bf16x8*)(W1 + ks * 16);
    }
#pragma unroll
    for (int u = 0; u < 8; ++u) H = mfma32(wf[u], af[u], H);
  }
  {
    const float* b1 = p.bias1 + (l * 2 + kv) * 128 + w * 32 + 4 * lh;
    unsigned hw[8];
    float4 bb4[4];
#pragma unroll
    for (int i = 0; i < 4; ++i) bb4[i] = *(const float4*)(b1 + 8 * i);
#pragma unroll
    for (int i = 0; i < 4; ++i) {
      const float4 bb = bb4[i];
      hw[i * 2] = pack2(siluf_(H[i * 4] + bb.x), siluf_(H[i * 4 + 1] + bb.y));
      hw[i * 2 + 1] = pack2(siluf_(H[i * 4 + 2] + bb.z), siluf_(H[i * 4 + 3] + bb.w));
    }
    uint4* hs = (uint4*)smraw;
    hs[(w * 2 + 0) * 64 + lane] = make_uint4(hw[0], hw[1], hw[2], hw[3]);
    hs[(w * 2 + 1) * 64 + lane] = make_uint4(hw[4], hw[5], hw[6], hw[7]);
  }
  __syncthreads();
  if (w < 2) {
    const int dt = w;
    const u16* W2 = p.W2t + (size_t)((l * 2 + kv) * 64 + dt * 32 + lr) * 128 + 4 * lh;
    const uint4* hs = (const uint4*)smraw;
    f32x16 o2 = zero16();
    uint2 wlo[8], whi[8];
#pragma unroll
    for (int ht = 0; ht < 4; ++ht)
#pragma unroll
      for (int s = 0; s < 2; ++s) {
        const u16* wp = W2 + ht * 32 + 16 * s;
        wlo[ht * 2 + s] = *(const uint2*)wp; whi[ht * 2 + s] = *(const uint2*)(wp + 8);
      }
#pragma unroll
    for (int ht = 0; ht < 4; ++ht)
#pragma unroll
      for (int s = 0; s < 2; ++s) {
        const uint2 lo = wlo[ht * 2 + s], hi = whi[ht * 2 + s];
        union { uint4 u; bf16x8 v; } cw, ch; cw.u = make_uint4(lo.x, lo.y, hi.x, hi.y);
        ch.u = hs[(ht * 2 + s) * 64 + lane];
        o2 = kv ? mfma32(ch.v, cw.v, o2) : mfma32(cw.v, ch.v, o2);
      }
    if (kv == 0) {
#pragma unroll
      for (int i = 0; i < 4; ++i) {
        uint2 o; o.x = pack2(o2[i * 4], o2[i * 4 + 1]); o.y = pack2(o2[i * 4 + 2], o2[i * 4 + 3]);
        *(uint2*)(p.kc + (size_t)R * 64 + dt * 32 + 4 * lh + 8 * i) = o;
      }
    } else {
      uint4 a, b;
      a.x = pack2(o2[0], o2[1]); a.y = pack2(o2[2], o2[3]); a.z = pack2(o2[4], o2[5]); a.w = pack2(o2[6], o2[7]);
      b.x = pack2(o2[8], o2[9]); b.y = pack2(o2[10], o2[11]); b.z = pack2(o2[12], o2[13]); b.w = pack2(o2[14], o2[15]);
      u16* dst = p.vcF + (size_t)(rt * 2 + dt) * 1024 + lane * 16;
      *(uint4*)dst = a; *(uint4*)(dst + 8) = b;
    }
  }
  __syncthreads();
}

DI void relayout_decode(const Params& p, int idx, int lr, u16*& dstbase, int& col, int& tokbase, int& tstride) {
  if (idx < 36864) {
    const int which = idx / 12288, id = idx % 12288;
    const int dt = id & 1, bh = id >> 8, b = bh / 6, h = bh % 6;
    col = C_VA + h * 64 + dt * 32 + lr;
    if (which == 0) { const int kt = (id >> 1) & 127; tokbase = b * 4096 + kt * 32; tstride = 1; dstbase = p.VA1; }
    else if (which == 1) { const int lt = (id >> 1) & 31, r4 = (id >> 6) & 3; tokbase = b * 4096 + lt * 128 + r4; tstride = 4; dstbase = p.VA4; }
    else { const int lt = (id >> 1) & 7, r = (id >> 4) & 15; tokbase = b * 4096 + lt * 512 + r; tstride = 16; dstbase = p.VA16; }
    dstbase += (size_t)id * 1024;
  } else if (idx < 40960) {
    const int which = (idx - 36864) >> 11, id = (idx - 36864) & 2047;
    const int dt = id & 1, kt = (id >> 1) & 127, b = id >> 8;
    col = (which ? C_VWB : C_VSB) + dt * 32 + lr; tokbase = b * 4096 + kt * 32; tstride = 1;
    dstbase = (which ? p.VW : p.VS) + (size_t)id * 1024;
  } else {
    const int id = idx - 40960;
    const int dt = id & 1, kt = (id >> 1) & 127, bh = id >> 8, b = bh >> 2, h = bh & 3;
    col = C_VC + h * 64 + dt * 32 + lr; tokbase = b * 4096 + kt * 32; tstride = 1;
    dstbase = p.VC + (size_t)id * 1024;
  }
}
DI void relayout4(const Params& p, int idx0) {
  const int lane = tid_() & 63, lr = lane & 31, lh = lane >> 5;
  u16* dst[4]; unsigned w[4][8];
#pragma unroll
  for (int t = 0; t < 4; ++t) {
    int col, tokbase, tstride;
    relayout_decode(p, idx0 + t, lr, dst[t], col, tokbase, tstride);
#pragma unroll
    for (int i = 0; i < 4; ++i)
#pragma unroll
      for (int jp = 0; jp < 2; ++jp) {
        const int kk = 4 * lh + 8 * i + 2 * jp;
        const unsigned oa = (unsigned)((tokbase + kk * tstride) * NP + col), ob = (unsigned)((tokbase + (kk + 1) * tstride) * NP + col);
        const u16 a = p.proj[oa];
        const u16 b = p.proj[ob];
        w[t][i * 2 + jp] = (unsigned)a | ((unsigned)b << 16);
      }
  }
#pragma unroll
  for (int t = 0; t < 4; ++t) {
    u16* d = dst[t] + lane * 16;
    *(uint4*)d = make_uint4(w[t][0], w[t][1], w[t][2], w[t][3]);
    *(uint4*)(d + 8) = make_uint4(w[t][4], w[t][5], w[t][6], w[t][7]);
  }
}

DI void kmean_item(const Params& p, int idx) {
  const int lane = tid_() & 63;
  const int blk = idx & 15, bh = idx >> 4, b = bh >> 2, h = bh & 3;
  const unsigned o0 = (unsigned)((b * 4096 + blk * 256) * NP + C_KC + h * 64 + lane);
  float s0 = 0.f, s1 = 0.f, s2 = 0.f, s3 = 0.f;
#pragma unroll 1
  for (int i = 0; i < 256; i += 16) {
    u16 v[16];
#pragma unroll
    for (int u = 0; u < 16; ++u) v[u] = p.proj[o0 + (unsigned)((i + u) * NP)];
#pragma unroll
    for (int u = 0; u < 16; u += 4) { s0 += bf2f(v[u]); s1 += bf2f(v[u + 1]); s2 += bf2f(v[u + 2]); s3 += bf2f(v[u + 3]); }
  }
  p.kmean[(size_t)idx * 64 + lane] = f2bf(((s0 + s1) + (s2 + s3)) * (1.f / 256.f));
}

DI void phase_mid(const Params& p_in, int l, char* smraw) {
  const Params p = launder(p_in);
  const int wid = tid_() >> 6;
  constexpr int N_CMP = 128, N_KM = 128, N_REL = 3072;
  for (int it = blockIdx.x; it < N_CMP + N_KM + N_REL; it += gridDim.x) {
    if (it < N_CMP) compress_item(p, l, it >> 6, it & 63, smraw);
    else if (it < N_CMP + N_KM) kmean_item(p, (it - N_CMP) * 4 + wid);
    else relayout4(p, (it - N_CMP - N_KM) * 16 + wid * 4);
  }
}

DI void attn_loadk(const u16* __restrict__ kp, bf16x8 (&kf)[4]) {
#pragma unroll
  for (int ks = 0; ks < 4; ++ks) kf[ks] = *(const bf16x8*)(kp + ks * 16);
}

typedef __attribute__((ext_vector_type(2))) float f32x2;
DI float fmax_nc(float a, float b) { return __builtin_amdgcn_fmed3f(a, b, __builtin_inff()); }
DI void attn_core(const bf16x8 (&qf)[4], const bf16x8 (&kf)[4], const bf16x8 (&vf)[2][2], const int lo, const int hi,
                   float& m, float& l, f32x16 (&O)[2], const int lh) {
  f32x16 sc = zero16();
#pragma unroll
  for (int ks = 0; ks < 4; ++ks) sc = mfma32(kf[ks], qf[ks], sc);
  const bool empty = hi < lo;
  const bool partial = !empty && (lo > 0 || hi < 31);
  if (__builtin_amdgcn_ballot_w64(partial) != 0ull) {
    const unsigned span = (unsigned)(hi - lo);
    const int base = 4 * lh - lo;
#pragma unroll
    for (int r = 0; r < 16; ++r) {
      const unsigned rel = (unsigned)(base + 8 * (r >> 2) + (r & 3));
      sc[r] = (rel <= span) ? sc[r] : -1e30f;
    }
  }
  float mx = fmax_nc(fmax_nc(fmax_nc(sc[0], sc[1]), fmax_nc(sc[2], sc[3])), fmax_nc(fmax_nc(sc[4], sc[5]), fmax_nc(sc[6], sc[7])));
  mx = fmax_nc(mx, fmax_nc(fmax_nc(fmax_nc(sc[8], sc[9]), fmax_nc(sc[10], sc[11])), fmax_nc(fmax_nc(sc[12], sc[13]), fmax_nc(sc[14], sc[15]))));
  mx = empty ? -1e30f : mx;
  mx = xor32_max(mx);
  if (__builtin_amdgcn_ballot_w64(mx > m + 16.f) != 0ull) {
    const float mn = (mx > m + 16.f) ? mx : m;
    const float alpha = __builtin_amdgcn_exp2f(m - mn);
    l *= alpha; m = mn;
#pragma unroll
    for (int dt = 0; dt < 2; ++dt)
#pragma unroll
      for (int r = 0; r < 16; ++r) O[dt][r] *= alpha;
  }
  const float meff = empty ? 3e38f : m;
  const f32x2 m2 = {meff, meff};
  f32x2 ps2 = {0.f, 0.f}; float pv[16];
#pragma unroll
  for (int r = 0; r < 16; r += 2) {
    const f32x2 s2 = {sc[r], sc[r + 1]};
    const f32x2 d2 = s2 - m2;
    const f32x2 e2 = {__builtin_amdgcn_exp2f(d2.x), __builtin_amdgcn_exp2f(d2.y)};
    pv[r] = e2.x; pv[r + 1] = e2.y; ps2 += e2;
  }
  const float ps = xor32_sum(ps2.x + ps2.y);
  l += ps;
  bf16x8 pb[2];
#pragma unroll
  for (int s = 0; s < 2; ++s)
#pragma unroll
    for (int j = 0; j < 8; ++j) pb[s][j] = (short)f2bf(pv[8 * s + j]);
#pragma unroll
  for (int dt = 0; dt < 2; ++dt)
#pragma unroll
    for (int s = 0; s < 2; ++s) O[dt] = mfma32(vf[dt][s], pb[s], O[dt]);
}

DI void attn_compute(const bf16x8 (&qf)[4], const bf16x8 (&kf)[4], const u16* __restrict__ vp, const int lo, const int hi,
                     float& m, float& l, f32x16 (&O)[2], const int lh) {
  bf16x8 vf[2][2];
#pragma unroll
  for (int dt = 0; dt < 2; ++dt)
#pragma unroll
    for (int s = 0; s < 2; ++s) vf[dt][s] = *(const bf16x8*)(vp + dt * 1024 + s * 8);
  attn_core(qf, kf, vf, lo, hi, m, l, O, lh);
}

template <class NF, class DF, class BF>
DI void attn_run_shared(const bf16x8 (&qf)[4], NF next, DF desc, BF band, float& m, float& l, f32x16 (&O)[2], char* lds) {
  const int tid = tid_(), lane = tid & 63, lr = lane & 31, lh = lane >> 5;
  int cur = next(-1);
  if (cur < 0) return;
  const int krow = tid >> 3, kc = tid & 7;
  const int kdst = krow * 128 + ((kc ^ ((krow >> 1) & 7)) * 16);
  const int vdst = 4096 + ((((tid >> 7) * 2 + (tid & 1)) * 64 + ((tid >> 1) & 63)) * 16);
  const int ksw = (lr >> 1) & 7;
  uint4 kreg, vreg;
  {
    const u16 *kb, *vt; int kst; desc(cur, kb, kst, vt);
    kreg = *(const uint4*)(kb + (size_t)krow * kst + kc * 8);
    vreg = *(const uint4*)(vt + tid * 8);
  }
  int st = 0;
#pragma unroll 1
  while (true) {
    char* buf = lds + st * 8192;
    *(uint4*)(buf + kdst) = kreg;
    *(uint4*)(buf + vdst) = vreg;
    __syncthreads();
    const int nx = next(cur);
    {
      const u16 *kb, *vt; int kst; desc(nx >= 0 ? nx : cur, kb, kst, vt);
      kreg = *(const uint4*)(kb + (size_t)krow * kst + kc * 8);
      vreg = *(const uint4*)(vt + tid * 8);
    }
    bf16x8 kf[4], vf[2][2];
#pragma unroll
    for (int ks = 0; ks < 4; ++ks) kf[ks] = *(const bf16x8*)(buf + lr * 128 + (((ks * 2 + lh) ^ ksw) * 16));
#pragma unroll
    for (int dt = 0; dt < 2; ++dt)
#pragma unroll
      for (int s2 = 0; s2 < 2; ++s2) vf[dt][s2] = *(const bf16x8*)(buf + 4096 + ((dt * 2 + s2) * 64 + lane) * 16);
    { int lo, hi; band(cur, lo, hi); attn_core(qf, kf, vf, lo, hi, m, l, O, lh); }
    if (nx < 0) break;
    st ^= 1; cur = nx;
  }
  __syncthreads();
}

DI void attn_loadv(const u16* __restrict__ vp, bf16x8 (&vf)[2][2]) {
#pragma unroll
  for (int dt = 0; dt < 2; ++dt)
#pragma unroll
    for (int s = 0; s < 2; ++s) vf[dt][s] = *(const bf16x8*)(vp + dt * 1024 + s * 8);
}
template <class NF, class DF, class BF>
DI void attn_run(const bf16x8 (&qf)[4], NF next, DF desc, BF band, float& m, float& l, f32x16 (&O)[2], const int lh) {
  int cur = next(-1);
  if (cur < 0) return;
  bf16x8 ka[4], kb[4], va[2][2], vb[2][2];
  { const u16 *kp, *vp; desc(cur, kp, vp); attn_loadk(kp, ka); attn_loadv(vp, va); }
#pragma unroll 1
  while (true) {
    const int nx = next(cur);
    { const u16 *kp, *vp; desc(nx >= 0 ? nx : cur, kp, vp); attn_loadk(kp, kb); attn_loadv(vp, vb); }
    { int lo, hi; band(cur, lo, hi); attn_core(qf, ka, va, lo, hi, m, l, O, lh); }
    if (nx < 0) break;
    const int nn = next(nx);
    { const u16 *kp, *vp; desc(nn >= 0 ? nn : nx, kp, vp); attn_loadk(kp, ka); attn_loadv(vp, va); }
    { int lo, hi; band(nx, lo, hi); attn_core(qf, kb, vb, lo, hi, m, l, O, lh); }
    if (nn < 0) break;
    cur = nn;
  }
}

template <class NF, class BF>
DI void attn_run_shared2(const bf16x8 (&qf)[4], NF next, const u16* __restrict__ kbase, const u16* __restrict__ vbase,
                         const int ntile_max, BF band2, float& m, float& l, f32x16 (&O)[2], char* lds) {
  const int tid = tid_(), lane = tid & 63, lr = lane & 31, lh = lane >> 5;
  int cur = next(-1);
  if (cur < 0) return;
  const int krow = tid >> 3, kc = tid & 7;
  const int kdst = krow * 128 + ((kc ^ ((krow >> 1) & 7)) * 16);
  const int vdst = 4096 + ((((tid >> 7) * 2 + (tid & 1)) * 64 + ((tid >> 1) & 63)) * 16);
  const int ksw = (lr >> 1) & 7;
  uint4 k0, k1, v0, v1;
  auto fetch = [&](int J) {
    const u16* kp = kbase + ((size_t)(64 * J + krow)) * NP + kc * 8;
    k0 = *(const uint4*)kp; k1 = *(const uint4*)(kp + (size_t)32 * NP);
    const u16* vp = vbase + (size_t)(2 * J) * 2048 + tid * 8;
    v0 = *(const uint4*)vp; v1 = *(const uint4*)(vp + 2048);
  };
  fetch(cur);
  int st = 0;
#pragma unroll 1
  while (true) {
    char* buf = lds + st * 16384;
    *(uint4*)(buf + kdst) = k0; *(uint4*)(buf + vdst) = v0;
    *(uint4*)(buf + 8192 + kdst) = k1; *(uint4*)(buf + 8192 + vdst) = v1;
    __syncthreads();
    const int nx = next(cur);
    fetch(nx >= 0 ? nx : cur);
#pragma unroll 1
    for (int half = 0; half < 2; ++half) {
      if (2 * cur + half > ntile_max) break;
      const char* tb = buf + half * 8192;
      bf16x8 kf[4], vf[2][2];
#pragma unroll
      for (int ks = 0; ks < 4; ++ks) kf[ks] = *(const bf16x8*)(tb + lr * 128 + (((ks * 2 + lh) ^ ksw) * 16));
#pragma unroll
      for (int dt = 0; dt < 2; ++dt)
#pragma unroll
        for (int s2 = 0; s2 < 2; ++s2) vf[dt][s2] = *(const bf16x8*)(tb + 4096 + ((dt * 2 + s2) * 64 + lane) * 16);
      int lo, hi; band2(cur, half, lo, hi);
      attn_core(qf, kf, vf, lo, hi, m, l, O, lh);
    }
    if (nx < 0) break;
    st ^= 1; cur = nx;
  }
  __syncthreads();
}
#define M_INIT (-1e4f)
#define BIG 100000

DI void store_gated(const u16* zrow  , u16* orow  , const f32x16 (&O)[2]) {
  uint2 z[2][4];
#pragma unroll
  for (int dt = 0; dt < 2; ++dt)
#pragma unroll
    for (int i = 0; i < 4; ++i) z[dt][i] = *(const uint2*)(zrow + dt * 32 + 8 * i);
#pragma unroll
  for (int dt = 0; dt < 2; ++dt)
#pragma unroll
    for (int i = 0; i < 4; ++i) {
      const uint2 zz = z[dt][i];
      const float z0 = bf2f((u16)(zz.x & 0xffff)), z1 = bf2f((u16)(zz.x >> 16)), z2 = bf2f((u16)(zz.y & 0xffff)), z3 = bf2f((u16)(zz.y >> 16));
      uint2 o; o.x = pack2(O[dt][i * 4] * siluf_(z0), O[dt][i * 4 + 1] * siluf_(z1));
      o.y = pack2(O[dt][i * 4 + 2] * siluf_(z2), O[dt][i * 4 + 3] * siluf_(z3));
      *(uint2*)(orow + dt * 32 + 8 * i) = o;
    }
}

DI void mixA_far_item(const Params& p, int b, int h, int T0, int r) {
  const int lane = tid_() & 63, lr = lane & 31, lh = lane >> 5;
  const int tq = T0 + r + 16 * lr;
  const size_t rowq = (size_t)b * 4096 + tq;
  const u16* proj = p.proj;
  bf16x8 qf[4];
  {
    const u16* qp = proj + rowq * NP + C_QA + h * 64 + lh * 8;
#pragma unroll
    for (int ks = 0; ks < 4; ++ks) qf[ks] = *(const bf16x8*)(qp + ks * 16);
  }
  float m = M_INIT, l = 0.f; f32x16 O[2]; O[0] = zero16(); O[1] = zero16();
  const int kcol = C_KA + h * 64 + lh * 8;
  {
    const size_t bh = (size_t)(b * 6 + h);
    auto lbase_of = [&](int id) { return (T0 >> 4) - 128 + 32 * (4 - id); };
    auto next = [&](int prev) {
      int id = prev + 1;
      while (id < 5 && lbase_of(id) < 0) ++id;
      return id < 5 ? id : -1;
    };
    auto desc = [&](int id, const u16*& kp, const u16*& vp) {
      const int lbase = lbase_of(id);
      const int tk = (lbase + lr) * 16 + r;
      vp = p.VA16 + (((bh * 16 + r) * 8 + (size_t)(lbase >> 5)) * 2) * 1024 + lane * 16;
      kp = proj + ((size_t)b * 4096 + tk) * NP + kcol;
    };
    auto band = [&](int id, int& lo, int& hi) { hi = (T0 >> 4) + lr - lbase_of(id); lo = hi - 128; };
    attn_run(qf, next, desc, band, m, l, O, lh);
  }
  if (lh == 0) { float2 ml; ml.x = m; ml.y = l; *(float2*)(p.mlA + (rowq * 6 + h) * 2) = ml; }
  u16* orow = p.obuf + rowq * 896 + h * 64 + 4 * lh;
#pragma unroll
  for (int dt = 0; dt < 2; ++dt)
#pragma unroll
    for (int i = 0; i < 4; ++i) {
      uint2 o; o.x = pack2(O[dt][i * 4], O[dt][i * 4 + 1]); o.y = pack2(O[dt][i * 4 + 2], O[dt][i * 4 + 3]);
      *(uint2*)(orow + dt * 32 + 8 * i) = o;
    }
}

DI void mixA_item(const Params& p, int b, int h, int T0, int r4) {
  const int lane = tid_() & 63, lr = lane & 31, lh = lane >> 5;
  const int tq = T0 + r4 + 4 * lr;
  const size_t rowq = (size_t)b * 4096 + tq;
  const u16* proj = p.proj;
  bf16x8 qf[4];
  {
    const u16* qp = proj + rowq * NP + C_QA + h * 64 + lh * 8;
#pragma unroll
    for (int ks = 0; ks < 4; ++ks) qf[ks] = *(const bf16x8*)(qp + ks * 16);
  }
  float m, l; f32x16 O[2];
  {
    const float2 ml = *(const float2*)(p.mlA + (rowq * 6 + h) * 2);
    m = ml.x; l = ml.y;
    const u16* orow = p.obuf + rowq * 896 + h * 64 + 4 * lh;
#pragma unroll
    for (int dt = 0; dt < 2; ++dt)
#pragma unroll
      for (int i = 0; i < 4; ++i) {
        const uint2 o = *(const uint2*)(orow + dt * 32 + 8 * i);
        O[dt][i * 4] = bf2f((u16)(o.x & 0xffff)); O[dt][i * 4 + 1] = bf2f((u16)(o.x >> 16));
        O[dt][i * 4 + 2] = bf2f((u16)(o.y & 0xffff)); O[dt][i * 4 + 3] = bf2f((u16)(o.y >> 16));
      }
  }
  const int kcol = C_KA + h * 64 + lh * 8;
  {
    const size_t bh = (size_t)(b * 6 + h);
    auto lbase_of = [&](int id) { return id < 5 ? (T0 >> 2) - 128 + 32 * id : T0 - 128 + 32 * (id - 5); };
    auto next = [&](int prev) {
      int id = prev + 1;
      while (id < 13 && lbase_of(id) < 0) ++id;
      return id < 13 ? id : -1;
    };
    auto desc = [&](int id, const u16*& kp, const u16*& vp) {
      const int lbase = lbase_of(id);
      const size_t lt = (size_t)(lbase >> 5);
      int tk;
      if (id < 5) { tk = (lbase + lr) * 4 + r4; vp = p.VA4 + (((bh * 4 + r4) * 32 + lt) * 2) * 1024 + lane * 16; }
      else { tk = lbase + lr; vp = p.VA1 + ((bh * 128 + lt) * 2) * 1024 + lane * 16; }
      kp = proj + ((size_t)b * 4096 + tk) * NP + kcol;
    };
    auto band = [&](int id, int& lo, int& hi) {
      hi = (id < 5 ? (T0 >> 2) + lr : tq) - lbase_of(id);
      lo = hi - 128;
    };
    attn_run(qf, next, desc, band, m, l, O, lh);
  }
  const float inv = 1.f / l;
#pragma unroll
  for (int dt = 0; dt < 2; ++dt)
#pragma unroll
    for (int rr = 0; rr < 16; ++rr) O[dt][rr] *= inv;
  store_gated(p.proj + rowq * NP + C_ZA + h * 64 + 4 * lh, p.obuf + rowq * 896 + h * 64 + 4 * lh, O);
}

DI int moba_seg_col(int h, int k) {
  const int s = h * 3 + k;
  return s < 6 ? C_VA + 64 * s : (s < 10 ? C_VC + 64 * (s - 6) : (s == 10 ? C_VSB : C_VWB));
}

DI unsigned moba_select(const Params& p, const bf16x8 (&qf)[4], int b, int h, int bo, int lr, int lh) {
  const u16* kmp = p.kmean + ((size_t)(b * 4 + h) * 16 + (lr & 15)) * 64 + lh * 8;
  f32x16 s = zero16();
#pragma unroll
  for (int ks = 0; ks < 4; ++ks) s = mfma32(*(const bf16x8*)(kmp + ks * 16), qf[ks], s);
  float own[8], oth[8];
#pragma unroll
  for (int x = 0; x < 8; ++x) {
    const int n = 8 * (x >> 2) + 4 * lh + (x & 3);
    own[x] = n < bo ? s[x] : -1e30f;
  }
#pragma unroll
  for (int x = 0; x < 8; ++x) oth[x] = xor32_get(own[x], lh);
  unsigned mymask = 0;
#pragma unroll
  for (int x = 0; x < 8; ++x) {
    const int nx = 8 * (x >> 2) + 4 * lh + (x & 3);
    int rank = 0;
#pragma unroll
    for (int y = 0; y < 8; ++y) {
      const int ny = 8 * (y >> 2) + 4 * lh + (y & 3);
      const int no = 8 * (y >> 2) + 4 * (1 - lh) + (y & 3);
      if (y != x) rank += (own[y] > own[x]) || (own[y] == own[x] && ny < nx);
      rank += (oth[y] > own[x]) || (oth[y] == own[x] && no < nx);
    }
    if (rank < 3 && nx < bo) mymask |= 1u << nx;
  }
  mymask = xor32_or(mymask);
  return mymask;
}

DI void moba_mask_item(const Params& p, int b, int h, int qt) {
  const int lane = tid_() & 63, lr = lane & 31, lh = lane >> 5;
  const int bo = qt >> 3;
  unsigned mask = 0;
  if (bo > 0) {
    bf16x8 qf[4];
    const u16* qp = p.proj + ((size_t)b * 4096 + qt * 32 + lr) * NP + C_QC + h * 64 + lh * 8;
#pragma unroll
    for (int ks = 0; ks < 4; ++ks) qf[ks] = *(const bf16x8*)(qp + ks * 16);
    mask = moba_select(p, qf, b, h, bo, lr, lh);
  }
  if (lh == 0) p.selm16[(size_t)(b * 4 + h) * 4096 + qt * 32 + lr] = (u16)mask;
}

DI void moba_list_item(const Params& p, int b, int h, int n) {
  const int lane = tid_() & 63;
  const u16* selm = p.selm16 + (size_t)(b * 4 + h) * 4096;
  u16* lst = p.mlist + ((size_t)(b * 4 + h) * 16 + n) * 4096;
  int base = 0;
#pragma unroll 1
  for (int t0 = 256 * (n + 1); t0 < 4096; t0 += 512) {
    unsigned mk[8];
#pragma unroll
    for (int i = 0; i < 8; ++i) { const int t = t0 + 64 * i + lane; mk[i] = t < 4096 ? (unsigned)selm[t] : 0u; }
#pragma unroll
    for (int i = 0; i < 8; ++i) {
      const bool f = (mk[i] >> n) & 1u;
      const unsigned long long bal = __ballot(f);
      const int pos = base + __popcll(bal & ((1ull << lane) - 1ull));
      if (f) lst[pos] = (u16)(t0 + 64 * i + lane);
      base += __popcll(bal);
    }
  }
  if (lane == 0) p.mcnt[(b * 4 + h) * 16 + n] = base;
}

DI int moba_part_token(const Params& p, int bh, int n, int c, int cntn) {
  const int lr = tid_() & 31;
  const u16* lst = p.mlist + ((size_t)bh * 16 + n) * 4096;
  const int idx = c * 32 + lr;
  return (int)lst[idx < cntn ? idx : cntn - 1];
}
DI void moba_part_item(const Params& p, int b, int h, int n, int c, const int cntn, const int t) {
  const int lane = tid_() & 63, lr = lane & 31, lh = lane >> 5;
  const bool valid = c * 32 + lr < cntn;
  const size_t rowq = (size_t)b * 4096 + t;
  const unsigned mk = p.selm16[(size_t)(b * 4 + h) * 4096 + t];
  const u16* proj = p.proj;
  bf16x8 qf[4];
  {
    const u16* qp = proj + rowq * NP + C_QC + h * 64 + lh * 8;
#pragma unroll
    for (int ks = 0; ks < 4; ++ks) qf[ks] = *(const bf16x8*)(qp + ks * 16);
  }
  float m = M_INIT, l = 0.f; f32x16 O[2]; O[0] = zero16(); O[1] = zero16();
  {
    const size_t krow0 = (size_t)b * 4096;
    const int kcol = C_KC + h * 64 + lh * 8;
    const u16* vbase = p.VC + ((size_t)(b * 4 + h) * 128 * 2) * 1024 + lane * 16;
    const int kt0 = n * 8;
    attn_run(qf, [&](int prev) { return prev < 0 ? kt0 : (prev + 1 < kt0 + 8 ? prev + 1 : -1); },
             [&](int kt, const u16*& kp, const u16*& vp) { kp = proj + (krow0 + kt * 32 + lr) * NP + kcol; vp = vbase + (size_t)kt * 2048; },
             [&](int, int& lo, int& hi) { lo = -BIG; hi = BIG; }, m, l, O, lh);
  }
  const int k = __popc(mk & ((1u << n) - 1u));
  if (valid) {
    if (lh == 0) { float2 ml; ml.x = m; ml.y = l; *(float2*)(p.mlC + ((rowq * 4 + h) * 3 + k) * 2) = ml; }
    u16* orow = p.proj + rowq * NP + moba_seg_col(h, k) + 4 * lh;
#pragma unroll
    for (int dt = 0; dt < 2; ++dt)
#pragma unroll
      for (int i = 0; i < 4; ++i) {
        uint2 o; o.x = pack2(O[dt][i * 4], O[dt][i * 4 + 1]); o.y = pack2(O[dt][i * 4 + 2], O[dt][i * 4 + 3]);
        *(uint2*)(orow + dt * 32 + 8 * i) = o;
      }
  }
}

DI void moba_item(const Params& p, int b, int h, int qt) {
  const int lane = tid_() & 63, lr = lane & 31, lh = lane >> 5;
  const int t0 = qt * 32, bo = qt >> 3, tq = t0 + lr;
  const size_t rowq = (size_t)b * 4096 + tq;
  const u16* proj = p.proj;
  bf16x8 qf[4];
  {
    const u16* qp = proj + rowq * NP + C_QC + h * 64 + lh * 8;
#pragma unroll
    for (int ks = 0; ks < 4; ++ks) qf[ks] = *(const bf16x8*)(qp + ks * 16);
  }
  float m = M_INIT, l = 0.f; f32x16 O[2]; O[0] = zero16(); O[1] = zero16();
  if (bo > 0) {
    const unsigned mk = p.selm16[(size_t)(b * 4 + h) * 4096 + tq];
    const int nsel = __popc(mk);
#pragma unroll
    for (int k = 0; k < 3; ++k) {
      const bool has = k < nsel;
      const float2 ml = *(const float2*)(p.mlC + ((rowq * 4 + h) * 3 + k) * 2);
      const float mk_ = has ? ml.x : -1e30f, lk = has ? ml.y : 0.f;
      const float mn = fmaxf(m, mk_);
      const float a = __builtin_amdgcn_exp2f(m - mn), bs = has ? __builtin_amdgcn_exp2f(mk_ - mn) : 0.f;
      l = l * a + lk * bs; m = mn;
      const u16* orow = proj + rowq * NP + moba_seg_col(h, k) + 4 * lh;
#pragma unroll
      for (int dt = 0; dt < 2; ++dt)
#pragma unroll
        for (int i = 0; i < 4; ++i) {
          const uint2 o = *(const uint2*)(orow + dt * 32 + 8 * i);
          const float o0 = has ? bf2f((u16)(o.x & 0xffff)) : 0.f, o1 = has ? bf2f((u16)(o.x >> 16)) : 0.f;
          const float o2 = has ? bf2f((u16)(o.y & 0xffff)) : 0.f, o3 = has ? bf2f((u16)(o.y >> 16)) : 0.f;
          O[dt][i * 4] = O[dt][i * 4] * a + o0 * bs; O[dt][i * 4 + 1] = O[dt][i * 4 + 1] * a + o1 * bs;
          O[dt][i * 4 + 2] = O[dt][i * 4 + 2] * a + o2 * bs; O[dt][i * 4 + 3] = O[dt][i * 4 + 3] * a + o3 * bs;
        }
    }
  }
  {
    const size_t krow0 = (size_t)b * 4096;
    const int kcol = C_KC + h * 64 + lh * 8;
    const u16* vbase = p.VC + ((size_t)(b * 4 + h) * 128 * 2) * 1024 + lane * 16;
    attn_run(qf, [&](int prev) { return prev < 0 ? qt : (prev == qt ? (bo * 8 < qt ? bo * 8 : -1) : (prev + 1 < qt ? prev + 1 : -1)); },
             [&](int kt, const u16*& kp, const u16*& vp) { kp = proj + (krow0 + kt * 32 + lr) * NP + kcol; vp = vbase + (size_t)kt * 2048; },
             [&](int kt, int& lo, int& hi) { lo = -BIG; hi = kt == qt ? lr : BIG; }, m, l, O, lh);
  }
  const float inv = 1.f / l;
#pragma unroll
  for (int dt = 0; dt < 2; ++dt)
#pragma unroll
    for (int rr = 0; rr < 16; ++rr) O[dt][rr] *= inv;
  store_gated(p.proj + rowq * NP + C_ZC + h * 64 + 4 * lh, p.obuf + rowq * 896 + 640 + h * 64 + 4 * lh, O);
}

DI void nsa_item(const Params& p, int b, int qt, char* smraw) {
  float* pslc = (float*)smraw;
  unsigned* selm = (unsigned*)(smraw + 33280);
  const int tid = tid_(), lane = tid & 63, g = tid >> 6, lr = lane & 31, lh = lane >> 5;
  const int t0 = qt * 32, tq = t0 + lr;
  const size_t rowq = (size_t)b * 4096 + tq;
  const u16* proj = p.proj;
  bf16x8 qf[4];
  {
    const u16* qp = proj + rowq * NP + C_QB + g * 64 + lh * 8;
#pragma unroll
    for (int ks = 0; ks < 4; ++ks) qf[ks] = *(const bf16x8*)(qp + ks * 16);
  }
  const int nvq = tq >= 31 ? ((tq - 31) >> 4) + 1 : 0;
  const int nct = ((t0 >> 4) + 1 + 31) >> 5;
  float m_c = M_INIT, l_c = 0.f; f32x16 Oc[2]; Oc[0] = zero16(); Oc[1] = zero16();
  const u16* kcb = p.kc + (size_t)b * 256 * 64 + lh * 8;
  const u16* vcb = p.vcF + (size_t)b * 16 * 1024 + lane * 16;
  char* kvlds = smraw + 34816;
  attn_run_shared(qf, [&](int prev) { return prev + 1 < nct ? prev + 1 : -1; },
                  [&](int ct, const u16*& kb, int& kst, const u16*& vt) {
                    kb = p.kc + ((size_t)b * 256 + ct * 32) * 64; kst = 64; vt = p.vcF + ((size_t)b * 8 + ct) * 2048;
                  },
                  [&](int ct, int& lo, int& hi) { lo = -BIG; hi = nvq - 1 - ct * 32; }, m_c, l_c, Oc, kvlds);
  const float invc = l_c > 0.f ? 1.f / l_c : 0.f;
  const u16* gp = proj + rowq * NP + C_GB + g;
  const u16 gq0 = gp[0], gq1 = gp[4], gq2 = gp[8];
  unsigned Opk[2][8];
  {
    const float g0 = sigmoidf_(bf2f(gq0)) * invc;
#pragma unroll
    for (int dt = 0; dt < 2; ++dt)
#pragma unroll
      for (int rr = 0; rr < 8; ++rr) Opk[dt][rr] = pack2(g0 * Oc[dt][2 * rr], g0 * Oc[dt][2 * rr + 1]);
  }
  {
    float carry = 0.f;
    const int ptid = tid_(), krow = ptid >> 3, kc = ptid & 7;
    const int kdst = krow * 128 + ((kc ^ ((krow >> 1) & 7)) * 16);
    const int ksw = (lr >> 1) & 7;
    const u16* kcg = p.kc + (size_t)b * 256 * 64 + (size_t)krow * 64 + kc * 8;
    uint4 kreg = *(const uint4*)kcg;
#pragma unroll 1
    for (int ct = 0; ct < 8; ++ct) {
      float tot[4] = {0.f, 0.f, 0.f, 0.f};
      if (ct < nct) {
        char* buf = kvlds + (ct & 1) * 8192;
        *(uint4*)(buf + kdst) = kreg;
        __syncthreads();
        kreg = *(const uint4*)(kcg + (size_t)(ct + 1 < nct ? ct + 1 : ct) * 32 * 64);
        f32x16 sc = zero16();
#pragma unroll
        for (int ks = 0; ks < 4; ++ks)
          sc = mfma32(*(const bf16x8*)(buf + lr * 128 + (((ks * 2 + lh) ^ ksw) * 16)), qf[ks], sc);
        float gs[4], sp[4];
#pragma unroll
        for (int i = 0; i < 4; ++i) {
          float s4 = 0.f, last = 0.f;
#pragma unroll
          for (int j = 0; j < 4; ++j) {
            const int c = ct * 32 + 4 * lh + 8 * i + j;
            const float e = (c < nvq) ? __builtin_amdgcn_exp2f(sc[i * 4 + j] - m_c) * invc : 0.f;
            s4 += e; last = e;
          }
          gs[i] = s4; sp[i] = last;
        }
        float ps[4];
#pragma unroll
        for (int i = 0; i < 4; ++i) ps[i] = xor32_get(sp[i], lh);
        if (lh) {
#pragma unroll
          for (int i = 0; i < 4; ++i) tot[i] = gs[i] + ps[i];
        } else {
          tot[0] = gs[0] + carry; tot[1] = gs[1] + ps[0]; tot[2] = gs[2] + ps[1]; tot[3] = gs[3] + ps[2];
          carry = ps[3];
        }
      } else {
        if (!lh) { tot[0] = carry; carry = 0.f; }
      }
#pragma unroll
      for (int i = 0; i < 4; ++i) pslc[(g * 32 + lr) * 65 + ct * 8 + 2 * i + lh] = tot[i];
    }
  }
  __syncthreads();
#pragma unroll 1
  for (int qi = 0; qi < 8; ++qi) {
    const int q = g * 8 + qi, J = lane, tqq = t0 + q, cur = tqq >> 6;
    const bool forced = (J == 0) || (J == cur) || (J == cur - 1);
    const bool valid = (J * 64 <= tqq);
    const float psum = ((pslc[(0 * 32 + q) * 65 + J] + pslc[(1 * 32 + q) * 65 + J]) + pslc[(2 * 32 + q) * 65 + J]) + pslc[(3 * 32 + q) * 65 + J];
    const float scv = forced ? 1e4f : (valid ? psum : -1e30f);
    int rank = 0;
#pragma unroll 4
    for (int j2 = 0; j2 < 64; ++j2) {
      const float o = __int_as_float(__builtin_amdgcn_readlane(__float_as_int(scv), j2));
      rank += ((o > scv) || (o == scv && j2 < J)) ? 1 : 0;
    }
    const bool sel = (rank < 16) && valid;
    const unsigned long long mk = __ballot(sel);
    if (lane == 0) { selm[q * 2] = (unsigned)mk; selm[q * 2 + 1] = (unsigned)(mk >> 32); }
  }
  __syncthreads();
  const unsigned mlo = selm[lr * 2], mhi = selm[lr * 2 + 1];
  unsigned alo = mlo, ahi = mhi;
#pragma unroll
  for (int o = 1; o < 32; o <<= 1) { alo |= __shfl_xor(alo, o); ahi |= __shfl_xor(ahi, o); }
  alo = __builtin_amdgcn_readfirstlane(alo); ahi = __builtin_amdgcn_readfirstlane(ahi);
  float m_s = M_INIT, l_s = 0.f; f32x16 Os[2]; Os[0] = zero16(); Os[1] = zero16();
  {
    const u16* vb = p.VS + ((size_t)b * 128 * 2) * 1024 + lane * 16;
    const unsigned long long any64 = ((unsigned long long)ahi << 32) | alo;
    const unsigned long long my64 = ((unsigned long long)mhi << 32) | mlo;
    const int Jmax = qt >> 1;
    auto next = [&](int prevJ) {
      const int J0 = prevJ + 1;
      if (J0 > Jmax) return -1;
      const unsigned long long mk = any64 >> J0;
      if (!mk) return -1;
      const int J = J0 + __builtin_ctzll(mk);
      return J <= Jmax ? J : -1;
    };
    auto band2 = [&](int J, int half, int& lo, int& hi) {
      lo = -BIG; hi = ((my64 >> J) & 1ull) ? tq - (2 * J + half) * 32 : -2 * BIG;
    };
    attn_run_shared2(qf, next, proj + ((size_t)b * 4096) * NP + C_KSB, p.VS + ((size_t)b * 128) * 2048, qt, band2, m_s, l_s, Os, kvlds);
  }
  {
    const float g1 = sigmoidf_(bf2f(gq1)) / l_s;
#pragma unroll
    for (int dt = 0; dt < 2; ++dt)
#pragma unroll
      for (int rr = 0; rr < 8; ++rr)
        Opk[dt][rr] = pack2(bf2f((u16)(Opk[dt][rr] & 0xffff)) + g1 * Os[dt][2 * rr], bf2f((u16)(Opk[dt][rr] >> 16)) + g1 * Os[dt][2 * rr + 1]);
  }
  m_s = M_INIT; l_s = 0.f; Os[0] = zero16(); Os[1] = zero16();
  {
    const u16* vb = p.VW + ((size_t)b * 128 * 2) * 1024 + lane * 16;
    const int klo = qt - 16 < 0 ? 0 : qt - 16;
    attn_run_shared(qf, [&](int prev) { return prev < 0 ? qt : (prev - 1 >= klo ? prev - 1 : -1); },
                    [&](int kt, const u16*& kb, int& kst, const u16*& vt) {
                      kb = proj + ((size_t)b * 4096 + kt * 32) * NP + C_KWB; kst = NP; vt = p.VW + ((size_t)b * 128 + kt) * 2048;
                    },
                    [&](int kt, int& lo, int& hi) { hi = tq - kt * 32; lo = hi - 511; }, m_s, l_s, Os, kvlds);
  }
  {
    const float g2 = sigmoidf_(bf2f(gq2)) / l_s;
#pragma unroll
    for (int dt = 0; dt < 2; ++dt)
#pragma unroll
      for (int rr = 0; rr < 8; ++rr) {
        Os[dt][2 * rr] = bf2f((u16)(Opk[dt][rr] & 0xffff)) + g2 * Os[dt][2 * rr];
        Os[dt][2 * rr + 1] = bf2f((u16)(Opk[dt][rr] >> 16)) + g2 * Os[dt][2 * rr + 1];
      }
  }
  store_gated(p.proj + rowq * NP + C_ZB + g * 64 + 4 * lh, p.obuf + rowq * 896 + 384 + g * 64 + 4 * lh, Os);
  __syncthreads();
}

DI void phase_attn_far(const Params& p_in, const BlkMap bm) {
  const Params p = launder(p_in);
  const int wid = tid_() >> 6;
  for (int it = bm.j * 4 + wid; it < 512; it += bm.per * 4) {
    const int bh = bm.x + 8 * (it >> 7);
    moba_mask_item(p, bh >> 2, bh & 3, it & 127);
  }
  for (int w = bm.j; w < 192; w += bm.per) {
    const int bh = bm.x + 8 * (w >> 5), sub = w & 31;
    mixA_far_item(p, bh / 6, bh % 6, (sub >> 2) * 512, (sub & 3) * 4 + wid);
  }
}

DI void phase_attn_lists(const Params& p_in, const BlkMap bm) {
  const Params p = launder(p_in);
  const int wid = tid_() >> 6;
  for (int it = bm.j * 4 + wid; it < 60; it += bm.per * 4) {
    const int bh = bm.x + 8 * (it / 15);
    moba_list_item(p, bh >> 2, bh & 3, it % 15);
  }
}

DI void phase_attn(const Params& p_in, const BlkMap bm, char* smraw) {
  const Params p = launder(p_in);
  const int wid = tid_() >> 6;
  for (int w = bm.j; w < 128; w += bm.per) {
    const int qt = w < 64 ? 127 - w : w - 64;
    nsa_item(p, bm.x, qt, smraw);
  }
  for (int w = bm.j; w < 192; w += bm.per) {
    const int bh = bm.x + 8 * (w >> 5), sub = w & 31;
    mixA_item(p, bh / 6, bh % 6, sub * 128, wid);
  }
  {
    const int nwv = bm.per * 4;
    int tot[4];
#pragma unroll
    for (int i = 0; i < 4; ++i) {
      const int* cnt = p.mcnt + (bm.x + 8 * i) * 16;
      int tt = 0;
#pragma unroll 1
      for (int n = 0; n < 15; ++n) tt += (cnt[n] + 31) >> 5;
      tot[i] = tt;
    }
    const int ntot = tot[0] + tot[1] + tot[2] + tot[3];
    auto decode = [&](int it, int& bh, int& n, int& c, int& cntn) {
      int f = it, i = 0;
      if (f >= tot[0]) { f -= tot[0]; i = 1; if (f >= tot[1]) { f -= tot[1]; i = 2; if (f >= tot[2]) { f -= tot[2]; i = 3; } } }
      bh = bm.x + 8 * i;
      const int* cnt = p.mcnt + bh * 16;
      n = 0; cntn = cnt[0];
#pragma unroll 1
      for (; n < 14; ++n) { const int ch = (cntn + 31) >> 5; if (f < ch) break; f -= ch; cntn = cnt[n + 1]; }
      c = f;
    };
    int it = bm.j * 4 + wid;
    if (it < ntot) {
      int bh, n, c, cntn; decode(it, bh, n, c, cntn);
      int t = moba_part_token(p, bh, n, c, cntn);
#pragma unroll 1
      while (true) {
        const int it2 = it + nwv;
        const bool more = it2 < ntot;
        int bh2 = bh, n2 = n, c2 = c, cntn2 = cntn;
        if (more) decode(it2, bh2, n2, c2, cntn2);
        const int t2 = moba_part_token(p, bh2, n2, c2, cntn2);
        moba_part_item(p, bh >> 2, bh & 3, n, c, cntn, t);
        if (!more) break;
        it = it2; bh = bh2; n = n2; c = c2; cntn = cntn2; t = t2;
      }
    }
  }
}

DI void phase_attn_fin(const Params& p_in, const BlkMap bm) {
  const Params p = launder(p_in);
  const int wid = tid_() >> 6;
  for (int w = bm.j; w < 128; w += bm.per) {
    const int bh = bm.x + 8 * (w >> 5), qg = w & 31;
    moba_item(p, bh >> 2, bh & 3, qg * 4 + wid);
  }
}

DI void phase_merge(const Params& p_in, const BlkMap bm, int l, u16* sm) {
  const Params p = launder(p_in);
  const int tid = tid_(), lane = tid & 63, wid = tid >> 6, wm = wid >> 1, wn = wid & 1;
  const int lr = lane & 31, lh = lane >> 5;
  const u16* Wbr = p.Wbr + (size_t)l * 1024 * 896;
  const u16* Wg = p.Wg + (size_t)l * 3072 * 1024;
  for (int k = 0;; ++k) {
    int mt, nt;
    if (!tile_map(bm, k, 256, 8, mt, nt)) break;
    const int m0 = mt * 128, n0 = nt * 128;
    f32x16 yacc[2][2];
#pragma unroll
    for (int a = 0; a < 2; ++a)
#pragma unroll
      for (int b = 0; b < 2; ++b) yacc[a][b] = zero16();
#pragma unroll 1
    for (int br = 0; br < 3; ++br) {
      const int kofs = br == 0 ? 0 : (br == 1 ? 384 : 640);
      const int Kb = br == 0 ? 384 : 256;
      unsigned sg[2][2][8];
      {
        f32x16 gg[2][2];
#pragma unroll
        for (int a = 0; a < 2; ++a)
#pragma unroll
          for (int b = 0; b < 2; ++b) gg[a][b] = zero16();
        gemm_loop<2, 2, 4, true>(p.xb + (size_t)m0 * 1024, 1024, Wg + (size_t)(br * 1024 + n0) * 1024, 1024, 1024, gg, sm);
#pragma unroll
        for (int a = 0; a < 2; ++a)
#pragma unroll
          for (int b = 0; b < 2; ++b)
#pragma unroll
            for (int r = 0; r < 8; ++r) sg[a][b][r] = pack2(sigmoidf_(gg[a][b][2 * r]), sigmoidf_(gg[a][b][2 * r + 1]));
      }
      f32x16 u[2][2];
#pragma unroll
      for (int a = 0; a < 2; ++a)
#pragma unroll
        for (int b = 0; b < 2; ++b) u[a][b] = zero16();
      gemm_loop<2, 2, 4, true>(p.obuf + (size_t)m0 * 896 + kofs, 896, Wbr + (size_t)n0 * 896 + kofs, 896, Kb, u, sm);
#pragma unroll
      for (int a = 0; a < 2; ++a)
#pragma unroll
        for (int b = 0; b < 2; ++b)
#pragma unroll
          for (int r = 0; r < 8; ++r) {
            yacc[a][b][2 * r] += bf2f((u16)(sg[a][b][r] & 0xffff)) * u[a][b][2 * r];
            yacc[a][b][2 * r + 1] += bf2f((u16)(sg[a][b][r] >> 16)) * u[a][b][2 * r + 1];
          }
    }
    tile_store_bf16<2>(yacc, p.y + (size_t)m0 * 1024 + n0, 1024, (char*)sm);
  }
}

DI void phase_out(const Params& p_in, const BlkMap bm, int l, const float* xres, u16* sm) {
  const Params p = launder(p_in);
  const int tid = tid_(), lane = tid & 63, wid = tid >> 6, wm = wid >> 1, wn = wid & 1;
  const int lr = lane & 31, lh = lane >> 5;
  const u16* Wo = p.Wout + (size_t)l * 1024 * 1024;
  for (int k = 0;; ++k) {
    int mt, nt;
    if (!tile_map(bm, k, 128, 8, mt, nt)) break;
    const int m0 = mt * 256, n0 = nt * 128;
    f32x16 acc[4][2];
#pragma unroll
    for (int a = 0; a < 4; ++a)
#pragma unroll
      for (int b = 0; b < 2; ++b) acc[a][b] = zero16();
    gemm_loop<4, 2, 3, false>(p.y + (size_t)m0 * 1024, 1024, Wo + (size_t)n0 * 1024, 1024, 1024, acc, sm);
#pragma unroll
    for (int mi = 0; mi < 4; ++mi) {
      float res[2][16];
#pragma unroll
      for (int ni = 0; ni < 2; ++ni)
#pragma unroll
        for (int r = 0; r < 16; ++r) {
          const int row = m0 + wm * 128 + mi * 32 + 4 * lh + 8 * (r >> 2) + (r & 3);
          res[ni][r] = __builtin_nontemporal_load(xres + (size_t)row * 1024 + n0 + wn * 64 + ni * 32 + lr);
        }
#pragma unroll
      for (int ni = 0; ni < 2; ++ni)
#pragma unroll
        for (int r = 0; r < 16; ++r) {
          const int row = m0 + wm * 128 + mi * 32 + 4 * lh + 8 * (r >> 2) + (r & 3);
          __builtin_nontemporal_store(res[ni][r] + acc[mi][ni][r], p.out + (size_t)row * 1024 + n0 + wn * 64 + ni * 32 + lr);
        }
    }
  }
}

#define XB_TMO      128
#define XB_XCNT(j)  (256  + 64 * (j))
#define XB_XSUB(j)  (1280 + 64 * (j))
#define XB_XGEN(j)  (2304 + 64 * (j))
#define XB_TOP      3328
#define XB_TOPGEN   3392
#define XB_RANK(j)  (3456 + 64 * (j))
#define XCD_BAR_WORDS 4480
#define XB_SPIN_CAP (1u << 18)
#define LAS __attribute__((address_space(3)))
DI unsigned xb_ld(unsigned* p) { return __hip_atomic_load(p, __ATOMIC_RELAXED, __HIP_MEMORY_SCOPE_AGENT); }
DI unsigned xb_add(unsigned* p, unsigned v) { return __hip_atomic_fetch_add(p, v, __ATOMIC_RELAXED, __HIP_MEMORY_SCOPE_AGENT); }
DI unsigned xb_xcc_id() { return (unsigned)__builtin_amdgcn_s_getreg((3 << 11) | 20) & 0xFu; }
#define XB_SPIN(cond, bar) do { unsigned _sp = 0; while (cond) { __builtin_amdgcn_s_sleep(1); \
    if ((++_sp & 255u) == 0u) { if (xb_ld(&(bar)[XB_TMO])) break; if (_sp > XB_SPIN_CAP) { atomicAdd(&(bar)[XB_TMO], 1u); break; } } } } while (0)
struct XcdBarrier { unsigned* bar; unsigned x; volatile LAS unsigned* st; };
DI XcdBarrier xcd_barrier_post(unsigned* bar, volatile LAS unsigned* st) {
  XcdBarrier b; b.bar = bar; b.x = xb_xcc_id(); b.st = st;
  if (threadIdx.x == 0) (void)xb_add(&bar[XB_XCNT(b.x)], 1u);
  return b;
}
DI void xcd_barrier_complete(unsigned* bar, unsigned x, unsigned& nloc, unsigned& nx) {
  const unsigned G = gridDim.x * gridDim.y * gridDim.z;
  unsigned sum, cnt, mine, sp = 0u;
  for (;;) {
    sum = 0u; cnt = 0u; mine = 0u;
#pragma unroll
    for (unsigned j = 0; j < 16; ++j) { const unsigned c = xb_ld(&bar[XB_XCNT(j)]); sum += c; cnt += (c > 0u) ? 1u : 0u; mine = (j == x) ? c : mine; }
    if (sum == G) break;
    __builtin_amdgcn_s_sleep(1);
    if ((++sp & 255u) == 0u) { if (xb_ld(&bar[XB_TMO])) break; if (sp > XB_SPIN_CAP) { atomicAdd(&bar[XB_TMO], 1u); break; } }
  }
  nloc = mine > 0u ? mine : 1u; nx = cnt > 0u ? cnt : 1u;
}
DI void xcd_barrier(const XcdBarrier& b) {
  asm volatile("s_waitcnt vmcnt(0)" ::: "memory");
  __syncthreads();
  if (threadIdx.x == 0) {
    unsigned* bar = b.bar;
    __builtin_amdgcn_s_waitcnt(0);
    unsigned nloc = b.st[0], nx = b.st[1];
    if (nloc == 0u) { xcd_barrier_complete(bar, b.x, nloc, nx); b.st[0] = nloc; b.st[1] = nx; }
    const unsigned old = xb_add(&bar[XB_XSUB(b.x)], 1u);
    const unsigned gen = old / nloc;
    if (old + 1u == (gen + 1u) * nloc) {
      __builtin_amdgcn_fence(__ATOMIC_RELEASE, "agent");
      asm volatile("s_waitcnt vmcnt(0)" ::: "memory");
      const unsigned og = xb_add(&bar[XB_TOP], 1u);
      const unsigned tg = og / nx;
      if (og + 1u == (tg + 1u) * nx) xb_add(&bar[XB_TOPGEN], 1u);
      else XB_SPIN(xb_ld(&bar[XB_TOPGEN]) == tg, bar);
      __builtin_amdgcn_fence(__ATOMIC_ACQUIRE, "agent");
      xb_add(&bar[XB_XGEN(b.x)], 1u);
      asm volatile("s_waitcnt vmcnt(0)" ::: "memory");
    } else {
      XB_SPIN(xb_ld(&bar[XB_XGEN(b.x)]) == gen, bar);
      __builtin_amdgcn_fence(__ATOMIC_ACQUIRE, "agent");
      asm volatile("s_waitcnt vmcnt(0)" ::: "memory");
    }
  }
  __syncthreads();
}

__global__ void __launch_bounds__(256, 2) hybrid_megakernel(Params p) {
  extern __shared__ __attribute__((aligned(16))) char smraw[];
  cg::grid_group grid = cg::this_grid();
  volatile LAS unsigned* xst = (volatile LAS unsigned*)(smraw + SMEM_MAIN);
  if (threadIdx.x == 0) { xst[0] = 0u; xst[1] = 0u; }
  __syncthreads();
  const XcdBarrier xb = xcd_barrier_post(p.bar, xst);
  if (threadIdx.x == 0) xst[2] = xb_add(&p.bar[XB_RANK(xb.x)], 1u);
  if (p.out == nullptr) grid.sync();
  prep_weights(p, (float*)smraw);
  prep_misc(p);
  rmsnorm_rows(p.x, p.norm_g, p.xb);
  xcd_barrier(xb);
  BlkMap bm;
  {
    bool ok = true; unsigned mine = 0;
#pragma unroll
    for (unsigned j = 0; j < 16; ++j) {
      const unsigned c = xb_ld(&p.bar[XB_XCNT(j)]);
      ok = ok && (j < 8 ? c > 0u : c == 0u);
      mine = (j == xb.x) ? c : mine;
    }
    const unsigned rank = xst[2];
    bm.x = ok ? (int)xb.x : (int)(blockIdx.x & 7);
    bm.j = ok ? (int)rank : (int)(blockIdx.x >> 3);
    bm.per = ok ? (int)mine : (int)(gridDim.x >> 3);
    bm.x = __builtin_amdgcn_readfirstlane(bm.x); bm.j = __builtin_amdgcn_readfirstlane(bm.j); bm.per = __builtin_amdgcn_readfirstlane(bm.per);
  }
#pragma unroll 1
  for (int l = 0; l < 2; ++l) {
    const float* xin = l == 0 ? p.x : p.out;
    phase_inproj(p, bm, l, (u16*)smraw);
    xcd_barrier(xb);
    phase_mid(p, l, smraw);
    xcd_barrier(xb);
    phase_attn_far(p, bm);
    xcd_barrier(xb);
    phase_attn_lists(p, bm);
    xcd_barrier(xb);
    phase_attn(p, bm, smraw);
    xcd_barrier(xb);
    phase_attn_fin(p, bm);
    xcd_barrier(xb);
    phase_merge(p, bm, l, (u16*)smraw);
    xcd_barrier(xb);
    phase_out(p, bm, l, xin, (u16*)smraw);
    if (l == 0) {
      xcd_barrier(xb);
      rmsnorm_rows(p.out, p.norm_g + 1024, p.xb);
      xcd_barrier(xb);
    }
  }
}

extern "C" void kernel_launch(void* const* d_in, const int* in_sizes, int n_in, void* d_out, int out_size,
                              void* d_ws, size_t ws_size, hipStream_t stream) {
  Params p{};
  p.x = (const float*)d_in[0]; p.pos = (const int*)d_in[1]; p.norm_g = (const float*)d_in[2]; p.w_in = (const float*)d_in[3];
  p.qna = (const float*)d_in[4]; p.kna = (const float*)d_in[5]; p.qnb = (const float*)d_in[6]; p.knb = (const float*)d_in[7];
  p.qnc = (const float*)d_in[8]; p.knc = (const float*)d_in[9]; p.cmp_pos = (const float*)d_in[10];
  p.ckw1 = (const float*)d_in[11]; p.ckw2 = (const float*)d_in[12]; p.cvw1 = (const float*)d_in[13]; p.cvw2 = (const float*)d_in[14];
  p.wbra = (const float*)d_in[15]; p.wbrb = (const float*)d_in[16]; p.wbrc = (const float*)d_in[17]; p.wout = (const float*)d_in[18];
  p.out = (float*)d_out;
  char* ws = (char*)d_ws; size_t off = 0;
  auto take = [&](size_t bytes) { char* r = ws + off; off += (bytes + 255) & ~(size_t)255; return r; };
  p.xb = (u16*)take((size_t)32768 * 1024 * 2);
  p.proj = (u16*)take((size_t)32768 * NP * 2);
  p.Wt1 = (u16*)take((size_t)2 * NP * 1024 * 2);
  p.Wg = (u16*)take((size_t)2 * 3072 * 1024 * 2);
  p.Wbr = (u16*)take((size_t)2 * 1024 * 896 * 2);
  p.Wout = (u16*)take((size_t)2 * 1024 * 1024 * 2);
  p.W1t = (u16*)take((size_t)4 * 128 * 2048 * 2);
  p.W2t = (u16*)take((size_t)4 * 64 * 128 * 2);
  p.bias1 = (float*)take(512 * 4);
  p.kc = (u16*)take((size_t)2048 * 64 * 2);
  p.vcF = (u16*)take((size_t)2048 * 64 * 2);
  p.VS = (u16*)take((size_t)2048 * 1024 * 2);
  p.VW = (u16*)take((size_t)2048 * 1024 * 2);
  p.VC = (u16*)take((size_t)8192 * 1024 * 2);
  p.kmean = (u16*)take((size_t)512 * 64 * 2);
  p.rope = (float*)take((size_t)32768 * 16 * 4);
  p.obuf = (u16*)take((size_t)32768 * 896 * 2);
  p.bar = (unsigned*)take((size_t)XCD_BAR_WORDS * 4);
  p.mlA = (float*)take((size_t)32768 * 6 * 2 * 4);
  p.selm16 = (u16*)take((size_t)32 * 4096 * 2);
  p.mlist = (u16*)take((size_t)32 * 16 * 4096 * 2);
  p.mcnt = (int*)take((size_t)32 * 16 * 4);
  p.mlC = (float*)take((size_t)32768 * 4 * 3 * 2 * 4);
  char* va = take((size_t)3 * 12288 * 1024 * 2);
  p.VA1 = (u16*)va; p.VA4 = (u16*)(va + (size_t)12288 * 1024 * 2); p.VA16 = (u16*)(va + (size_t)2 * 12288 * 1024 * 2);
  p.y = (u16*)va;
  if (off > ws_size) { fprintf(stderr, "workspace too small: need %zu have %zu\n", off, ws_size); return; }

  static int grid_blocks = 0;
  if (!grid_blocks) {
    int dev = 0, cus = 0, per_cu = 0;
    hipGetDevice(&dev);
    hipDeviceGetAttribute(&cus, hipDeviceAttributeMultiprocessorCount, dev);
    hipFuncSetAttribute((const void*)hybrid_megakernel, hipFuncAttributeMaxDynamicSharedMemorySize, SMEM_BYTES);
    hipOccupancyMaxActiveBlocksPerMultiprocessor(&per_cu, hybrid_megakernel, 256, SMEM_BYTES);
    if (per_cu > 2) per_cu = 2;
    if (per_cu < 1) per_cu = 1;
    if (cus < 8) cus = 8;
    grid_blocks = cus * per_cu;
  }
  hipMemsetAsync(p.bar, 0, (size_t)XCD_BAR_WORDS * 4, stream);
  void* args[] = {&p};
  hipError_t e = hipLaunchCooperativeKernel((void*)hybrid_megakernel, dim3(grid_blocks), dim3(256), args, SMEM_BYTES, stream);
  if (e != hipSuccess) fprintf(stderr, "cooperative launch failed: %s (grid %d)\n", hipGetErrorString(e), grid_blocks);
}
```

```cpp
#include <hip/hip_runtime.h>
#include <hip/hip_cooperative_groups.h>
#include <cstdio>
namespace cg = cooperative_groups;

typedef unsigned short u16;
typedef __attribute__((ext_vector_type(8))) short bf16x8;
typedef __attribute__((ext_vector_type(16))) float f32x16;
#define DI __device__ __forceinline__

constexpr int NP = 3584;
constexpr int INW = 6540;
constexpr int C_QA = 0, C_KA = 384, C_VA = 768, C_ZA = 1152, C_QB = 1536, C_KCB = 1792, C_VCB = 1856,
              C_KSB = 1920, C_VSB = 1984, C_KWB = 2048, C_VWB = 2112, C_ZB = 2176, C_QC = 2432, C_KC = 2688,
              C_VC = 2944, C_ZC = 3200, C_GB = 3456;
constexpr int SMEM_MAIN = 73728;
constexpr int SMEM_BYTES = SMEM_MAIN + 16;

struct Params {
  const float* x; const int* pos; const float* norm_g; const float* w_in;
  const float* qna; const float* kna; const float* qnb; const float* knb; const float* qnc; const float* knc;
  const float* cmp_pos; const float* ckw1; const float* ckw2; const float* cvw1; const float* cvw2;
  const float* wbra; const float* wbrb; const float* wbrc; const float* wout;
  float* out;
  u16* xb; u16* proj; u16* y; u16* Wt1; u16* Wg; u16* Wbr; u16* Wout; u16* W1t; u16* W2t;
  float* bias1; u16* kc; u16* vcF; u16* VA1; u16* VA4; u16* VA16; u16* VS; u16* VW; u16* VC; u16* kmean;
  float* rope; u16* obuf; unsigned* bar; float* mlA;
  u16* selm16; u16* mlist; int* mcnt; float* mlC;
};

__device__ const float c_freq[8] = {1.0f, 0.19392274474868576f, 0.03760603093086393f, 0.007292664737217109f,
                                    0.001414213562373095f, 0.0002742481756762073f, 5.318295896944988e-05f,
                                    1.031338537721246e-05f};

DI u16 f2bf(float f) { __bf16 b = (__bf16)f; return __builtin_bit_cast(u16, b); }
DI float bf2f(u16 h) { return __uint_as_float(((unsigned)h) << 16); }
DI unsigned pack2(float a, float b) { return (unsigned)f2bf(a) | ((unsigned)f2bf(b) << 16); }
DI f32x16 mfma32(bf16x8 a, bf16x8 b, f32x16 c) { return __builtin_amdgcn_mfma_f32_32x32x16_bf16(a, b, c, 0, 0, 0); }
DI f32x16 zero16() { f32x16 z;
#pragma unroll
  for (int i = 0; i < 16; ++i) z[i] = 0.f; return z; }
DI float sigmoidf_(float x) { return 1.f / (1.f + __expf(-x)); }
DI float siluf_(float x) { return x / (1.f + __expf(-x)); }

typedef __attribute__((ext_vector_type(2))) unsigned u32x2_t;
DI float xor32_max(float x) {
  const u32x2_t r = __builtin_amdgcn_permlane32_swap(__float_as_uint(x), __float_as_uint(x), false, false);
  return __builtin_amdgcn_fmed3f(__uint_as_float(r[0]), __uint_as_float(r[1]), __builtin_inff());
}
DI float xor32_sum(float x) {
  const u32x2_t r = __builtin_amdgcn_permlane32_swap(__float_as_uint(x), __float_as_uint(x), false, false);
  return __uint_as_float(r[0]) + __uint_as_float(r[1]);
}
DI float xor32_get(float x, int lh) {
  const u32x2_t r = __builtin_amdgcn_permlane32_swap(__float_as_uint(x), __float_as_uint(x), false, false);
  return __uint_as_float(lh ? r[0] : r[1]);
}
DI unsigned xor32_or(unsigned x) {
  const u32x2_t r = __builtin_amdgcn_permlane32_swap(x, x, false, false);
  return r[0] | r[1];
}


DI int tid_() { int t = threadIdx.x; asm volatile("" : "+v"(t)); return t; }
template <class T> DI T* as_global(T* ptr) { return (T*)(__attribute__((address_space(1))) T*)ptr; }
#define LAU(f) do { asm volatile("" : "+s"(q.f)); q.f = as_global(q.f); } while (0)
DI Params launder(const Params& p) {
  Params q = p;
  return q;
}

struct TDesc { const float* src; int ld; int nvalid; u16* dst; int dld; };
DI void tconv_pair(const TDesc a, const TDesc b, const bool hasb, float* sm) {
  const int tid = tid_(), n = tid & 63, kq = tid >> 6;
  float va[16], vb[16];
#pragma unroll
  for (int i = 0; i < 16; ++i) { const int k = i * 4 + kq; va[i] = (n < a.nvalid) ? a.src[(size_t)k * a.ld + n] : 0.f; }
#pragma unroll
  for (int i = 0; i < 16; ++i) { const int k = i * 4 + kq; vb[i] = (hasb && n < b.nvalid) ? b.src[(size_t)k * b.ld + n] : 0.f; }
#pragma unroll
  for (int i = 0; i < 16; ++i) { const int k = i * 4 + kq; sm[k * 65 + n] = va[i]; sm[4160 + k * 65 + n] = vb[i]; }
  __syncthreads();
  const int k2 = (tid & 31) * 2, ng = tid >> 5;
#pragma unroll 4
  for (int i = 0; i < 8; ++i) {
    const int nn = i * 8 + ng;
    *(unsigned*)(a.dst + (size_t)nn * a.dld + k2) = pack2(sm[k2 * 65 + nn], sm[(k2 + 1) * 65 + nn]);
    if (hasb) *(unsigned*)(b.dst + (size_t)nn * b.dld + k2) = pack2(sm[4160 + k2 * 65 + nn], sm[4160 + (k2 + 1) * 65 + nn]);
  }
  __syncthreads();
}

DI TDesc tile_desc(const Params& p, int idx) {
  constexpr int TL = 2276;
  TDesc d;
  int l = idx / TL, t = idx % TL;
  if (t < 896) {
    int cg_ = t >> 4, kg = t & 15;
    d.nvalid = cg_ < 54 ? 64 : (cg_ == 54 ? 12 : 0);
    int srccol = cg_ < 34 ? cg_ * 64 : (cg_ < 54 ? cg_ * 64 + 12 : 2176);
    d.src = p.w_in + (size_t)l * 1024 * INW + (size_t)(kg * 64) * INW + srccol; d.ld = INW;
    d.dst = p.Wt1 + (size_t)l * NP * 1024 + (size_t)(cg_ * 64) * 1024 + kg * 64; d.dld = 1024;
  } else if (t < 1664) {
    t -= 896; int cg_ = t >> 4, kg = t & 15;
    d.nvalid = 64;
    d.src = p.w_in + (size_t)l * 1024 * INW + (size_t)(kg * 64) * INW + 3468 + cg_ * 64; d.ld = INW;
    d.dst = p.Wg + (size_t)l * 3072 * 1024 + (size_t)(cg_ * 64) * 1024 + kg * 64; d.dld = 1024;
  } else if (t < 1888) {
    t -= 1664; int ng = t / 14, kg = t % 14;
    const float* src;
    if (kg < 6) src = p.wbra + (size_t)l * 384 * 1024 + (size_t)(kg * 64) * 1024;
    else if (kg < 10) src = p.wbrb + (size_t)l * 256 * 1024 + (size_t)((kg - 6) * 64) * 1024;
    else src = p.wbrc + (size_t)l * 256 * 1024 + (size_t)((kg - 10) * 64) * 1024;
    d.nvalid = 64; d.src = src + ng * 64; d.ld = 1024;
    d.dst = p.Wbr + (size_t)l * 1024 * 896 + (size_t)(ng * 64) * 896 + kg * 64; d.dld = 896;
  } else if (t < 2144) {
    t -= 1888; int ng = t >> 4, kg = t & 15;
    d.nvalid = 64; d.src = p.wout + (size_t)l * 1024 * 1024 + (size_t)(kg * 64) * 1024 + ng * 64; d.ld = 1024;
    d.dst = p.Wout + (size_t)l * 1024 * 1024 + (size_t)(ng * 64) * 1024 + kg * 64; d.dld = 1024;
  } else if (t < 2272) {
    t -= 2144; int kv = t >> 6; t &= 63; int ng = t >> 5, kg = t & 31;
    const float* w = kv ? p.cvw1 : p.ckw1;
    d.nvalid = 64; d.src = w + (size_t)l * 2048 * 128 + (size_t)(kg * 64) * 128 + ng * 64; d.ld = 128;
    d.dst = p.W1t + ((size_t)(l * 2 + kv) * 128 + ng * 64) * 2048 + kg * 64; d.dld = 2048;
  } else {
    t -= 2272; int kv = t >> 1, kg = t & 1;
    const float* w = kv ? p.cvw2 : p.ckw2;
    d.nvalid = 64; d.src = w + (size_t)l * 128 * 64 + (size_t)(kg * 64) * 64; d.ld = 64;
    d.dst = p.W2t + ((size_t)(l * 2 + kv) * 64) * 128 + kg * 64; d.dld = 128;
  }
  return d;
}

DI void prep_weights(const Params& p_in, float* sm) {
  const Params p = launder(p_in);
  constexpr int TL = 2276;
  for (int idx = blockIdx.x; idx < 2 * TL; idx += 2 * gridDim.x) {
    const int idx2 = idx + gridDim.x;
    const bool hasb = idx2 < 2 * TL;
    const TDesc a = tile_desc(p, idx);
    const TDesc b = tile_desc(p, hasb ? idx2 : idx);
    tconv_pair(a, b, hasb, sm);
  }
}

DI void prep_misc(const Params& p_in) {
  const Params p = launder(p_in);
  const int gtid = blockIdx.x * 256 + tid_(), gsz = gridDim.x * 256;
  for (int i = gtid; i < 32768 * 8; i += gsz) {
    int tok = i >> 3, d = i & 7;
    float a = (float)p.pos[tok] * c_freq[d];
    double rev = (double)a * 0.15915494309189535;
    rev -= floor(rev);
    float fr = (float)rev;
    p.rope[tok * 16 + d] = __builtin_amdgcn_cosf(fr);
    p.rope[tok * 16 + 8 + d] = __builtin_amdgcn_sinf(fr);
  }
  {
    const int lane = tid_() & 63;
    const int gw = blockIdx.x * 4 + (tid_() >> 6);
    if (gw < 512) {
      const int l = gw >> 8, kv = (gw >> 7) & 1, n = gw & 127;
      const float* w = (kv ? p.cvw1 : p.ckw1) + (size_t)l * 2048 * 128 + n;
      const float* cp = p.cmp_pos + l * 2048;
      float s = 0.f;
#pragma unroll 8
      for (int i = 0; i < 32; ++i) { const int k = lane + 64 * i; s += cp[k] * w[(size_t)k * 128]; }
#pragma unroll
      for (int o = 32; o >= 1; o >>= 1) s += __shfl_xor(s, o);
      if (lane == 0) p.bias1[gw] = s;
    }
  }
}

DI void rmsnorm_rows(const float* __restrict__ xin, const float* __restrict__ g, u16* __restrict__ xb) {
  const int lane = tid_() & 63, wid = tid_() >> 6;
  for (int row = (blockIdx.x * 4 + wid) * 2; row < 32768; row += gridDim.x * 8) {
    const float4* xr0 = (const float4*)(xin + (size_t)row * 1024);
    const float4* xr1 = xr0 + 256;
    float4 v0[4], v1[4];
#pragma unroll
    for (int i = 0; i < 4; ++i) { v0[i] = xr0[lane + i * 64]; v1[i] = xr1[lane + i * 64]; }
    float s0 = 0.f, s1 = 0.f;
#pragma unroll
    for (int i = 0; i < 4; ++i) {
      s0 += v0[i].x * v0[i].x + v0[i].y * v0[i].y + v0[i].z * v0[i].z + v0[i].w * v0[i].w;
      s1 += v1[i].x * v1[i].x + v1[i].y * v1[i].y + v1[i].z * v1[i].z + v1[i].w * v1[i].w;
    }
#pragma unroll
    for (int o = 32; o >= 1; o >>= 1) { s0 += __shfl_xor(s0, o); s1 += __shfl_xor(s1, o); }
    const float r0 = rsqrtf(s0 * (1.f / 1024.f) + 1e-6f), r1 = rsqrtf(s1 * (1.f / 1024.f) + 1e-6f);
#pragma unroll
    for (int i = 0; i < 4; ++i) {
      const float4 gg = ((const float4*)g)[lane + i * 64];
      uint2 o; o.x = pack2(v0[i].x * r0 * gg.x, v0[i].y * r0 * gg.y); o.y = pack2(v0[i].z * r0 * gg.z, v0[i].w * r0 * gg.w);
      *(uint2*)(xb + (size_t)row * 1024 + (lane + i * 64) * 4) = o;
      uint2 q; q.x = pack2(v1[i].x * r1 * gg.x, v1[i].y * r1 * gg.y); q.y = pack2(v1[i].z * r1 * gg.z, v1[i].w * r1 * gg.w);
      *(uint2*)(xb + (size_t)(row + 1) * 1024 + (lane + i * 64) * 4) = q;
    }
  }
}

#define WAITVL(n) asm volatile("s_waitcnt vmcnt(" #n ") lgkmcnt(0)" ::: "memory")
template <int MT, int NT, int NS, bool SWAP>
DI void gemm_loop(const u16* __restrict__ A, int lda, const u16* __restrict__ Bt, int ldb, int K,
                  f32x16 (&acc)[MT][NT], u16* sm16) {
  constexpr int BN = 64 * NT, BM = 64 * MT;
  constexpr int A_BYTES = BM * 64, B_BYTES = BN * 64, STAGE = A_BYTES + B_BYTES;
  constexpr int NLD = MT + NT;
  char* sm = (char*)sm16;
  const int tid = tid_(), lane = tid & 63, wid = tid >> 6, wm = wid >> 1, wn = wid & 1;
  const int lr = lane & 31, lh = lane >> 5;
  const int row0 = tid >> 2, kc0 = ((tid & 3) ^ ((row0 >> 2) & 3)) * 8;
  const u16* ag = A + (size_t)row0 * lda + kc0;
  const u16* bg = Bt + (size_t)row0 * ldb + kc0;
  const size_t a64 = (size_t)64 * lda, b64 = (size_t)64 * ldb;
  const int nk = K >> 5;
  auto issue = [&](int kt) {
    char* d = sm + (kt % NS) * STAGE + tid * 16;
    const int ko = kt * 32;
#pragma unroll
    for (int i = 0; i < MT; ++i)
      __builtin_amdgcn_global_load_lds((const unsigned*)(ag + i * a64 + ko), (unsigned*)(d + i * 4096), 16, 0, 0);
#pragma unroll
    for (int i = 0; i < NT; ++i)
      __builtin_amdgcn_global_load_lds((const unsigned*)(bg + i * b64 + ko), (unsigned*)(d + A_BYTES + i * 4096), 16, 0, 0);
  };
  auto wait_bar = [&](int after) {
    if (NLD == 4) { if (after >= 2) WAITVL(8); else if (after == 1) WAITVL(4); else WAITVL(0); }
    else if (NLD == 3) { if (after >= 2) WAITVL(6); else if (after == 1) WAITVL(3); else WAITVL(0); }
    else { if (after >= 2) WAITVL(12); else if (after == 1) WAITVL(6); else WAITVL(0); }
    __builtin_amdgcn_s_barrier();
    asm volatile("" ::: "memory");
  };
  const int sw = (lr >> 2) & 3;
  const int aoff = (wm * 32 * MT + lr) * 64, boff = A_BYTES + (wn * 32 * NT + lr) * 64;
  const int c0 = ((0 + lh) ^ sw) * 16, c1 = ((2 + lh) ^ sw) * 16;
  auto ldk = [&](int kt, int ks, bf16x8 (&af)[MT], bf16x8 (&bfv)[NT]) {
    const char* sb = sm + (kt % NS) * STAGE + (ks ? c1 : c0);
#pragma unroll
    for (int mi = 0; mi < MT; ++mi) af[mi] = *(const bf16x8*)(sb + aoff + mi * 2048);
#pragma unroll
    for (int ni = 0; ni < NT; ++ni) bfv[ni] = *(const bf16x8*)(sb + boff + ni * 2048);
  };
  auto mmak = [&](const bf16x8 (&af)[MT], const bf16x8 (&bfv)[NT]) {
#pragma unroll
    for (int mi = 0; mi < MT; ++mi)
#pragma unroll
      for (int ni = 0; ni < NT; ++ni)
        acc[mi][ni] = SWAP ? mfma32(bfv[ni], af[mi], acc[mi][ni]) : mfma32(af[mi], bfv[ni], acc[mi][ni]);
  };
  __syncthreads();
#pragma unroll
  for (int i = 0; i < NS - 1; ++i) if (i < nk) issue(i);
  { const int after = nk - 1 < NS - 2 ? nk - 1 : NS - 2; wait_bar(after); }
  if (nk > NS - 1) issue(NS - 1);
  bf16x8 fa_a[MT], fa_b[NT], fb_a[MT], fb_b[NT];
  ldk(0, 0, fa_a, fa_b);
  for (int kt = 0; kt < nk; ++kt) {
    ldk(kt, 1, fb_a, fb_b);
    mmak(fa_a, fa_b);
    if (kt + 1 < nk) {
      { const int r = nk - 2 - kt; wait_bar(r < NS - 2 ? r : NS - 2); }
      if (kt + NS < nk) issue(kt + NS);
      ldk(kt + 1, 0, fa_a, fa_b);
    }
    mmak(fb_a, fb_b);
  }
}

struct BlkMap { int x, j, per; };
DI bool tile_map(const BlkMap bm, int k, int MTL, int NTL, int& mt, int& nt) {
  const int x = bm.x, j = bm.j, per = bm.per;
  const int u = j + per * k;
  if (u >= (MTL >> 3) * NTL) return false;
  const int q = u / (8 * NTL), rem = u - q * (8 * NTL);
  nt = rem >> 3; mt = (x + 8 * q) * 8 + (rem & 7);
  return true;
}


template <int MT>
DI void tile_store_bf16(const f32x16 (&acc)[MT][2], u16* __restrict__ dst  , int ld, char* sm) {
  const int tid = tid_(), lane = tid & 63, wid = tid >> 6, wm = wid >> 1, wn = wid & 1;
  const int lr = lane & 31, lh = lane >> 5;
  __syncthreads();
#pragma unroll
  for (int mi = 0; mi < MT; ++mi) {
    char* rowp = sm + (wm * 32 * MT + mi * 32 + lr) * 272 + (wn * 64 + 4 * lh) * 2;
#pragma unroll
    for (int ni = 0; ni < 2; ++ni)
#pragma unroll
      for (int i = 0; i < 4; ++i) {
        uint2 o; o.x = pack2(acc[mi][ni][i * 4 + 0], acc[mi][ni][i * 4 + 1]);
        o.y = pack2(acc[mi][ni][i * 4 + 2], acc[mi][ni][i * 4 + 3]);
        *(uint2*)(rowp + (ni * 32 + 8 * i) * 2) = o;
      }
  }
  __syncthreads();
  const int c = tid & 15, r0 = tid >> 4;
#pragma unroll
  for (int j = 0; j < 4 * MT; ++j) {
    const int row = r0 + 16 * j;
    typedef __attribute__((ext_vector_type(4))) unsigned u32x4s;
    const u32x4s v = *(const u32x4s*)(sm + row * 272 + c * 16);
    __builtin_nontemporal_store(v, (u32x4s*)(dst + (size_t)row * ld + c * 8));
  }
}

DI void phase_inproj(const Params& p_in, const BlkMap bm, int l, u16* sm) {
  const Params p = launder(p_in);
  const int tid = tid_(), lane = tid & 63, wid = tid >> 6, wm = wid >> 1, wn = wid & 1;
  const int lr = lane & 31, lh = lane >> 5;
  const u16* Wt = p.Wt1 + (size_t)l * NP * 1024;
  for (int k = 0;; ++k) {
    int mt, nt;
    if (!tile_map(bm, k, 128, 28, mt, nt)) break;
    const int m0 = mt * 256, n0 = nt * 128;
    f32x16 acc[4][2];
#pragma unroll
    for (int a = 0; a < 4; ++a)
#pragma unroll
      for (int b = 0; b < 2; ++b) acc[a][b] = zero16();
    gemm_loop<4, 2, 3, true>(p.xb + (size_t)m0 * 1024, 1024, Wt + (size_t)n0 * 1024, 1024, 1024, acc, sm);
    const int cg_ = (n0 + wn * 64) >> 6;
    const float* gain = p.qna; bool has = true, isq = false;
    if (cg_ < 6) { gain = p.qna; isq = true; }
    else if (cg_ < 12) gain = p.kna;
    else if (cg_ >= 24 && cg_ < 28) { gain = p.qnb; isq = true; }
    else if (cg_ == 28 || cg_ == 30 || cg_ == 32) gain = p.knb;
    else if (cg_ >= 38 && cg_ < 42) { gain = p.qnc; isq = true; }
    else if (cg_ >= 42 && cg_ < 46) gain = p.knc;
    else has = false;
    if (has) {
      gain += l * 64;
      float4 g4[2][4], c4[4], s4[4];
#pragma unroll
      for (int ni = 0; ni < 2; ++ni)
#pragma unroll
        for (int i = 0; i < 4; ++i) g4[ni][i] = *(const float4*)(gain + ni * 32 + 4 * lh + 8 * i);
#pragma unroll
      for (int mi = 0; mi < 4; ++mi) {
        const int token = m0 + wm * 128 + mi * 32 + lr;
        c4[mi] = *(const float4*)(p.rope + (size_t)token * 16 + 4 * lh);
        s4[mi] = *(const float4*)(p.rope + (size_t)token * 16 + 8 + 4 * lh);
      }
      const float qs = isq ? 0.18033688011112042f : 1.f;
#pragma unroll
      for (int mi = 0; mi < 4; ++mi) {
        float ss = 0.f;
#pragma unroll
        for (int ni = 0; ni < 2; ++ni)
#pragma unroll
          for (int r = 0; r < 16; ++r) ss += acc[mi][ni][r] * acc[mi][ni][r];
        ss = xor32_sum(ss);
        const float rs = rsqrtf(ss * (1.f / 64.f) + 1e-6f);
#pragma unroll
        for (int ni = 0; ni < 2; ++ni)
#pragma unroll
          for (int i = 0; i < 4; ++i) {
            acc[mi][ni][i * 4 + 0] *= rs * g4[ni][i].x; acc[mi][ni][i * 4 + 1] *= rs * g4[ni][i].y;
            acc[mi][ni][i * 4 + 2] *= rs * g4[ni][i].z; acc[mi][ni][i * 4 + 3] *= rs * g4[ni][i].w;
          }
        const float cc[4] = {c4[mi].x, c4[mi].y, c4[mi].z, c4[mi].w}, sn[4] = {s4[mi].x, s4[mi].y, s4[mi].z, s4[mi].w};
#pragma unroll
        for (int j = 0; j < 4; ++j) {
          const float x1 = acc[mi][0][j], x2 = acc[mi][0][4 + j];
          acc[mi][0][j] = x1 * cc[j] - x2 * sn[j];
          acc[mi][0][4 + j] = x2 * cc[j] + x1 * sn[j];
        }
        if (isq) {
#pragma unroll
          for (int ni = 0; ni < 2; ++ni)
#pragma unroll
            for (int r = 0; r < 16; ++r) acc[mi][ni][r] *= qs;
        }
      }
    }
    tile_store_bf16<4>(acc, p.proj + (size_t)m0 * NP + n0, NP, (char*)sm);
  }
}

DI void compress_item(const Params& p, int l, int kv, int rt, char* smraw) {
  const int tid = tid_(), lane = tid & 63, w = tid >> 6, lr = lane & 31, lh = lane >> 5;
  const u16* W1 = p.W1t + (size_t)((l * 2 + kv) * 128 + w * 32 + lr) * 2048 + lh * 8;
  const int col = kv ? C_VCB : C_KCB;
  const int R = rt * 32 + lr;
  f32x16 H = zero16();
#pragma unroll 1
  for (int ks0 = 0; ks0 < 128; ks0 += 8) {
    bf16x8 af[8], wf[8];
#pragma unroll
    for (int u = 0; u < 8; ++u) {
      const int ks = ks0 + u, tt = ks >> 2, d = (ks & 3) * 16 + lh * 8;
      int tokrow = R * 16 + tt; tokrow = tokrow > 32767 ? 32767 : tokrow;
      af[u] = *(const bf16x8*)(p.proj + (size_t)tokrow * NP + col + d);
      wf[u] = *(const bf16x8*)(W1 + ks * 16);
    }
#pragma unroll
    for (int u = 0; u < 8; ++u) H = mfma32(wf[u], af[u], H);
  }
  {
    const float* b1 = p.bias1 + (l * 2 + kv) * 128 + w * 32 + 4 * lh;
    unsigned hw[8];
    float4 bb4[4];
#pragma unroll
    for (int i = 0; i < 4; ++i) bb4[i] = *(const float4*)(b1 + 8 * i);
#pragma unroll
    for (int i = 0; i < 4; ++i) {
      const float4 bb = bb4[i];
      hw[i * 2] = pack2(siluf_(H[i * 4] + bb.x), siluf_(H[i * 4 + 1] + bb.y));
      hw[i * 2 + 1] = pack2(siluf_(H[i * 4 + 2] + bb.z), siluf_(H[i * 4 + 3] + bb.w));
    }
    uint4* hs = (uint4*)smraw;
    hs[(w * 2 + 0) * 64 + lane] = make_uint4(hw[0], hw[1], hw[2], hw[3]);
    hs[(w * 2 + 1) * 64 + lane] = make_uint4(hw[4], hw[5], hw[6], hw[7]);
  }
  __syncthreads();
  if (w < 2) {
    const int dt = w;
    const u16* W2 = p.W2t + (size_t)((l * 2 + kv) * 64 + dt * 32 + lr) * 128 + 4 * lh;
    const uint4* hs = (const uint4*)smraw;
    f32x16 o2 = zero16();
    uint2 wlo[8], whi[8];
#pragma unroll
    for (int ht = 0; ht < 4; ++ht)
#pragma unroll
      for (int s = 0; s < 2; ++s) {
        const u16* wp = W2 + ht * 32 + 16 * s;
        wlo[ht * 2 + s] = *(const uint2*)wp; whi[ht * 2 + s] = *(const uint2*)(wp + 8);
      }
#pragma unroll
    for (int ht = 0; ht < 4; ++ht)
#pragma unroll
      for (int s = 0; s < 2; ++s) {
        const uint2 lo = wlo[ht * 2 + s], hi = whi[ht * 2 + s];
        union { uint4 u; bf16x8 v; } cw, ch; cw.u = make_uint4(lo.x, lo.y, hi.x, hi.y);
        ch.u = hs[(ht * 2 + s) * 64 + lane];
        o2 = kv ? mfma32(ch.v, cw.v, o2) : mfma32(cw.v, ch.v, o2);
      }
    if (kv == 0) {
#pragma unroll
      for (int i = 0; i < 4; ++i) {
        uint2 o; o.x = pack2(o2[i * 4], o2[i * 4 + 1]); o.y = pack2(o2[i * 4 + 2], o2[i * 4 + 3]);
        *(uint2*)(p.kc + (size_t)R * 64 + dt * 32 + 4 * lh + 8 * i) = o;
      }
    } else {
      uint4 a, b;
      a.x = pack2(o2[0], o2[1]); a.y = pack2(o2[2], o2[3]); a.z = pack2(o2[4], o2[5]); a.w = pack2(o2[6], o2[7]);
      b.x = pack2(o2[8], o2[9]); b.y = pack2(o2[10], o2[11]); b.z = pack2(o2[12], o2[13]); b.w = pack2(o2[14], o2[15]);
      u16* dst = p.vcF + (size_t)(rt * 2 + dt) * 1024 + lane * 16;
      *(uint4*)dst = a; *(uint4*)(dst + 8) = b;
    }
  }
  __syncthreads();
}

DI void relayout_decode(const Params& p, int idx, int lr, u16*& dstbase, int& col, int& tokbase, int& tstride) {
  if (idx < 36864) {
    const int which = idx / 12288, id = idx % 12288;
    const int dt = id & 1, bh = id >> 8, b = bh / 6, h = bh % 6;
    col = C_VA + h * 64 + dt * 32 + lr;
    if (which == 0) { const int kt = (id >> 1) & 127; tokbase = b * 4096 + kt * 32; tstride = 1; dstbase = p.VA1; }
    else if (which == 1) { const int lt = (id >> 1) & 31, r4 = (id >> 6) & 3; tokbase = b * 4096 + lt * 128 + r4; tstride = 4; dstbase = p.VA4; }
    else { const int lt = (id >> 1) & 7, r = (id >> 4) & 15; tokbase = b * 4096 + lt * 512 + r; tstride = 16; dstbase = p.VA16; }
    dstbase += (size_t)id * 1024;
  } else if (idx < 40960) {
    const int which = (idx - 36864) >> 11, id = (idx - 36864) & 2047;
    const int dt = id & 1, kt = (id >> 1) & 127, b = id >> 8;
    col = (which ? C_VWB : C_VSB) + dt * 32 + lr; tokbase = b * 4096 + kt * 32; tstride = 1;
    dstbase = (which ? p.VW : p.VS) + (size_t)id * 1024;
  } else {
    const int id = idx - 40960;
    const int dt = id & 1, kt = (id >> 1) & 127, bh = id >> 8, b = bh >> 2, h = bh & 3;
    col = C_VC + h * 64 + dt * 32 + lr; tokbase = b * 4096 + kt * 32; tstride = 1;
    dstbase = p.VC + (size_t)id * 1024;
  }
}
DI void relayout4(const Params& p, int idx0) {
  const int lane = tid_() & 63, lr = lane & 31, lh = lane >> 5;
  u16* dst[4]; unsigned w[4][8];
#pragma unroll
  for (int t = 0; t < 4; ++t) {
    int col, tokbase, tstride;
    relayout_decode(p, idx0 + t, lr, dst[t], col, tokbase, tstride);
#pragma unroll
    for (int i = 0; i < 4; ++i)
#pragma unroll
      for (int jp = 0; jp < 2; ++jp) {
        const int kk = 4 * lh + 8 * i + 2 * jp;
        const unsigned oa = (unsigned)((tokbase + kk * tstride) * NP + col), ob = (unsigned)((tokbase + (kk + 1) * tstride) * NP + col);
        const u16 a = p.proj[oa];
        const u16 b = p.proj[ob];
        w[t][i * 2 + jp] = (unsigned)a | ((unsigned)b << 16);
      }
  }
#pragma unroll
  for (int t = 0; t < 4; ++t) {
    u16* d = dst[t] + lane * 16;
    *(uint4*)d = make_uint4(w[t][0], w[t][1], w[t][2], w[t][3]);
    *(uint4*)(d + 8) = make_uint4(w[t][4], w[t][5], w[t][6], w[t][7]);
  }
}

DI void kmean_item(const Params& p, int idx) {
  const int lane = tid_() & 63;
  const int blk = idx & 15, bh = idx >> 4, b = bh >> 2, h = bh & 3;
  const unsigned o0 = (unsigned)((b * 4096 + blk * 256) * NP + C_KC + h * 64 + lane);
  float s0 = 0.f, s1 = 0.f, s2 = 0.f, s3 = 0.f;
#pragma unroll 1
  for (int i = 0; i < 256; i += 16) {
    u16 v[16];
#pragma unroll
    for (int u = 0; u < 16; ++u) v[u] = p.proj[o0 + (unsigned)((i + u) * NP)];
#pragma unroll
    for (int u = 0; u < 16; u += 4) { s0 += bf2f(v[u]); s1 += bf2f(v[u + 1]); s2 += bf2f(v[u + 2]); s3 += bf2f(v[u + 3]); }
  }
  p.kmean[(size_t)idx * 64 + lane] = f2bf(((s0 + s1) + (s2 + s3)) * (1.f / 256.f));
}

DI void phase_mid(const Params& p_in, int l, char* smraw) {
  const Params p = launder(p_in);
  const int wid = tid_() >> 6;
  constexpr int N_CMP = 128, N_KM = 128, N_REL = 3072;
  for (int it = blockIdx.x; it < N_CMP + N_KM + N_REL; it += gridDim.x) {
    if (it < N_CMP) compress_item(p, l, it >> 6, it & 63, smraw);
    else if (it < N_CMP + N_KM) kmean_item(p, (it - N_CMP) * 4 + wid);
    else relayout4(p, (it - N_CMP - N_KM) * 16 + wid * 4);
  }
}

DI void attn_loadk(const u16* __restrict__ kp, bf16x8 (&kf)[4]) {
#pragma unroll
  for (int ks = 0; ks < 4; ++ks) kf[ks] = *(const bf16x8*)(kp + ks * 16);
}

typedef __attribute__((ext_vector_type(2))) float f32x2;
DI float fmax_nc(float a, float b) { return __builtin_amdgcn_fmed3f(a, b, __builtin_inff()); }
DI void attn_core(const bf16x8 (&qf)[4], const bf16x8 (&kf)[4], const bf16x8 (&vf)[2][2], const int lo, const int hi,
                   float& m, float& l, f32x16 (&O)[2], const int lh) {
  f32x16 sc = zero16();
#pragma unroll
  for (int ks = 0; ks < 4; ++ks) sc = mfma32(kf[ks], qf[ks], sc);
  const bool empty = hi < lo;
  const bool partial = !empty && (lo > 0 || hi < 31);
  if (__builtin_amdgcn_ballot_w64(partial) != 0ull) {
    const unsigned span = (unsigned)(hi - lo);
    const int base = 4 * lh - lo;
#pragma unroll
    for (int r = 0; r < 16; ++r) {
      const unsigned rel = (unsigned)(base + 8 * (r >> 2) + (r & 3));
      sc[r] = (rel <= span) ? sc[r] : -1e30f;
    }
  }
  float mx = fmax_nc(fmax_nc(fmax_nc(sc[0], sc[1]), fmax_nc(sc[2], sc[3])), fmax_nc(fmax_nc(sc[4], sc[5]), fmax_nc(sc[6], sc[7])));
  mx = fmax_nc(mx, fmax_nc(fmax_nc(fmax_nc(sc[8], sc[9]), fmax_nc(sc[10], sc[11])), fmax_nc(fmax_nc(sc[12], sc[13]), fmax_nc(sc[14], sc[15]))));
  mx = empty ? -1e30f : mx;
  mx = xor32_max(mx);
  if (__builtin_amdgcn_ballot_w64(mx > m + 16.f) != 0ull) {
    const float mn = (mx > m + 16.f) ? mx : m;
    const float alpha = __builtin_amdgcn_exp2f(m - mn);
    l *= alpha; m = mn;
#pragma unroll
    for (int dt = 0; dt < 2; ++dt)
#pragma unroll
      for (int r = 0; r < 16; ++r) O[dt][r] *= alpha;
  }
  const float meff = empty ? 3e38f : m;
  const f32x2 m2 = {meff, meff};
  f32x2 ps2 = {0.f, 0.f}; float pv[16];
#pragma unroll
  for (int r = 0; r < 16; r += 2) {
    const f32x2 s2 = {sc[r], sc[r + 1]};
    const f32x2 d2 = s2 - m2;
    const f32x2 e2 = {__builtin_amdgcn_exp2f(d2.x), __builtin_amdgcn_exp2f(d2.y)};
    pv[r] = e2.x; pv[r + 1] = e2.y; ps2 += e2;
  }
  const float ps = xor32_sum(ps2.x + ps2.y);
  l += ps;
  bf16x8 pb[2];
#pragma unroll
  for (int s = 0; s < 2; ++s)
#pragma unroll
    for (int j = 0; j < 8; ++j) pb[s][j] = (short)f2bf(pv[8 * s + j]);
#pragma unroll
  for (int dt = 0; dt < 2; ++dt)
#pragma unroll
    for (int s = 0; s < 2; ++s) O[dt] = mfma32(vf[dt][s], pb[s], O[dt]);
}

DI void attn_compute(const bf16x8 (&qf)[4], const bf16x8 (&kf)[4], const u16* __restrict__ vp, const int lo, const int hi,
                     float& m, float& l, f32x16 (&O)[2], const int lh) {
  bf16x8 vf[2][2];
#pragma unroll
  for (int dt = 0; dt < 2; ++dt)
#pragma unroll
    for (int s = 0; s < 2; ++s) vf[dt][s] = *(const bf16x8*)(vp + dt * 1024 + s * 8);
  attn_core(qf, kf, vf, lo, hi, m, l, O, lh);
}

template <class NF, class DF, class BF>
DI void attn_run_shared(const bf16x8 (&qf)[4], NF next, DF desc, BF band, float& m, float& l, f32x16 (&O)[2], char* lds) {
  const int tid = tid_(), lane = tid & 63, lr = lane & 31, lh = lane >> 5;
  int cur = next(-1);
  if (cur < 0) return;
  const int krow = tid >> 3, kc = tid & 7;
  const int kdst = krow * 128 + ((kc ^ ((krow >> 1) & 7)) * 16);
  const int vdst = 4096 + ((((tid >> 7) * 2 + (tid & 1)) * 64 + ((tid >> 1) & 63)) * 16);
  const int ksw = (lr >> 1) & 7;
  uint4 kreg, vreg;
  {
    const u16 *kb, *vt; int kst; desc(cur, kb, kst, vt);
    kreg = *(const uint4*)(kb + (size_t)krow * kst + kc * 8);
    vreg = *(const uint4*)(vt + tid * 8);
  }
  int st = 0;
#pragma unroll 1
  while (true) {
    char* buf = lds + st * 8192;
    *(uint4*)(buf + kdst) = kreg;
    *(uint4*)(buf + vdst) = vreg;
    __syncthreads();
    const int nx = next(cur);
    {
      const u16 *kb, *vt; int kst; desc(nx >= 0 ? nx : cur, kb, kst, vt);
      kreg = *(const uint4*)(kb + (size_t)krow * kst + kc * 8);
      vreg = *(const uint4*)(vt + tid * 8);
    }
    bf16x8 kf[4], vf[2][2];
#pragma unroll
    for (int ks = 0; ks < 4; ++ks) kf[ks] = *(const bf16x8*)(buf + lr * 128 + (((ks * 2 + lh) ^ ksw) * 16));
#pragma unroll
    for (int dt = 0; dt < 2; ++dt)
#pragma unroll
      for (int s2 = 0; s2 < 2; ++s2) vf[dt][s2] = *(const bf16x8*)(buf + 4096 + ((dt * 2 + s2) * 64 + lane) * 16);
    { int lo, hi; band(cur, lo, hi); attn_core(qf, kf, vf, lo, hi, m, l, O, lh); }
    if (nx < 0) break;
    st ^= 1; cur = nx;
  }
  __syncthreads();
}

DI void attn_loadv(const u16* __restrict__ vp, bf16x8 (&vf)[2][2]) {
#pragma unroll
  for (int dt = 0; dt < 2; ++dt)
#pragma unroll
    for (int s = 0; s < 2; ++s) vf[dt][s] = *(const bf16x8*)(vp + dt * 1024 + s * 8);
}
template <class NF, class DF, class BF>
DI void attn_run(const bf16x8 (&qf)[4], NF next, DF desc, BF band, float& m, float& l, f32x16 (&O)[2], const int lh) {
  int cur = next(-1);
  if (cur < 0) return;
  bf16x8 ka[4], kb[4], va[2][2], vb[2][2];
  { const u16 *kp, *vp; desc(cur, kp, vp); attn_loadk(kp, ka); attn_loadv(vp, va); }
#pragma unroll 1
  while (true) {
    const int nx = next(cur);
    { const u16 *kp, *vp; desc(nx >= 0 ? nx : cur, kp, vp); attn_loadk(kp, kb); attn_loadv(vp, vb); }
    { int lo, hi; band(cur, lo, hi); attn_core(qf, ka, va, lo, hi, m, l, O, lh); }
    if (nx < 0) break;
    const int nn = next(nx);
    { const u16 *kp, *vp; desc(nn >= 0 ? nn : nx, kp, vp); attn_loadk(kp, ka); attn_loadv(vp, va); }
    { int lo, hi; band(nx, lo, hi); attn_core(qf, kb, vb, lo, hi, m, l, O, lh); }
    if (nn < 0) break;
    cur = nn;
  }
}

template <class NF, class BF>
DI void attn_run_shared2(const bf16x8 (&qf)[4], NF next, const u16* __restrict__ kbase, const u16* __restrict__ vbase,
                         const int ntile_max, BF band2, float& m, float& l, f32x16 (&O)[2], char* lds) {
  const int tid = tid_(), lane = tid & 63, lr = lane & 31, lh = lane >> 5;
  int cur = next(-1);
  if (cur < 0) return;
  const int krow = tid >> 3, kc = tid & 7;
  const int kdst = krow * 128 + ((kc ^ ((krow >> 1) & 7)) * 16);
  const int vdst = 4096 + ((((tid >> 7) * 2 + (tid & 1)) * 64 + ((tid >> 1) & 63)) * 16);
  const int ksw = (lr >> 1) & 7;
  uint4 k0, k1, v0, v1;
  auto fetch = [&](int J) {
    const u16* kp = kbase + ((size_t)(64 * J + krow)) * NP + kc * 8;
    k0 = *(const uint4*)kp; k1 = *(const uint4*)(kp + (size_t)32 * NP);
    const u16* vp = vbase + (size_t)(2 * J) * 2048 + tid * 8;
    v0 = *(const uint4*)vp; v1 = *(const uint4*)(vp + 2048);
  };
  fetch(cur);
  int st = 0;
#pragma unroll 1
  while (true) {
    char* buf = lds + st * 16384;
    *(uint4*)(buf + kdst) = k0; *(uint4*)(buf + vdst) = v0;
    *(uint4*)(buf + 8192 + kdst) = k1; *(uint4*)(buf + 8192 + vdst) = v1;
    __syncthreads();
    const int nx = next(cur);
    fetch(nx >= 0 ? nx : cur);
#pragma unroll 1
    for (int half = 0; half < 2; ++half) {
      if (2 * cur + half > ntile_max) break;
      const char* tb = buf + half * 8192;
      bf16x8 kf[4], vf[2][2];
#pragma unroll
      for (int ks = 0; ks < 4; ++ks) kf[ks] = *(const bf16x8*)(tb + lr * 128 + (((ks * 2 + lh) ^ ksw) * 16));
#pragma unroll
      for (int dt = 0; dt < 2; ++dt)
#pragma unroll
        for (int s2 = 0; s2 < 2; ++s2) vf[dt][s2] = *(const bf16x8*)(tb + 4096 + ((dt * 2 + s2) * 64 + lane) * 16);
      int lo, hi; band2(cur, half, lo, hi);
      attn_core(qf, kf, vf, lo, hi, m, l, O, lh);
    }
    if (nx < 0) break;
    st ^= 1; cur = nx;
  }
  __syncthreads();
}
#define M_INIT (-1e4f)
#define BIG 100000

DI void store_gated(const u16* zrow  , u16* orow  , const f32x16 (&O)[2]) {
  const int lh = (tid_() & 63) >> 5;
  const u16* z0 = zrow - 4 * lh + 8 * lh;
  u16* o0 = orow - 4 * lh + 8 * lh;
  uint4 zz[2][2];
#pragma unroll
  for (int dt = 0; dt < 2; ++dt)
#pragma unroll
    for (int a = 0; a < 2; ++a) zz[dt][a] = *(const uint4*)(z0 + dt * 32 + 16 * a);
#pragma unroll
  for (int dt = 0; dt < 2; ++dt)
#pragma unroll
    for (int a = 0; a < 2; ++a) {
      const u32x2_t rx = __builtin_amdgcn_permlane32_swap(zz[dt][a].x, zz[dt][a].z, false, false);
      const u32x2_t ry = __builtin_amdgcn_permlane32_swap(zz[dt][a].y, zz[dt][a].w, false, false);
      const unsigned zA0 = rx[0], zA1 = ry[0], zB0 = rx[1], zB1 = ry[1];
      const int iA = (2 * a) * 4, iB = (2 * a + 1) * 4;
      unsigned oA0 = pack2(O[dt][iA] * siluf_(bf2f((u16)(zA0 & 0xffff))), O[dt][iA + 1] * siluf_(bf2f((u16)(zA0 >> 16))));
      unsigned oA1 = pack2(O[dt][iA + 2] * siluf_(bf2f((u16)(zA1 & 0xffff))), O[dt][iA + 3] * siluf_(bf2f((u16)(zA1 >> 16))));
      unsigned oB0 = pack2(O[dt][iB] * siluf_(bf2f((u16)(zB0 & 0xffff))), O[dt][iB + 1] * siluf_(bf2f((u16)(zB0 >> 16))));
      unsigned oB1 = pack2(O[dt][iB + 2] * siluf_(bf2f((u16)(zB1 & 0xffff))), O[dt][iB + 3] * siluf_(bf2f((u16)(zB1 >> 16))));
      const u32x2_t sx = __builtin_amdgcn_permlane32_swap(oA0, oB0, false, false);
      const u32x2_t sy = __builtin_amdgcn_permlane32_swap(oA1, oB1, false, false);
      *(uint4*)(o0 + dt * 32 + 16 * a) = make_uint4(sx[0], sy[0], sx[1], sy[1]);
    }
}

DI void mixA_far_item(const Params& p, int b, int h, int T0, int r) {
  const int lane = tid_() & 63, lr = lane & 31, lh = lane >> 5;
  const int tq = T0 + r + 16 * lr;
  const size_t rowq = (size_t)b * 4096 + tq;
  const u16* proj = p.proj;
  bf16x8 qf[4];
  {
    const u16* qp = proj + rowq * NP + C_QA + h * 64 + lh * 8;
#pragma unroll
    for (int ks = 0; ks < 4; ++ks) qf[ks] = *(const bf16x8*)(qp + ks * 16);
  }
  float m = M_INIT, l = 0.f; f32x16 O[2]; O[0] = zero16(); O[1] = zero16();
  const int kcol = C_KA + h * 64 + lh * 8;
  {
    const size_t bh = (size_t)(b * 6 + h);
    auto lbase_of = [&](int id) { return (T0 >> 4) - 128 + 32 * (4 - id); };
    auto next = [&](int prev) {
      int id = prev + 1;
      while (id < 5 && lbase_of(id) < 0) ++id;
      return id < 5 ? id : -1;
    };
    auto desc = [&](int id, const u16*& kp, const u16*& vp) {
      const int lbase = lbase_of(id);
      const int tk = (lbase + lr) * 16 + r;
      vp = p.VA16 + (((bh * 16 + r) * 8 + (size_t)(lbase >> 5)) * 2) * 1024 + lane * 16;
      kp = proj + ((size_t)b * 4096 + tk) * NP + kcol;
    };
    auto band = [&](int id, int& lo, int& hi) { hi = (T0 >> 4) + lr - lbase_of(id); lo = hi - 128; };
    attn_run(qf, next, desc, band, m, l, O, lh);
  }
  if (lh == 0) { float2 ml; ml.x = m; ml.y = l; *(float2*)(p.mlA + (rowq * 6 + h) * 2) = ml; }
  u16* orow = p.obuf + rowq * 896 + h * 64 + 4 * lh;
#pragma unroll
  for (int dt = 0; dt < 2; ++dt)
#pragma unroll
    for (int i = 0; i < 4; ++i) {
      uint2 o; o.x = pack2(O[dt][i * 4], O[dt][i * 4 + 1]); o.y = pack2(O[dt][i * 4 + 2], O[dt][i * 4 + 3]);
      *(uint2*)(orow + dt * 32 + 8 * i) = o;
    }
}

DI void mixA_item(const Params& p, int b, int h, int T0, int r4) {
  const int lane = tid_() & 63, lr = lane & 31, lh = lane >> 5;
  const int tq = T0 + r4 + 4 * lr;
  const size_t rowq = (size_t)b * 4096 + tq;
  const u16* proj = p.proj;
  bf16x8 qf[4];
  {
    const u16* qp = proj + rowq * NP + C_QA + h * 64 + lh * 8;
#pragma unroll
    for (int ks = 0; ks < 4; ++ks) qf[ks] = *(const bf16x8*)(qp + ks * 16);
  }
  float m, l; f32x16 O[2];
  {
    const float2 ml = *(const float2*)(p.mlA + (rowq * 6 + h) * 2);
    m = ml.x; l = ml.y;
    const u16* orow = p.obuf + rowq * 896 + h * 64 + 4 * lh;
#pragma unroll
    for (int dt = 0; dt < 2; ++dt)
#pragma unroll
      for (int i = 0; i < 4; ++i) {
        const uint2 o = *(const uint2*)(orow + dt * 32 + 8 * i);
        O[dt][i * 4] = bf2f((u16)(o.x & 0xffff)); O[dt][i * 4 + 1] = bf2f((u16)(o.x >> 16));
        O[dt][i * 4 + 2] = bf2f((u16)(o.y & 0xffff)); O[dt][i * 4 + 3] = bf2f((u16)(o.y >> 16));
      }
  }
  const int kcol = C_KA + h * 64 + lh * 8;
  {
    const size_t bh = (size_t)(b * 6 + h);
    auto lbase_of = [&](int id) { return id < 5 ? (T0 >> 2) - 128 + 32 * id : T0 - 128 + 32 * (id - 5); };
    auto next = [&](int prev) {
      int id = prev + 1;
      while (id < 13 && lbase_of(id) < 0) ++id;
      return id < 13 ? id : -1;
    };
    auto desc = [&](int id, const u16*& kp, const u16*& vp) {
      const int lbase = lbase_of(id);
      const size_t lt = (size_t)(lbase >> 5);
      int tk;
      if (id < 5) { tk = (lbase + lr) * 4 + r4; vp = p.VA4 + (((bh * 4 + r4) * 32 + lt) * 2) * 1024 + lane * 16; }
      else { tk = lbase + lr; vp = p.VA1 + ((bh * 128 + lt) * 2) * 1024 + lane * 16; }
      kp = proj + ((size_t)b * 4096 + tk) * NP + kcol;
    };
    auto band = [&](int id, int& lo, int& hi) {
      hi = (id < 5 ? (T0 >> 2) + lr : tq) - lbase_of(id);
      lo = hi - 128;
    };
    attn_run(qf, next, desc, band, m, l, O, lh);
  }
  const float inv = 1.f / l;
#pragma unroll
  for (int dt = 0; dt < 2; ++dt)
#pragma unroll
    for (int rr = 0; rr < 16; ++rr) O[dt][rr] *= inv;
  store_gated(p.proj + rowq * NP + C_ZA + h * 64 + 4 * lh, p.obuf + rowq * 896 + h * 64 + 4 * lh, O);
}

DI int moba_seg_col(int h, int k) {
  const int s = h * 3 + k;
  return s < 6 ? C_VA + 64 * s : (s < 10 ? C_VC + 64 * (s - 6) : (s == 10 ? C_VSB : C_VWB));
}

DI unsigned moba_select(const Params& p, const bf16x8 (&qf)[4], int b, int h, int bo, int lr, int lh) {
  const u16* kmp = p.kmean + ((size_t)(b * 4 + h) * 16 + (lr & 15)) * 64 + lh * 8;
  f32x16 s = zero16();
#pragma unroll
  for (int ks = 0; ks < 4; ++ks) s = mfma32(*(const bf16x8*)(kmp + ks * 16), qf[ks], s);
  float own[8], oth[8];
#pragma unroll
  for (int x = 0; x < 8; ++x) {
    const int n = 8 * (x >> 2) + 4 * lh + (x & 3);
    own[x] = n < bo ? s[x] : -1e30f;
  }
#pragma unroll
  for (int x = 0; x < 8; ++x) oth[x] = xor32_get(own[x], lh);
  unsigned mymask = 0;
#pragma unroll
  for (int x = 0; x < 8; ++x) {
    const int nx = 8 * (x >> 2) + 4 * lh + (x & 3);
    int rank = 0;
#pragma unroll
    for (int y = 0; y < 8; ++y) {
      const int ny = 8 * (y >> 2) + 4 * lh + (y & 3);
      const int no = 8 * (y >> 2) + 4 * (1 - lh) + (y & 3);
      if (y != x) rank += (own[y] > own[x]) || (own[y] == own[x] && ny < nx);
      rank += (oth[y] > own[x]) || (oth[y] == own[x] && no < nx);
    }
    if (rank < 3 && nx < bo) mymask |= 1u << nx;
  }
  mymask = xor32_or(mymask);
  return mymask;
}

DI void moba_mask_item(const Params& p, int b, int h, int qt) {
  const int lane = tid_() & 63, lr = lane & 31, lh = lane >> 5;
  const int bo = qt >> 3;
  unsigned mask = 0;
  if (bo > 0) {
    bf16x8 qf[4];
    const u16* qp = p.proj + ((size_t)b * 4096 + qt * 32 + lr) * NP + C_QC + h * 64 + lh * 8;
#pragma unroll
    for (int ks = 0; ks < 4; ++ks) qf[ks] = *(const bf16x8*)(qp + ks * 16);
    mask = moba_select(p, qf, b, h, bo, lr, lh);
  }
  if (lh == 0) p.selm16[(size_t)(b * 4 + h) * 4096 + qt * 32 + lr] = (u16)mask;
}

DI void moba_list_item(const Params& p, int b, int h, int n) {
  const int lane = tid_() & 63;
  const u16* selm = p.selm16 + (size_t)(b * 4 + h) * 4096;
  u16* lst = p.mlist + ((size_t)(b * 4 + h) * 16 + n) * 4096;
  int base = 0;
#pragma unroll 1
  for (int t0 = 256 * (n + 1); t0 < 4096; t0 += 512) {
    unsigned mk[8];
#pragma unroll
    for (int i = 0; i < 8; ++i) { const int t = t0 + 64 * i + lane; mk[i] = t < 4096 ? (unsigned)selm[t] : 0u; }
#pragma unroll
    for (int i = 0; i < 8; ++i) {
      const bool f = (mk[i] >> n) & 1u;
      const unsigned long long bal = __ballot(f);
      const int pos = base + __popcll(bal & ((1ull << lane) - 1ull));
      if (f) lst[pos] = (u16)(t0 + 64 * i + lane);
      base += __popcll(bal);
    }
  }
  if (lane == 0) p.mcnt[(b * 4 + h) * 16 + n] = base;
}

DI int moba_part_token(const Params& p, int bh, int n, int c, int cntn) {
  const int lr = tid_() & 31;
  const u16* lst = p.mlist + ((size_t)bh * 16 + n) * 4096;
  const int idx = c * 32 + lr;
  return (int)lst[idx < cntn ? idx : cntn - 1];
}
DI void moba_part_item(const Params& p, int b, int h, int n, int c, const int cntn, const int t) {
  const int lane = tid_() & 63, lr = lane & 31, lh = lane >> 5;
  const bool valid = c * 32 + lr < cntn;
  const size_t rowq = (size_t)b * 4096 + t;
  const unsigned mk = p.selm16[(size_t)(b * 4 + h) * 4096 + t];
  const u16* proj = p.proj;
  bf16x8 qf[4];
  {
    const u16* qp = proj + rowq * NP + C_QC + h * 64 + lh * 8;
#pragma unroll
    for (int ks = 0; ks < 4; ++ks) qf[ks] = *(const bf16x8*)(qp + ks * 16);
  }
  float m = M_INIT, l = 0.f; f32x16 O[2]; O[0] = zero16(); O[1] = zero16();
  {
    const size_t krow0 = (size_t)b * 4096;
    const int kcol = C_KC + h * 64 + lh * 8;
    const u16* vbase = p.VC + ((size_t)(b * 4 + h) * 128 * 2) * 1024 + lane * 16;
    const int kt0 = n * 8;
    attn_run(qf, [&](int prev) { return prev < 0 ? kt0 : (prev + 1 < kt0 + 8 ? prev + 1 : -1); },
             [&](int kt, const u16*& kp, const u16*& vp) { kp = proj + (krow0 + kt * 32 + lr) * NP + kcol; vp = vbase + (size_t)kt * 2048; },
             [&](int, int& lo, int& hi) { lo = -BIG; hi = BIG; }, m, l, O, lh);
  }
  const int k = __popc(mk & ((1u << n) - 1u));
  if (valid) {
    if (lh == 0) { float2 ml; ml.x = m; ml.y = l; *(float2*)(p.mlC + ((rowq * 4 + h) * 3 + k) * 2) = ml; }
    u16* orow = p.proj + rowq * NP + moba_seg_col(h, k) + 4 * lh;
#pragma unroll
    for (int dt = 0; dt < 2; ++dt)
#pragma unroll
      for (int i = 0; i < 4; ++i) {
        uint2 o; o.x = pack2(O[dt][i * 4], O[dt][i * 4 + 1]); o.y = pack2(O[dt][i * 4 + 2], O[dt][i * 4 + 3]);
        *(uint2*)(orow + dt * 32 + 8 * i) = o;
      }
  }
}

DI void moba_item(const Params& p, int b, int h, int qt) {
  const int lane = tid_() & 63, lr = lane & 31, lh = lane >> 5;
  const int t0 = qt * 32, bo = qt >> 3, tq = t0 + lr;
  const size_t rowq = (size_t)b * 4096 + tq;
  const u16* proj = p.proj;
  bf16x8 qf[4];
  {
    const u16* qp = proj + rowq * NP + C_QC + h * 64 + lh * 8;
#pragma unroll
    for (int ks = 0; ks < 4; ++ks) qf[ks] = *(const bf16x8*)(qp + ks * 16);
  }
  float m = M_INIT, l = 0.f; f32x16 O[2]; O[0] = zero16(); O[1] = zero16();
  if (bo > 0) {
    const unsigned mk = p.selm16[(size_t)(b * 4 + h) * 4096 + tq];
    const int nsel = __popc(mk);
#pragma unroll
    for (int k = 0; k < 3; ++k) {
      const bool has = k < nsel;
      const float2 ml = *(const float2*)(p.mlC + ((rowq * 4 + h) * 3 + k) * 2);
      const float mk_ = has ? ml.x : -1e30f, lk = has ? ml.y : 0.f;
      const float mn = fmaxf(m, mk_);
      const float a = __builtin_amdgcn_exp2f(m - mn), bs = has ? __builtin_amdgcn_exp2f(mk_ - mn) : 0.f;
      l = l * a + lk * bs; m = mn;
      const u16* orow = proj + rowq * NP + moba_seg_col(h, k) + 4 * lh;
#pragma unroll
      for (int dt = 0; dt < 2; ++dt)
#pragma unroll
        for (int i = 0; i < 4; ++i) {
          const uint2 o = *(const uint2*)(orow + dt * 32 + 8 * i);
          const float o0 = has ? bf2f((u16)(o.x & 0xffff)) : 0.f, o1 = has ? bf2f((u16)(o.x >> 16)) : 0.f;
          const float o2 = has ? bf2f((u16)(o.y & 0xffff)) : 0.f, o3 = has ? bf2f((u16)(o.y >> 16)) : 0.f;
          O[dt][i * 4] = O[dt][i * 4] * a + o0 * bs; O[dt][i * 4 + 1] = O[dt][i * 4 + 1] * a + o1 * bs;
          O[dt][i * 4 + 2] = O[dt][i * 4 + 2] * a + o2 * bs; O[dt][i * 4 + 3] = O[dt][i * 4 + 3] * a + o3 * bs;
        }
    }
  }
  {
    const size_t krow0 = (size_t)b * 4096;
    const int kcol = C_KC + h * 64 + lh * 8;
    const u16* vbase = p.VC + ((size_t)(b * 4 + h) * 128 * 2) * 1024 + lane * 16;
    attn_run(qf, [&](int prev) { return prev < 0 ? qt : (prev == qt ? (bo * 8 < qt ? bo * 8 : -1) : (prev + 1 < qt ? prev + 1 : -1)); },
             [&](int kt, const u16*& kp, const u16*& vp) { kp = proj + (krow0 + kt * 32 + lr) * NP + kcol; vp = vbase + (size_t)kt * 2048; },
             [&](int kt, int& lo, int& hi) { lo = -BIG; hi = kt == qt ? lr : BIG; }, m, l, O, lh);
  }
  const float inv = 1.f / l;
#pragma unroll
  for (int dt = 0; dt < 2; ++dt)
#pragma unroll
    for (int rr = 0; rr < 16; ++rr) O[dt][rr] *= inv;
  store_gated(p.proj + rowq * NP + C_ZC + h * 64 + 4 * lh, p.obuf + rowq * 896 + 640 + h * 64 + 4 * lh, O);
}

DI void nsa_item(const Params& p, int b, int qt, char* smraw) {
  float* pslc = (float*)smraw;
  unsigned* selm = (unsigned*)(smraw + 33280);
  const int tid = tid_(), lane = tid & 63, g = tid >> 6, lr = lane & 31, lh = lane >> 5;
  const int t0 = qt * 32, tq = t0 + lr;
  const size_t rowq = (size_t)b * 4096 + tq;
  const u16* proj = p.proj;
  bf16x8 qf[4];
  {
    const u16* qp = proj + rowq * NP + C_QB + g * 64 + lh * 8;
#pragma unroll
    for (int ks = 0; ks < 4; ++ks) qf[ks] = *(const bf16x8*)(qp + ks * 16);
  }
  const int nvq = tq >= 31 ? ((tq - 31) >> 4) + 1 : 0;
  const int nct = ((t0 >> 4) + 1 + 31) >> 5;
  float m_c = M_INIT, l_c = 0.f; f32x16 Oc[2]; Oc[0] = zero16(); Oc[1] = zero16();
  const u16* kcb = p.kc + (size_t)b * 256 * 64 + lh * 8;
  const u16* vcb = p.vcF + (size_t)b * 16 * 1024 + lane * 16;
  char* kvlds = smraw + 34816;
  attn_run_shared(qf, [&](int prev) { return prev + 1 < nct ? prev + 1 : -1; },
                  [&](int ct, const u16*& kb, int& kst, const u16*& vt) {
                    kb = p.kc + ((size_t)b * 256 + ct * 32) * 64; kst = 64; vt = p.vcF + ((size_t)b * 8 + ct) * 2048;
                  },
                  [&](int ct, int& lo, int& hi) { lo = -BIG; hi = nvq - 1 - ct * 32; }, m_c, l_c, Oc, kvlds);
  const float invc = l_c > 0.f ? 1.f / l_c : 0.f;
  const u16* gp = proj + rowq * NP + C_GB + g;
  const u16 gq0 = gp[0], gq1 = gp[4], gq2 = gp[8];
  unsigned Opk[2][8];
  {
    const float g0 = sigmoidf_(bf2f(gq0)) * invc;
#pragma unroll
    for (int dt = 0; dt < 2; ++dt)
#pragma unroll
      for (int rr = 0; rr < 8; ++rr) Opk[dt][rr] = pack2(g0 * Oc[dt][2 * rr], g0 * Oc[dt][2 * rr + 1]);
  }
  {
    float carry = 0.f;
    const int ptid = tid_(), krow = ptid >> 3, kc = ptid & 7;
    const int kdst = krow * 128 + ((kc ^ ((krow >> 1) & 7)) * 16);
    const int ksw = (lr >> 1) & 7;
    const u16* kcg = p.kc + (size_t)b * 256 * 64 + (size_t)krow * 64 + kc * 8;
    uint4 kreg = *(const uint4*)kcg;
#pragma unroll 1
    for (int ct = 0; ct < 8; ++ct) {
      float tot[4] = {0.f, 0.f, 0.f, 0.f};
      if (ct < nct) {
        char* buf = kvlds + (ct & 1) * 8192;
        *(uint4*)(buf + kdst) = kreg;
        __syncthreads();
        kreg = *(const uint4*)(kcg + (size_t)(ct + 1 < nct ? ct + 1 : ct) * 32 * 64);
        f32x16 sc = zero16();
#pragma unroll
        for (int ks = 0; ks < 4; ++ks)
          sc = mfma32(*(const bf16x8*)(buf + lr * 128 + (((ks * 2 + lh) ^ ksw) * 16)), qf[ks], sc);
        float gs[4], sp[4];
#pragma unroll
        for (int i = 0; i < 4; ++i) {
          float s4 = 0.f, last = 0.f;
#pragma unroll
          for (int j = 0; j < 4; ++j) {
            const int c = ct * 32 + 4 * lh + 8 * i + j;
            const float e = (c < nvq) ? __builtin_amdgcn_exp2f(sc[i * 4 + j] - m_c) * invc : 0.f;
            s4 += e; last = e;
          }
          gs[i] = s4; sp[i] = last;
        }
        float ps[4];
#pragma unroll
        for (int i = 0; i < 4; ++i) ps[i] = xor32_get(sp[i], lh);
        if (lh) {
#pragma unroll
          for (int i = 0; i < 4; ++i) tot[i] = gs[i] + ps[i];
        } else {
          tot[0] = gs[0] + carry; tot[1] = gs[1] + ps[0]; tot[2] = gs[2] + ps[1]; tot[3] = gs[3] + ps[2];
          carry = ps[3];
        }
      } else {
        if (!lh) { tot[0] = carry; carry = 0.f; }
      }
#pragma unroll
      for (int i = 0; i < 4; ++i) pslc[(g * 32 + lr) * 65 + ct * 8 + 2 * i + lh] = tot[i];
    }
  }
  __syncthreads();
#pragma unroll 1
  for (int qi = 0; qi < 8; ++qi) {
    const int q = g * 8 + qi, J = lane, tqq = t0 + q, cur = tqq >> 6;
    const bool forced = (J == 0) || (J == cur) || (J == cur - 1);
    const bool valid = (J * 64 <= tqq);
    const float psum = ((pslc[(0 * 32 + q) * 65 + J] + pslc[(1 * 32 + q) * 65 + J]) + pslc[(2 * 32 + q) * 65 + J]) + pslc[(3 * 32 + q) * 65 + J];
    const float scv = forced ? 1e4f : (valid ? psum : -1e30f);
    int rank = 0;
#pragma unroll 4
    for (int j2 = 0; j2 < 64; ++j2) {
      const float o = __int_as_float(__builtin_amdgcn_readlane(__float_as_int(scv), j2));
      rank += ((o > scv) || (o == scv && j2 < J)) ? 1 : 0;
    }
    const bool sel = (rank < 16) && valid;
    const unsigned long long mk = __ballot(sel);
    if (lane == 0) { selm[q * 2] = (unsigned)mk; selm[q * 2 + 1] = (unsigned)(mk >> 32); }
  }
  __syncthreads();
  const unsigned mlo = selm[lr * 2], mhi = selm[lr * 2 + 1];
  unsigned alo = mlo, ahi = mhi;
#pragma unroll
  for (int o = 1; o < 32; o <<= 1) { alo |= __shfl_xor(alo, o); ahi |= __shfl_xor(ahi, o); }
  alo = __builtin_amdgcn_readfirstlane(alo); ahi = __builtin_amdgcn_readfirstlane(ahi);
  float m_s = M_INIT, l_s = 0.f; f32x16 Os[2]; Os[0] = zero16(); Os[1] = zero16();
  {
    const u16* vb = p.VS + ((size_t)b * 128 * 2) * 1024 + lane * 16;
    const unsigned long long any64 = ((unsigned long long)ahi << 32) | alo;
    const unsigned long long my64 = ((unsigned long long)mhi << 32) | mlo;
    const int Jmax = qt >> 1;
    auto next = [&](int prevJ) {
      const int J0 = prevJ + 1;
      if (J0 > Jmax) return -1;
      const unsigned long long mk = any64 >> J0;
      if (!mk) return -1;
      const int J = J0 + __builtin_ctzll(mk);
      return J <= Jmax ? J : -1;
    };
    auto band2 = [&](int J, int half, int& lo, int& hi) {
      lo = -BIG; hi = ((my64 >> J) & 1ull) ? tq - (2 * J + half) * 32 : -2 * BIG;
    };
    attn_run_shared2(qf, next, proj + ((size_t)b * 4096) * NP + C_KSB, p.VS + ((size_t)b * 128) * 2048, qt, band2, m_s, l_s, Os, kvlds);
  }
  {
    const float g1 = sigmoidf_(bf2f(gq1)) / l_s;
#pragma unroll
    for (int dt = 0; dt < 2; ++dt)
#pragma unroll
      for (int rr = 0; rr < 8; ++rr)
        Opk[dt][rr] = pack2(bf2f((u16)(Opk[dt][rr] & 0xffff)) + g1 * Os[dt][2 * rr], bf2f((u16)(Opk[dt][rr] >> 16)) + g1 * Os[dt][2 * rr + 1]);
  }
  m_s = M_INIT; l_s = 0.f; Os[0] = zero16(); Os[1] = zero16();
  {
    const u16* vb = p.VW + ((size_t)b * 128 * 2) * 1024 + lane * 16;
    const int klo = qt - 16 < 0 ? 0 : qt - 16;
    attn_run_shared(qf, [&](int prev) { return prev < 0 ? qt : (prev - 1 >= klo ? prev - 1 : -1); },
                    [&](int kt, const u16*& kb, int& kst, const u16*& vt) {
                      kb = proj + ((size_t)b * 4096 + kt * 32) * NP + C_KWB; kst = NP; vt = p.VW + ((size_t)b * 128 + kt) * 2048;
                    },
                    [&](int kt, int& lo, int& hi) { hi = tq - kt * 32; lo = hi - 511; }, m_s, l_s, Os, kvlds);
  }
  {
    const float g2 = sigmoidf_(bf2f(gq2)) / l_s;
#pragma unroll
    for (int dt = 0; dt < 2; ++dt)
#pragma unroll
      for (int rr = 0; rr < 8; ++rr) {
        Os[dt][2 * rr] = bf2f((u16)(Opk[dt][rr] & 0xffff)) + g2 * Os[dt][2 * rr];
        Os[dt][2 * rr + 1] = bf2f((u16)(Opk[dt][rr] >> 16)) + g2 * Os[dt][2 * rr + 1];
      }
  }
  store_gated(p.proj + rowq * NP + C_ZB + g * 64 + 4 * lh, p.obuf + rowq * 896 + 384 + g * 64 + 4 * lh, Os);
  __syncthreads();
}

DI void phase_attn_far(const Params& p_in, const BlkMap bm) {
  const Params p = launder(p_in);
  const int wid = tid_() >> 6;
  for (int it = bm.j * 4 + wid; it < 512; it += bm.per * 4) {
    const int bh = bm.x + 8 * (it >> 7);
    moba_mask_item(p, bh >> 2, bh & 3, it & 127);
  }
  for (int w = bm.j; w < 192; w += bm.per) {
    const int bh = bm.x + 8 * (w >> 5), sub = w & 31;
    mixA_far_item(p, bh / 6, bh % 6, (sub >> 2) * 512, (sub & 3) * 4 + wid);
  }
}

DI void phase_attn_lists(const Params& p_in, const BlkMap bm) {
  const Params p = launder(p_in);
  const int wid = tid_() >> 6;
  for (int it = bm.j * 4 + wid; it < 60; it += bm.per * 4) {
    const int bh = bm.x + 8 * (it / 15);
    moba_list_item(p, bh >> 2, bh & 3, it % 15);
  }
}

DI void phase_attn(const Params& p_in, const BlkMap bm, char* smraw) {
  const Params p = launder(p_in);
  const int wid = tid_() >> 6;
  for (int w = bm.j; w < 128; w += bm.per) {
    const int qt = w < 64 ? 127 - w : w - 64;
    nsa_item(p, bm.x, qt, smraw);
  }
  for (int w = bm.j; w < 192; w += bm.per) {
    const int bh = bm.x + 8 * (w >> 5), sub = w & 31;
    mixA_item(p, bh / 6, bh % 6, sub * 128, wid);
  }
  {
    const int nwv = bm.per * 4;
    int tot[4];
#pragma unroll
    for (int i = 0; i < 4; ++i) {
      const int* cnt = p.mcnt + (bm.x + 8 * i) * 16;
      int tt = 0;
#pragma unroll 1
      for (int n = 0; n < 15; ++n) tt += (cnt[n] + 31) >> 5;
      tot[i] = tt;
    }
    const int ntot = tot[0] + tot[1] + tot[2] + tot[3];
    auto decode = [&](int it, int& bh, int& n, int& c, int& cntn) {
      int f = it, i = 0;
      if (f >= tot[0]) { f -= tot[0]; i = 1; if (f >= tot[1]) { f -= tot[1]; i = 2; if (f >= tot[2]) { f -= tot[2]; i = 3; } } }
      bh = bm.x + 8 * i;
      const int* cnt = p.mcnt + bh * 16;
      n = 0; cntn = cnt[0];
#pragma unroll 1
      for (; n < 14; ++n) { const int ch = (cntn + 31) >> 5; if (f < ch) break; f -= ch; cntn = cnt[n + 1]; }
      c = f;
    };
    int it = bm.j * 4 + wid;
    if (it < ntot) {
      int bh, n, c, cntn; decode(it, bh, n, c, cntn);
      int t = moba_part_token(p, bh, n, c, cntn);
#pragma unroll 1
      while (true) {
        const int it2 = it + nwv;
        const bool more = it2 < ntot;
        int bh2 = bh, n2 = n, c2 = c, cntn2 = cntn;
        if (more) decode(it2, bh2, n2, c2, cntn2);
        const int t2 = moba_part_token(p, bh2, n2, c2, cntn2);
        moba_part_item(p, bh >> 2, bh & 3, n, c, cntn, t);
        if (!more) break;
        it = it2; bh = bh2; n = n2; c = c2; cntn = cntn2; t = t2;
      }
    }
  }
}

DI void phase_attn_fin(const Params& p_in, const BlkMap bm) {
  const Params p = launder(p_in);
  const int wid = tid_() >> 6;
  for (int w = bm.j; w < 128; w += bm.per) {
    const int bh = bm.x + 8 * (w >> 5), qg = w & 31;
    moba_item(p, bh >> 2, bh & 3, qg * 4 + wid);
  }
}

DI void phase_merge(const Params& p_in, const BlkMap bm, int l, u16* sm) {
  const Params p = launder(p_in);
  const int tid = tid_(), lane = tid & 63, wid = tid >> 6, wm = wid >> 1, wn = wid & 1;
  const int lr = lane & 31, lh = lane >> 5;
  const u16* Wbr = p.Wbr + (size_t)l * 1024 * 896;
  const u16* Wg = p.Wg + (size_t)l * 3072 * 1024;
  for (int k = 0;; ++k) {
    int mt, nt;
    if (!tile_map(bm, k, 256, 8, mt, nt)) break;
    const int m0 = mt * 128, n0 = nt * 128;
    f32x16 yacc[2][2];
#pragma unroll
    for (int a = 0; a < 2; ++a)
#pragma unroll
      for (int b = 0; b < 2; ++b) yacc[a][b] = zero16();
#pragma unroll 1
    for (int br = 0; br < 3; ++br) {
      const int kofs = br == 0 ? 0 : (br == 1 ? 384 : 640);
      const int Kb = br == 0 ? 384 : 256;
      unsigned sg[2][2][8];
      {
        f32x16 gg[2][2];
#pragma unroll
        for (int a = 0; a < 2; ++a)
#pragma unroll
          for (int b = 0; b < 2; ++b) gg[a][b] = zero16();
        gemm_loop<2, 2, 4, true>(p.xb + (size_t)m0 * 1024, 1024, Wg + (size_t)(br * 1024 + n0) * 1024, 1024, 1024, gg, sm);
#pragma unroll
        for (int a = 0; a < 2; ++a)
#pragma unroll
          for (int b = 0; b < 2; ++b)
#pragma unroll
            for (int r = 0; r < 8; ++r) sg[a][b][r] = pack2(sigmoidf_(gg[a][b][2 * r]), sigmoidf_(gg[a][b][2 * r + 1]));
      }
      f32x16 u[2][2];
#pragma unroll
      for (int a = 0; a < 2; ++a)
#pragma unroll
        for (int b = 0; b < 2; ++b) u[a][b] = zero16();
      gemm_loop<2, 2, 4, true>(p.obuf + (size_t)m0 * 896 + kofs, 896, Wbr + (size_t)n0 * 896 + kofs, 896, Kb, u, sm);
#pragma unroll
      for (int a = 0; a < 2; ++a)
#pragma unroll
        for (int b = 0; b < 2; ++b)
#pragma unroll
          for (int r = 0; r < 8; ++r) {
            yacc[a][b][2 * r] += bf2f((u16)(sg[a][b][r] & 0xffff)) * u[a][b][2 * r];
            yacc[a][b][2 * r + 1] += bf2f((u16)(sg[a][b][r] >> 16)) * u[a][b][2 * r + 1];
          }
    }
    tile_store_bf16<2>(yacc, p.y + (size_t)m0 * 1024 + n0, 1024, (char*)sm);
  }
}

DI void phase_out(const Params& p_in, const BlkMap bm, int l, const float* xres, u16* sm) {
  const Params p = launder(p_in);
  const int tid = tid_(), lane = tid & 63, wid = tid >> 6, wm = wid >> 1, wn = wid & 1;
  const int lr = lane & 31, lh = lane >> 5;
  const u16* Wo = p.Wout + (size_t)l * 1024 * 1024;
  for (int k = 0;; ++k) {
    int mt, nt;
    if (!tile_map(bm, k, 128, 8, mt, nt)) break;
    const int m0 = mt * 256, n0 = nt * 128;
    f32x16 acc[4][2];
#pragma unroll
    for (int a = 0; a < 4; ++a)
#pragma unroll
      for (int b = 0; b < 2; ++b) acc[a][b] = zero16();
    gemm_loop<4, 2, 3, false>(p.y + (size_t)m0 * 1024, 1024, Wo + (size_t)n0 * 1024, 1024, 1024, acc, sm);
#pragma unroll
    for (int mi = 0; mi < 4; ++mi) {
      float res[2][16];
#pragma unroll
      for (int ni = 0; ni < 2; ++ni)
#pragma unroll
        for (int r = 0; r < 16; ++r) {
          const int row = m0 + wm * 128 + mi * 32 + 4 * lh + 8 * (r >> 2) + (r & 3);
          res[ni][r] = __builtin_nontemporal_load(xres + (size_t)row * 1024 + n0 + wn * 64 + ni * 32 + lr);
        }
#pragma unroll
      for (int ni = 0; ni < 2; ++ni)
#pragma unroll
        for (int r = 0; r < 16; ++r) {
          const int row = m0 + wm * 128 + mi * 32 + 4 * lh + 8 * (r >> 2) + (r & 3);
          __builtin_nontemporal_store(res[ni][r] + acc[mi][ni][r], p.out + (size_t)row * 1024 + n0 + wn * 64 + ni * 32 + lr);
        }
    }
  }
}

#define XB_TMO      128
#define XB_XCNT(j)  (256  + 64 * (j))
#define XB_XSUB(j)  (1280 + 64 * (j))
#define XB_XGEN(j)  (2304 + 64 * (j))
#define XB_TOP      3328
#define XB_TOPGEN   3392
#define XB_RANK(j)  (3456 + 64 * (j))
#define XCD_BAR_WORDS 4480
#define XB_SPIN_CAP (1u << 18)
#define LAS __attribute__((address_space(3)))
DI unsigned xb_ld(unsigned* p) { return __hip_atomic_load(p, __ATOMIC_RELAXED, __HIP_MEMORY_SCOPE_AGENT); }
DI unsigned xb_add(unsigned* p, unsigned v) { return __hip_atomic_fetch_add(p, v, __ATOMIC_RELAXED, __HIP_MEMORY_SCOPE_AGENT); }
DI unsigned xb_xcc_id() { return (unsigned)__builtin_amdgcn_s_getreg((3 << 11) | 20) & 0xFu; }
#define XB_SPIN(cond, bar) do { unsigned _sp = 0; while (cond) { __builtin_amdgcn_s_sleep(1); \
    if ((++_sp & 255u) == 0u) { if (xb_ld(&(bar)[XB_TMO])) break; if (_sp > XB_SPIN_CAP) { atomicAdd(&(bar)[XB_TMO], 1u); break; } } } } while (0)
struct XcdBarrier { unsigned* bar; unsigned x; volatile LAS unsigned* st; };
DI XcdBarrier xcd_barrier_post(unsigned* bar, volatile LAS unsigned* st) {
  XcdBarrier b; b.bar = bar; b.x = xb_xcc_id(); b.st = st;
  if (threadIdx.x == 0) (void)xb_add(&bar[XB_XCNT(b.x)], 1u);
  return b;
}
DI void xcd_barrier_complete(unsigned* bar, unsigned x, unsigned& nloc, unsigned& nx) {
  const unsigned G = gridDim.x * gridDim.y * gridDim.z;
  unsigned sum, cnt, mine, sp = 0u;
  for (;;) {
    sum = 0u; cnt = 0u; mine = 0u;
#pragma unroll
    for (unsigned j = 0; j < 16; ++j) { const unsigned c = xb_ld(&bar[XB_XCNT(j)]); sum += c; cnt += (c > 0u) ? 1u : 0u; mine = (j == x) ? c : mine; }
    if (sum == G) break;
    __builtin_amdgcn_s_sleep(1);
    if ((++sp & 255u) == 0u) { if (xb_ld(&bar[XB_TMO])) break; if (sp > XB_SPIN_CAP) { atomicAdd(&bar[XB_TMO], 1u); break; } }
  }
  nloc = mine > 0u ? mine : 1u; nx = cnt > 0u ? cnt : 1u;
}
DI void xcd_barrier(const XcdBarrier& b) {
  asm volatile("s_waitcnt vmcnt(0)" ::: "memory");
  __syncthreads();
  if (threadIdx.x == 0) {
    unsigned* bar = b.bar;
    __builtin_amdgcn_s_waitcnt(0);
    unsigned nloc = b.st[0], nx = b.st[1];
    if (nloc == 0u) { xcd_barrier_complete(bar, b.x, nloc, nx); b.st[0] = nloc; b.st[1] = nx; }
    const unsigned old = xb_add(&bar[XB_XSUB(b.x)], 1u);
    const unsigned gen = old / nloc;
    if (old + 1u == (gen + 1u) * nloc) {
      __builtin_amdgcn_fence(__ATOMIC_RELEASE, "agent");
      asm volatile("s_waitcnt vmcnt(0)" ::: "memory");
      const unsigned og = xb_add(&bar[XB_TOP], 1u);
      const unsigned tg = og / nx;
      if (og + 1u == (tg + 1u) * nx) xb_add(&bar[XB_TOPGEN], 1u);
      else XB_SPIN(xb_ld(&bar[XB_TOPGEN]) == tg, bar);
      __builtin_amdgcn_fence(__ATOMIC_ACQUIRE, "agent");
      xb_add(&bar[XB_XGEN(b.x)], 1u);
      asm volatile("s_waitcnt vmcnt(0)" ::: "memory");
    } else {
      XB_SPIN(xb_ld(&bar[XB_XGEN(b.x)]) == gen, bar);
      __builtin_amdgcn_fence(__ATOMIC_ACQUIRE, "agent");
      asm volatile("s_waitcnt vmcnt(0)" ::: "memory");
    }
  }
  __syncthreads();
}

__global__ void __launch_bounds__(256, 2) hybrid_megakernel(Params p) {
  extern __shared__ __attribute__((aligned(16))) char smraw[];
  cg::grid_group grid = cg::this_grid();
  volatile LAS unsigned* xst = (volatile LAS unsigned*)(smraw + SMEM_MAIN);
  if (threadIdx.x == 0) { xst[0] = 0u; xst[1] = 0u; }
  __syncthreads();
  const XcdBarrier xb = xcd_barrier_post(p.bar, xst);
  if (threadIdx.x == 0) xst[2] = xb_add(&p.bar[XB_RANK(xb.x)], 1u);
  if (p.out == nullptr) grid.sync();
  prep_weights(p, (float*)smraw);
  prep_misc(p);
  rmsnorm_rows(p.x, p.norm_g, p.xb);
  xcd_barrier(xb);
  BlkMap bm;
  {
    bool ok = true; unsigned mine = 0;
#pragma unroll
    for (unsigned j = 0; j < 16; ++j) {
      const unsigned c = xb_ld(&p.bar[XB_XCNT(j)]);
      ok = ok && (j < 8 ? c > 0u : c == 0u);
      mine = (j == xb.x) ? c : mine;
    }
    const unsigned rank = xst[2];
    bm.x = ok ? (int)xb.x : (int)(blockIdx.x & 7);
    bm.j = ok ? (int)rank : (int)(blockIdx.x >> 3);
    bm.per = ok ? (int)mine : (int)(gridDim.x >> 3);
    bm.x = __builtin_amdgcn_readfirstlane(bm.x); bm.j = __builtin_amdgcn_readfirstlane(bm.j); bm.per = __builtin_amdgcn_readfirstlane(bm.per);
  }
#pragma unroll 1
  for (int l = 0; l < 2; ++l) {
    const float* xin = l == 0 ? p.x : p.out;
    phase_inproj(p, bm, l, (u16*)smraw);
    xcd_barrier(xb);
    phase_mid(p, l, smraw);
    xcd_barrier(xb);
    phase_attn_far(p, bm);
    xcd_barrier(xb);
    phase_attn_lists(p, bm);
    xcd_barrier(xb);
    phase_attn(p, bm, smraw);
    xcd_barrier(xb);
    phase_attn_fin(p, bm);
    xcd_barrier(xb);
    phase_merge(p, bm, l, (u16*)smraw);
    xcd_barrier(xb);
    phase_out(p, bm, l, xin, (u16*)smraw);
    if (l == 0) {
      xcd_barrier(xb);
      rmsnorm_rows(p.out, p.norm_g + 1024, p.xb);
      xcd_barrier(xb);
    }
  }
}

extern "C" void kernel_launch(void* const* d_in, const int* in_sizes, int n_in, void* d_out, int out_size,
                              void* d_ws, size_t ws_size, hipStream_t stream) {
  Params p{};
  p.x = (const float*)d_in[0]; p.pos = (const int*)d_in[1]; p.norm_g = (const float*)d_in[2]; p.w_in = (const float*)d_in[3];
  p.qna = (const float*)d_in[4]; p.kna = (const float*)d_in[5]; p.qnb = (const float*)d_in[6]; p.knb = (const float*)d_in[7];
  p.qnc = (const float*)d_in[8]; p.knc = (const float*)d_in[9]; p.cmp_pos = (const float*)d_in[10];
  p.ckw1 = (const float*)d_in[11]; p.ckw2 = (const float*)d_in[12]; p.cvw1 = (const float*)d_in[13]; p.cvw2 = (const float*)d_in[14];
  p.wbra = (const float*)d_in[15]; p.wbrb = (const float*)d_in[16]; p.wbrc = (const float*)d_in[17]; p.wout = (const float*)d_in[18];
  p.out = (float*)d_out;
  char* ws = (char*)d_ws; size_t off = 0;
  auto take = [&](size_t bytes) { char* r = ws + off; off += (bytes + 255) & ~(size_t)255; return r; };
  p.xb = (u16*)take((size_t)32768 * 1024 * 2);
  p.proj = (u16*)take((size_t)32768 * NP * 2);
  p.Wt1 = (u16*)take((size_t)2 * NP * 1024 * 2);
  p.Wg = (u16*)take((size_t)2 * 3072 * 1024 * 2);
  p.Wbr = (u16*)take((size_t)2 * 1024 * 896 * 2);
  p.Wout = (u16*)take((size_t)2 * 1024 * 1024 * 2);
  p.W1t = (u16*)take((size_t)4 * 128 * 2048 * 2);
  p.W2t = (u16*)take((size_t)4 * 64 * 128 * 2);
  p.bias1 = (float*)take(512 * 4);
  p.kc = (u16*)take((size_t)2048 * 64 * 2);
  p.vcF = (u16*)take((size_t)2048 * 64 * 2);
  p.VS = (u16*)take((size_t)2048 * 1024 * 2);
  p.VW = (u16*)take((size_t)2048 * 1024 * 2);
  p.VC = (u16*)take((size_t)8192 * 1024 * 2);
  p.kmean = (u16*)take((size_t)512 * 64 * 2);
  p.rope = (float*)take((size_t)32768 * 16 * 4);
  p.obuf = (u16*)take((size_t)32768 * 896 * 2);
  p.bar = (unsigned*)take((size_t)XCD_BAR_WORDS * 4);
  p.mlA = (float*)take((size_t)32768 * 6 * 2 * 4);
  p.selm16 = (u16*)take((size_t)32 * 4096 * 2);
  p.mlist = (u16*)take((size_t)32 * 16 * 4096 * 2);
  p.mcnt = (int*)take((size_t)32 * 16 * 4);
  p.mlC = (float*)take((size_t)32768 * 4 * 3 * 2 * 4);
  char* va = take((size_t)3 * 12288 * 1024 * 2);
  p.VA1 = (u16*)va; p.VA4 = (u16*)(va + (size_t)12288 * 1024 * 2); p.VA16 = (u16*)(va + (size_t)2 * 12288 * 1024 * 2);
  p.y = (u16*)va;
  if (off > ws_size) { fprintf(stderr, "workspace too small: need %zu have %zu\n", off, ws_size); return; }

  static int grid_blocks = 0;
  if (!grid_blocks) {
    int dev = 0, cus = 0, per_cu = 0;
    hipGetDevice(&dev);
    hipDeviceGetAttribute(&cus, hipDeviceAttributeMultiprocessorCount, dev);
    hipFuncSetAttribute((const void*)hybrid_megakernel, hipFuncAttributeMaxDynamicSharedMemorySize, SMEM_BYTES);
    hipOccupancyMaxActiveBlocksPerMultiprocessor(&per_cu, hybrid_megakernel, 256, SMEM_BYTES);
    if (per_cu > 2) per_cu = 2;
    if (per_cu < 1) per_cu = 1;
    if (cus < 8) cus = 8;
    grid_blocks = cus * per_cu;
  }
  hipMemsetAsync(p.bar, 0, (size_t)XCD_BAR_WORDS * 4, stream);
  void* args[] = {&p};
  hipError_t e = hipLaunchCooperativeKernel((void*)hybrid_megakernel, dim3(grid_blocks), dim3(256), args, SMEM_BYTES, stream);
  if (e != hipSuccess) fprintf(stderr, "cooperative launch failed: %s (grid %d)\n", hipGetErrorString(e), grid_blocks);
}
```

```cpp
#include <hip/hip_runtime.h>
#include <hip/hip_cooperative_groups.h>
#include <cstdio>
namespace cg = cooperative_groups;

typedef unsigned short u16;
typedef __attribute__((ext_vector_type(8))) short bf16x8;
typedef __attribute__((ext_vector_type(16))) float f32x16;
#define DI __device__ __forceinline__

constexpr int NP = 3584;
constexpr int INW = 6540;
constexpr int C_QA = 0, C_KA = 384, C_VA = 768, C_ZA = 1152, C_QB = 1536, C_KCB = 1792, C_VCB = 1856,
              C_KSB = 1920, C_VSB = 1984, C_KWB = 2048, C_VWB = 2112, C_ZB = 2176, C_QC = 2432, C_KC = 2688,
              C_VC = 2944, C_ZC = 3200, C_GB = 3456;
constexpr int SMEM_MAIN = 73728;
constexpr int SMEM_BYTES = SMEM_MAIN + 16;

struct Params {
  const float* x; const int* pos; const float* norm_g; const float* w_in;
  const float* qna; const float* kna; const float* qnb; const float* knb; const float* qnc; const float* knc;
  const float* cmp_pos; const float* ckw1; const float* ckw2; const float* cvw1; const float* cvw2;
  const float* wbra; const float* wbrb; const float* wbrc; const float* wout;
  float* out;
  u16* xb; u16* proj; u16* y; u16* Wt1; u16* Wg; u16* Wbr; u16* Wout; u16* W1t; u16* W2t;
  float* bias1; u16* kc; u16* vcF; u16* VA1; u16* VA4; u16* VA16; u16* VS; u16* VW; u16* VC; u16* kmean;
  float* rope; u16* obuf; unsigned* bar; float* mlA;
  u16* selm16; u16* mlist; int* mcnt; float* mlC;
};

__device__ const float c_freq[8] = {1.0f, 0.19392274474868576f, 0.03760603093086393f, 0.007292664737217109f,
                                    0.001414213562373095f, 0.0002742481756762073f, 5.318295896944988e-05f,
                                    1.031338537721246e-05f};

DI u16 f2bf(float f) { __bf16 b = (__bf16)f; return __builtin_bit_cast(u16, b); }
DI float bf2f(u16 h) { return __uint_as_float(((unsigned)h) << 16); }
DI unsigned pack2(float a, float b) { return (unsigned)f2bf(a) | ((unsigned)f2bf(b) << 16); }
DI f32x16 mfma32(bf16x8 a, bf16x8 b, f32x16 c) { return __builtin_amdgcn_mfma_f32_32x32x16_bf16(a, b, c, 0, 0, 0); }
DI f32x16 zero16() { f32x16 z;
#pragma unroll
  for (int i = 0; i < 16; ++i) z[i] = 0.f; return z; }
DI float sigmoidf_(float x) { return 1.f / (1.f + __expf(-x)); }
DI float siluf_(float x) { return x / (1.f + __expf(-x)); }

typedef __attribute__((ext_vector_type(2))) unsigned u32x2_t;
DI float xor32_max(float x) {
  const u32x2_t r = __builtin_amdgcn_permlane32_swap(__float_as_uint(x), __float_as_uint(x), false, false);
  return __builtin_amdgcn_fmed3f(__uint_as_float(r[0]), __uint_as_float(r[1]), __builtin_inff());
}
DI float xor32_sum(float x) {
  const u32x2_t r = __builtin_amdgcn_permlane32_swap(__float_as_uint(x), __float_as_uint(x), false, false);
  return __uint_as_float(r[0]) + __uint_as_float(r[1]);
}
DI float xor32_get(float x, int lh) {
  const u32x2_t r = __builtin_amdgcn_permlane32_swap(__float_as_uint(x), __float_as_uint(x), false, false);
  return __uint_as_float(lh ? r[0] : r[1]);
}
DI unsigned xor32_or(unsigned x) {
  const u32x2_t r = __builtin_amdgcn_permlane32_swap(x, x, false, false);
  return r[0] | r[1];
}


DI int tid_() { int t = threadIdx.x; asm volatile("" : "+v"(t)); return t; }
template <class T> DI T* as_global(T* ptr) { return (T*)(__attribute__((address_space(1))) T*)ptr; }
#define LAU(f) do { asm volatile("" : "+s"(q.f)); q.f = as_global(q.f); } while (0)
DI Params launder(const Params& p) {
  Params q = p;
  return q;
}

struct TDesc { const float* src; int ld; int nvalid; u16* dst; int dld; };
DI void tconv_pair(const TDesc a, const TDesc b, const bool hasb, float* sm) {
  const int tid = tid_(), n = tid & 63, kq = tid >> 6;
  float va[16], vb[16];
#pragma unroll
  for (int i = 0; i < 16; ++i) { const int k = i * 4 + kq; va[i] = (n < a.nvalid) ? a.src[(size_t)k * a.ld + n] : 0.f; }
#pragma unroll
  for (int i = 0; i < 16; ++i) { const int k = i * 4 + kq; vb[i] = (hasb && n < b.nvalid) ? b.src[(size_t)k * b.ld + n] : 0.f; }
#pragma unroll
  for (int i = 0; i < 16; ++i) { const int k = i * 4 + kq; sm[k * 65 + n] = va[i]; sm[4160 + k * 65 + n] = vb[i]; }
  __syncthreads();
  const int k2 = (tid & 31) * 2, ng = tid >> 5;
#pragma unroll 4
  for (int i = 0; i < 8; ++i) {
    const int nn = i * 8 + ng;
    *(unsigned*)(a.dst + (size_t)nn * a.dld + k2) = pack2(sm[k2 * 65 + nn], sm[(k2 + 1) * 65 + nn]);
    if (hasb) *(unsigned*)(b.dst + (size_t)nn * b.dld + k2) = pack2(sm[4160 + k2 * 65 + nn], sm[4160 + (k2 + 1) * 65 + nn]);
  }
  __syncthreads();
}

DI TDesc tile_desc(const Params& p, int idx) {
  constexpr int TL = 2276;
  TDesc d;
  int l = idx / TL, t = idx % TL;
  if (t < 896) {
    int cg_ = t >> 4, kg = t & 15;
    d.nvalid = cg_ < 54 ? 64 : (cg_ == 54 ? 12 : 0);
    int srccol = cg_ < 34 ? cg_ * 64 : (cg_ < 54 ? cg_ * 64 + 12 : 2176);
    d.src = p.w_in + (size_t)l * 1024 * INW + (size_t)(kg * 64) * INW + srccol; d.ld = INW;
    d.dst = p.Wt1 + (size_t)l * NP * 1024 + (size_t)(cg_ * 64) * 1024 + kg * 64; d.dld = 1024;
  } else if (t < 1664) {
    t -= 896; int cg_ = t >> 4, kg = t & 15;
    d.nvalid = 64;
    d.src = p.w_in + (size_t)l * 1024 * INW + (size_t)(kg * 64) * INW + 3468 + cg_ * 64; d.ld = INW;
    d.dst = p.Wg + (size_t)l * 3072 * 1024 + (size_t)(cg_ * 64) * 1024 + kg * 64; d.dld = 1024;
  } else if (t < 1888) {
    t -= 1664; int ng = t / 14, kg = t % 14;
    const float* src;
    if (kg < 6) src = p.wbra + (size_t)l * 384 * 1024 + (size_t)(kg * 64) * 1024;
    else if (kg < 10) src = p.wbrb + (size_t)l * 256 * 1024 + (size_t)((kg - 6) * 64) * 1024;
    else src = p.wbrc + (size_t)l * 256 * 1024 + (size_t)((kg - 10) * 64) * 1024;
    d.nvalid = 64; d.src = src + ng * 64; d.ld = 1024;
    d.dst = p.Wbr + (size_t)l * 1024 * 896 + (size_t)(ng * 64) * 896 + kg * 64; d.dld = 896;
  } else if (t < 2144) {
    t -= 1888; int ng = t >> 4, kg = t & 15;
    d.nvalid = 64; d.src = p.wout + (size_t)l * 1024 * 1024 + (size_t)(kg * 64) * 1024 + ng * 64; d.ld = 1024;
    d.dst = p.Wout + (size_t)l * 1024 * 1024 + (size_t)(ng * 64) * 1024 + kg * 64; d.dld = 1024;
  } else if (t < 2272) {
    t -= 2144; int kv = t >> 6; t &= 63; int ng = t >> 5, kg = t & 31;
    const float* w = kv ? p.cvw1 : p.ckw1;
    d.nvalid = 64; d.src = w + (size_t)l * 2048 * 128 + (size_t)(kg * 64) * 128 + ng * 64; d.ld = 128;
    d.dst = p.W1t + ((size_t)(l * 2 + kv) * 128 + ng * 64) * 2048 + kg * 64; d.dld = 2048;
  } else {
    t -= 2272; int kv = t >> 1, kg = t & 1;
    const float* w = kv ? p.cvw2 : p.ckw2;
    d.nvalid = 64; d.src = w + (size_t)l * 128 * 64 + (size_t)(kg * 64) * 64; d.ld = 64;
    d.dst = p.W2t + ((size_t)(l * 2 + kv) * 64) * 128 + kg * 64; d.dld = 128;
  }
  return d;
}

DI void prep_weights(const Params& p_in, float* sm) {
  const Params p = launder(p_in);
  constexpr int TL = 2276;
  for (int idx = blockIdx.x; idx < 2 * TL; idx += 2 * gridDim.x) {
    const int idx2 = idx + gridDim.x;
    const bool hasb = idx2 < 2 * TL;
    const TDesc a = tile_desc(p, idx);
    const TDesc b = tile_desc(p, hasb ? idx2 : idx);
    tconv_pair(a, b, hasb, sm);
  }
}

DI void prep_misc(const Params& p_in) {
  const Params p = launder(p_in);
  const int gtid = blockIdx.x * 256 + tid_(), gsz = gridDim.x * 256;
  for (int i = gtid; i < 32768 * 8; i += gsz) {
    int tok = i >> 3, d = i & 7;
    float a = (float)p.pos[tok] * c_freq[d];
    double rev = (double)a * 0.15915494309189535;
    rev -= floor(rev);
    float fr = (float)rev;
    p.rope[tok * 16 + d] = __builtin_amdgcn_cosf(fr);
    p.rope[tok * 16 + 8 + d] = __builtin_amdgcn_sinf(fr);
  }
  {
    const int lane = tid_() & 63;
    const int gw = blockIdx.x * 4 + (tid_() >> 6);
    if (gw < 512) {
      const int l = gw >> 8, kv = (gw >> 7) & 1, n = gw & 127;
      const float* w = (kv ? p.cvw1 : p.ckw1) + (size_t)l * 2048 * 128 + n;
      const float* cp = p.cmp_pos + l * 2048;
      float s = 0.f;
#pragma unroll 8
      for (int i = 0; i < 32; ++i) { const int k = lane + 64 * i; s += cp[k] * w[(size_t)k * 128]; }
#pragma unroll
      for (int o = 32; o >= 1; o >>= 1) s += __shfl_xor(s, o);
      if (lane == 0) p.bias1[gw] = s;
    }
  }
}

DI void rmsnorm_rows(const float* __restrict__ xin, const float* __restrict__ g, u16* __restrict__ xb) {
  const int lane = tid_() & 63, wid = tid_() >> 6;
  for (int row = (blockIdx.x * 4 + wid) * 2; row < 32768; row += gridDim.x * 8) {
    const float4* xr0 = (const float4*)(xin + (size_t)row * 1024);
    const float4* xr1 = xr0 + 256;
    float4 v0[4], v1[4];
#pragma unroll
    for (int i = 0; i < 4; ++i) { v0[i] = xr0[lane + i * 64]; v1[i] = xr1[lane + i * 64]; }
    float s0 = 0.f, s1 = 0.f;
#pragma unroll
    for (int i = 0; i < 4; ++i) {
      s0 += v0[i].x * v0[i].x + v0[i].y * v0[i].y + v0[i].z * v0[i].z + v0[i].w * v0[i].w;
      s1 += v1[i].x * v1[i].x + v1[i].y * v1[i].y + v1[i].z * v1[i].z + v1[i].w * v1[i].w;
    }
#pragma unroll
    for (int o = 32; o >= 1; o >>= 1) { s0 += __shfl_xor(s0, o); s1 += __shfl_xor(s1, o); }
    const float r0 = rsqrtf(s0 * (1.f / 1024.f) + 1e-6f), r1 = rsqrtf(s1 * (1.f / 1024.f) + 1e-6f);
#pragma unroll
    for (int i = 0; i < 4; ++i) {
      const float4 gg = ((const float4*)g)[lane + i * 64];
      uint2 o; o.x = pack2(v0[i].x * r0 * gg.x, v0[i].y * r0 * gg.y); o.y = pack2(v0[i].z * r0 * gg.z, v0[i].w * r0 * gg.w);
      *(uint2*)(xb + (size_t)row * 1024 + (lane + i * 64) * 4) = o;
      uint2 q; q.x = pack2(v1[i].x * r1 * gg.x, v1[i].y * r1 * gg.y); q.y = pack2(v1[i].z * r1 * gg.z, v1[i].w * r1 * gg.w);
      *(uint2*)(xb + (size_t)(row + 1) * 1024 + (lane + i * 64) * 4) = q;
    }
  }
}

#define WAITVL(n) asm volatile("s_waitcnt vmcnt(" #n ") lgkmcnt(0)" ::: "memory")
template <int MT, int NT, int NS, bool SWAP>
DI void gemm_loop(const u16* __restrict__ A, int lda, const u16* __restrict__ Bt, int ldb, int K,
                  f32x16 (&acc)[MT][NT], u16* sm16) {
  constexpr int BN = 64 * NT, BM = 64 * MT;
  constexpr int A_BYTES = BM * 64, B_BYTES = BN * 64, STAGE = A_BYTES + B_BYTES;
  constexpr int NLD = MT + NT;
  char* sm = (char*)sm16;
  const int tid = tid_(), lane = tid & 63, wid = tid >> 6, wm = wid >> 1, wn = wid & 1;
  const int lr = lane & 31, lh = lane >> 5;
  const int row0 = tid >> 2, kc0 = ((tid & 3) ^ ((row0 >> 2) & 3)) * 8;
  const u16* ag = A + (size_t)row0 * lda + kc0;
  const u16* bg = Bt + (size_t)row0 * ldb + kc0;
  const size_t a64 = (size_t)64 * lda, b64 = (size_t)64 * ldb;
  const int nk = K >> 5;
  auto issue = [&](int kt) {
    char* d = sm + (kt % NS) * STAGE + tid * 16;
    const int ko = kt * 32;
#pragma unroll
    for (int i = 0; i < MT; ++i)
      __builtin_amdgcn_global_load_lds((const unsigned*)(ag + i * a64 + ko), (unsigned*)(d + i * 4096), 16, 0, 0);
#pragma unroll
    for (int i = 0; i < NT; ++i)
      __builtin_amdgcn_global_load_lds((const unsigned*)(bg + i * b64 + ko), (unsigned*)(d + A_BYTES + i * 4096), 16, 0, 0);
  };
  auto wait_bar = [&](int after) {
    if (NLD == 4) { if (after >= 2) WAITVL(8); else if (after == 1) WAITVL(4); else WAITVL(0); }
    else if (NLD == 3) { if (after >= 2) WAITVL(6); else if (after == 1) WAITVL(3); else WAITVL(0); }
    else { if (after >= 2) WAITVL(12); else if (after == 1) WAITVL(6); else WAITVL(0); }
    __builtin_amdgcn_s_barrier();
    asm volatile("" ::: "memory");
  };
  const int sw = (lr >> 2) & 3;
  const int aoff = (wm * 32 * MT + lr) * 64, boff = A_BYTES + (wn * 32 * NT + lr) * 64;
  const int c0 = ((0 + lh) ^ sw) * 16, c1 = ((2 + lh) ^ sw) * 16;
  auto ldk = [&](int kt, int ks, bf16x8 (&af)[MT], bf16x8 (&bfv)[NT]) {
    const char* sb = sm + (kt % NS) * STAGE + (ks ? c1 : c0);
#pragma unroll
    for (int mi = 0; mi < MT; ++mi) af[mi] = *(const bf16x8*)(sb + aoff + mi * 2048);
#pragma unroll
    for (int ni = 0; ni < NT; ++ni) bfv[ni] = *(const bf16x8*)(sb + boff + ni * 2048);
  };
  auto mmak = [&](const bf16x8 (&af)[MT], const bf16x8 (&bfv)[NT]) {
#pragma unroll
    for (int mi = 0; mi < MT; ++mi)
#pragma unroll
      for (int ni = 0; ni < NT; ++ni)
        acc[mi][ni] = SWAP ? mfma32(bfv[ni], af[mi], acc[mi][ni]) : mfma32(af[mi], bfv[ni], acc[mi][ni]);
  };
  __syncthreads();
#pragma unroll
  for (int i = 0; i < NS - 1; ++i) if (i < nk) issue(i);
  { const int after = nk - 1 < NS - 2 ? nk - 1 : NS - 2; wait_bar(after); }
  if (nk > NS - 1) issue(NS - 1);
  bf16x8 fa_a[MT], fa_b[NT], fb_a[MT], fb_b[NT];
  ldk(0, 0, fa_a, fa_b);
  for (int kt = 0; kt < nk; ++kt) {
    ldk(kt, 1, fb_a, fb_b);
    mmak(fa_a, fa_b);
    if (kt + 1 < nk) {
      { const int r = nk - 2 - kt; wait_bar(r < NS - 2 ? r : NS - 2); }
      if (kt + NS < nk) issue(kt + NS);
      ldk(kt + 1, 0, fa_a, fa_b);
    }
    mmak(fb_a, fb_b);
  }
}

struct BlkMap { int x, j, per; };
DI bool tile_map(const BlkMap bm, int k, int MTL, int NTL, int& mt, int& nt) {
  const int x = bm.x, j = bm.j, per = bm.per;
  const int u = j + per * k;
  if (u >= (MTL >> 3) * NTL) return false;
  const int q = u / (8 * NTL), rem = u - q * (8 * NTL);
  nt = rem >> 3; mt = (x + 8 * q) * 8 + (rem & 7);
  return true;
}


template <int MT>
DI void tile_store_bf16(const f32x16 (&acc)[MT][2], u16* __restrict__ dst  , int ld, char* sm) {
  const int tid = tid_(), lane = tid & 63, wid = tid >> 6, wm = wid >> 1, wn = wid & 1;
  const int lr = lane & 31, lh = lane >> 5;
  __syncthreads();
#pragma unroll
  for (int mi = 0; mi < MT; ++mi) {
    char* rowp = sm + (wm * 32 * MT + mi * 32 + lr) * 272 + (wn * 64 + 4 * lh) * 2;
#pragma unroll
    for (int ni = 0; ni < 2; ++ni)
#pragma unroll
      for (int i = 0; i < 4; ++i) {
        uint2 o; o.x = pack2(acc[mi][ni][i * 4 + 0], acc[mi][ni][i * 4 + 1]);
        o.y = pack2(acc[mi][ni][i * 4 + 2], acc[mi][ni][i * 4 + 3]);
        *(uint2*)(rowp + (ni * 32 + 8 * i) * 2) = o;
      }
  }
  __syncthreads();
  const int c = tid & 15, r0 = tid >> 4;
#pragma unroll
  for (int j = 0; j < 4 * MT; ++j) {
    const int row = r0 + 16 * j;
    typedef __attribute__((ext_vector_type(4))) unsigned u32x4s;
    const u32x4s v = *(const u32x4s*)(sm + row * 272 + c * 16);
    __builtin_nontemporal_store(v, (u32x4s*)(dst + (size_t)row * ld + c * 8));
  }
}

DI void phase_inproj(const Params& p_in, const BlkMap bm, int l, u16* sm) {
  const Params p = launder(p_in);
  const int tid = tid_(), lane = tid & 63, wid = tid >> 6, wm = wid >> 1, wn = wid & 1;
  const int lr = lane & 31, lh = lane >> 5;
  const u16* Wt = p.Wt1 + (size_t)l * NP * 1024;
  for (int k = 0;; ++k) {
    int mt, nt;
    if (!tile_map(bm, k, 128, 28, mt, nt)) break;
    const int m0 = mt * 256, n0 = nt * 128;
    f32x16 acc[4][2];
#pragma unroll
    for (int a = 0; a < 4; ++a)
#pragma unroll
      for (int b = 0; b < 2; ++b) acc[a][b] = zero16();
    gemm_loop<4, 2, 3, true>(p.xb + (size_t)m0 * 1024, 1024, Wt + (size_t)n0 * 1024, 1024, 1024, acc, sm);
    const int cg_ = (n0 + wn * 64) >> 6;
    const float* gain = p.qna; bool has = true, isq = false;
    if (cg_ < 6) { gain = p.qna; isq = true; }
    else if (cg_ < 12) gain = p.kna;
    else if (cg_ >= 24 && cg_ < 28) { gain = p.qnb; isq = true; }
    else if (cg_ == 28 || cg_ == 30 || cg_ == 32) gain = p.knb;
    else if (cg_ >= 38 && cg_ < 42) { gain = p.qnc; isq = true; }
    else if (cg_ >= 42 && cg_ < 46) gain = p.knc;
    else has = false;
    if (has) {
      gain += l * 64;
      float4 g4[2][4], c4[4], s4[4];
#pragma unroll
      for (int ni = 0; ni < 2; ++ni)
#pragma unroll
        for (int i = 0; i < 4; ++i) g4[ni][i] = *(const float4*)(gain + ni * 32 + 4 * lh + 8 * i);
#pragma unroll
      for (int mi = 0; mi < 4; ++mi) {
        const int token = m0 + wm * 128 + mi * 32 + lr;
        c4[mi] = *(const float4*)(p.rope + (size_t)token * 16 + 4 * lh);
        s4[mi] = *(const float4*)(p.rope + (size_t)token * 16 + 8 + 4 * lh);
      }
      const float qs = isq ? 0.18033688011112042f : 1.f;
#pragma unroll
      for (int mi = 0; mi < 4; ++mi) {
        float ss = 0.f;
#pragma unroll
        for (int ni = 0; ni < 2; ++ni)
#pragma unroll
          for (int r = 0; r < 16; ++r) ss += acc[mi][ni][r] * acc[mi][ni][r];
        ss = xor32_sum(ss);
        const float rs = rsqrtf(ss * (1.f / 64.f) + 1e-6f);
#pragma unroll
        for (int ni = 0; ni < 2; ++ni)
#pragma unroll
          for (int i = 0; i < 4; ++i) {
            acc[mi][ni][i * 4 + 0] *= rs * g4[ni][i].x; acc[mi][ni][i * 4 + 1] *= rs * g4[ni][i].y;
            acc[mi][ni][i * 4 + 2] *= rs * g4[ni][i].z; acc[mi][ni][i * 4 + 3] *= rs * g4[ni][i].w;
          }
        const float cc[4] = {c4[mi].x, c4[mi].y, c4[mi].z, c4[mi].w}, sn[4] = {s4[mi].x, s4[mi].y, s4[mi].z, s4[mi].w};
#pragma unroll
        for (int j = 0; j < 4; ++j) {
          const float x1 = acc[mi][0][j], x2 = acc[mi][0][4 + j];
          acc[mi][0][j] = x1 * cc[j] - x2 * sn[j];
          acc[mi][0][4 + j] = x2 * cc[j] + x1 * sn[j];
        }
        if (isq) {
#pragma unroll
          for (int ni = 0; ni < 2; ++ni)
#pragma unroll
            for (int r = 0; r < 16; ++r) acc[mi][ni][r] *= qs;
        }
      }
    }
    tile_store_bf16<4>(acc, p.proj + (size_t)m0 * NP + n0, NP, (char*)sm);
  }
}

DI void compress_item(const Params& p, int l, int kv, int rt, char* smraw) {
  const int tid = tid_(), lane = tid & 63, w = tid >> 6, lr = lane & 31, lh = lane >> 5;
  const u16* W1 = p.W1t + (size_t)((l * 2 + kv) * 128 + w * 32 + lr) * 2048 + lh * 8;
  const int col = kv ? C_VCB : C_KCB;
  const int R = rt * 32 + lr;
  f32x16 H = zero16();
#pragma unroll 1
  for (int ks0 = 0; ks0 < 128; ks0 += 8) {
    bf16x8 af[8], wf[8];
#pragma unroll
    for (int u = 0; u < 8; ++u) {
      const int ks = ks0 + u, tt = ks >> 2, d = (ks & 3) * 16 + lh * 8;
      int tokrow = R * 16 + tt; tokrow = tokrow > 32767 ? 32767 : tokrow;
      af[u] = *(const bf16x8*)(p.proj + (size_t)tokrow * NP + col + d);
      wf[u] = *(const bf16x8*)(W1 + ks * 16);
    }
#pragma unroll
    for (int u = 0; u < 8; ++u) H = mfma32(wf[u], af[u], H);
  }
  {
    const float* b1 = p.bias1 + (l * 2 + kv) * 128 + w * 32 + 4 * lh;
    unsigned hw[8];
    float4 bb4[4];
#pragma unroll
    for (int i = 0; i < 4; ++i) bb4[i] = *(const float4*)(b1 + 8 * i);
#pragma unroll
    for (int i = 0; i < 4; ++i) {
      const float4 bb = bb4[i];
      hw[i * 2] = pack2(siluf_(H[i * 4] + bb.x), siluf_(H[i * 4 + 1] + bb.y));
      hw[i * 2 + 1] = pack2(siluf_(H[i * 4 + 2] + bb.z), siluf_(H[i * 4 + 3] + bb.w));
    }
    uint4* hs = (uint4*)smraw;
    hs[(w * 2 + 0) * 64 + lane] = make_uint4(hw[0], hw[1], hw[2], hw[3]);
    hs[(w * 2 + 1) * 64 + lane] = make_uint4(hw[4], hw[5], hw[6], hw[7]);
  }
  __syncthreads();
  if (w < 2) {
    const int dt = w;
    const u16* W2 = p.W2t + (size_t)((l * 2 + kv) * 64 + dt * 32 + lr) * 128 + 4 * lh;
    const uint4* hs = (const uint4*)smraw;
    f32x16 o2 = zero16();
    uint2 wlo[8], whi[8];
#pragma unroll
    for (int ht = 0; ht < 4; ++ht)
#pragma unroll
      for (int s = 0; s < 2; ++s) {
        const u16* wp = W2 + ht * 32 + 16 * s;
        wlo[ht * 2 + s] = *(const uint2*)wp; whi[ht * 2 + s] = *(const uint2*)(wp + 8);
      }
#pragma unroll
    for (int ht = 0; ht < 4; ++ht)
#pragma unroll
      for (int s = 0; s < 2; ++s) {
        const uint2 lo = wlo[ht * 2 + s], hi = whi[ht * 2 + s];
        union { uint4 u; bf16x8 v; } cw, ch; cw.u = make_uint4(lo.x, lo.y, hi.x, hi.y);
        ch.u = hs[(ht * 2 + s) * 64 + lane];
        o2 = kv ? mfma32(ch.v, cw.v, o2) : mfma32(cw.v, ch.v, o2);
      }
    if (kv == 0) {
#pragma unroll
      for (int i = 0; i < 4; ++i) {
        uint2 o; o.x = pack2(o2[i * 4], o2[i * 4 + 1]); o.y = pack2(o2[i * 4 + 2], o2[i * 4 + 3]);
        *(uint2*)(p.kc + (size_t)R * 64 + dt * 32 + 4 * lh + 8 * i) = o;
      }
    } else {
      uint4 a, b;
      a.x = pack2(o2[0], o2[1]); a.y = pack2(o2[2], o2[3]); a.z = pack2(o2[4], o2[5]); a.w = pack2(o2[6], o2[7]);
      b.x = pack2(o2[8], o2[9]); b.y = pack2(o2[10], o2[11]); b.z = pack2(o2[12], o2[13]); b.w = pack2(o2[14], o2[15]);
      u16* dst = p.vcF + (size_t)(rt * 2 + dt) * 1024 + lane * 16;
      *(uint4*)dst = a; *(uint4*)(dst + 8) = b;
    }
  }
  __syncthreads();
}

DI void relayout_decode(const Params& p, int idx, int lr, u16*& dstbase, int& col, int& tokbase, int& tstride) {
  if (idx < 36864) {
    const int which = idx / 12288, id = idx % 12288;
    const int dt = id & 1, bh = id >> 8, b = bh / 6, h = bh % 6;
    col = C_VA + h * 64 + dt * 32 + lr;
    if (which == 0) { const int kt = (id >> 1) & 127; tokbase = b * 4096 + kt * 32; tstride = 1; dstbase = p.VA1; }
    else if (which == 1) { const int lt = (id >> 1) & 31, r4 = (id >> 6) & 3; tokbase = b * 4096 + lt * 128 + r4; tstride = 4; dstbase = p.VA4; }
    else { const int lt = (id >> 1) & 7, r = (id >> 4) & 15; tokbase = b * 4096 + lt * 512 + r; tstride = 16; dstbase = p.VA16; }
    dstbase += (size_t)id * 1024;
  } else if (idx < 40960) {
    const int which = (idx - 36864) >> 11, id = (idx - 36864) & 2047;
    const int dt = id & 1, kt = (id >> 1) & 127, b = id >> 8;
    col = (which ? C_VWB : C_VSB) + dt * 32 + lr; tokbase = b * 4096 + kt * 32; tstride = 1;
    dstbase = (which ? p.VW : p.VS) + (size_t)id * 1024;
  } else {
    const int id = idx - 40960;
    const int dt = id & 1, kt = (id >> 1) & 127, bh = id >> 8, b = bh >> 2, h = bh & 3;
    col = C_VC + h * 64 + dt * 32 + lr; tokbase = b * 4096 + kt * 32; tstride = 1;
    dstbase = p.VC + (size_t)id * 1024;
  }
}
DI void relayout4(const Params& p, int idx0) {
  const int lane = tid_() & 63, lr = lane & 31, lh = lane >> 5;
  u16* dst[4]; unsigned w[4][8];
#pragma unroll
  for (int t = 0; t < 4; ++t) {
    int col, tokbase, tstride;
    relayout_decode(p, idx0 + t, lr, dst[t], col, tokbase, tstride);
#pragma unroll
    for (int i = 0; i < 4; ++i)
#pragma unroll
      for (int jp = 0; jp < 2; ++jp) {
        const int kk = 4 * lh + 8 * i + 2 * jp;
        const unsigned oa = (unsigned)((tokbase + kk * tstride) * NP + col), ob = (unsigned)((tokbase + (kk + 1) * tstride) * NP + col);
        const u16 a = p.proj[oa];
        const u16 b = p.proj[ob];
        w[t][i * 2 + jp] = (unsigned)a | ((unsigned)b << 16);
      }
  }
#pragma unroll
  for (int t = 0; t < 4; ++t) {
    u16* d = dst[t] + lane * 16;
    *(uint4*)d = make_uint4(w[t][0], w[t][1], w[t][2], w[t][3]);
    *(uint4*)(d + 8) = make_uint4(w[t][4], w[t][5], w[t][6], w[t][7]);
  }
}

DI void kmean_item(const Params& p, int idx) {
  const int lane = tid_() & 63;
  const int blk = idx & 15, bh = idx >> 4, b = bh >> 2, h = bh & 3;
  const unsigned o0 = (unsigned)((b * 4096 + blk * 256) * NP + C_KC + h * 64 + lane);
  float s0 = 0.f, s1 = 0.f, s2 = 0.f, s3 = 0.f;
#pragma unroll 1
  for (int i = 0; i < 256; i += 16) {
    u16 v[16];
#pragma unroll
    for (int u = 0; u < 16; ++u) v[u] = p.proj[o0 + (unsigned)((i + u) * NP)];
#pragma unroll
    for (int u = 0; u < 16; u += 4) { s0 += bf2f(v[u]); s1 += bf2f(v[u + 1]); s2 += bf2f(v[u + 2]); s3 += bf2f(v[u + 3]); }
  }
  p.kmean[(size_t)idx * 64 + lane] = f2bf(((s0 + s1) + (s2 + s3)) * (1.f / 256.f));
}

DI void phase_mid(const Params& p_in, int l, char* smraw) {
  const Params p = launder(p_in);
  const int wid = tid_() >> 6;
  constexpr int N_CMP = 128, N_KM = 128, N_REL = 3072;
  for (int it = blockIdx.x; it < N_CMP + N_KM + N_REL; it += gridDim.x) {
    if (it < N_CMP) compress_item(p, l, it >> 6, it & 63, smraw);
    else if (it < N_CMP + N_KM) kmean_item(p, (it - N_CMP) * 4 + wid);
    else relayout4(p, (it - N_CMP - N_KM) * 16 + wid * 4);
  }
}

DI void attn_loadk(const u16* __restrict__ kp, bf16x8 (&kf)[4]) {
#pragma unroll
  for (int ks = 0; ks < 4; ++ks) kf[ks] = *(const bf16x8*)(kp + ks * 16);
}

typedef __attribute__((ext_vector_type(2))) float f32x2;
DI float fmax_nc(float a, float b) { return __builtin_amdgcn_fmed3f(a, b, __builtin_inff()); }
DI void attn_core(const bf16x8 (&qf)[4], const bf16x8 (&kf)[4], const bf16x8 (&vf)[2][2], const int lo, const int hi,
                   float& m, float& l, f32x16 (&O)[2], const int lh) {
  f32x16 sc = zero16();
#pragma unroll
  for (int ks = 0; ks < 4; ++ks) sc = mfma32(kf[ks], qf[ks], sc);
  const bool empty = hi < lo;
  const bool partial = !empty && (lo > 0 || hi < 31);
  if (__builtin_amdgcn_ballot_w64(partial) != 0ull) {
    const unsigned span = (unsigned)(hi - lo);
    const int base = 4 * lh - lo;
#pragma unroll
    for (int r = 0; r < 16; ++r) {
      const unsigned rel = (unsigned)(base + 8 * (r >> 2) + (r & 3));
      sc[r] = (rel <= span) ? sc[r] : -1e30f;
    }
  }
  float mx = fmax_nc(fmax_nc(fmax_nc(sc[0], sc[1]), fmax_nc(sc[2], sc[3])), fmax_nc(fmax_nc(sc[4], sc[5]), fmax_nc(sc[6], sc[7])));
  mx = fmax_nc(mx, fmax_nc(fmax_nc(fmax_nc(sc[8], sc[9]), fmax_nc(sc[10], sc[11])), fmax_nc(fmax_nc(sc[12], sc[13]), fmax_nc(sc[14], sc[15]))));
  mx = empty ? -1e30f : mx;
  mx = xor32_max(mx);
  if (__builtin_amdgcn_ballot_w64(mx > m + 16.f) != 0ull) {
    const float mn = (mx > m + 16.f) ? mx : m;
    const float alpha = __builtin_amdgcn_exp2f(m - mn);
    l *= alpha; m = mn;
#pragma unroll
    for (int dt = 0; dt < 2; ++dt)
#pragma unroll
      for (int r = 0; r < 16; ++r) O[dt][r] *= alpha;
  }
  const float meff = empty ? 3e38f : m;
  const f32x2 m2 = {meff, meff};
  f32x2 ps2 = {0.f, 0.f}; float pv[16];
#pragma unroll
  for (int r = 0; r < 16; r += 2) {
    const f32x2 s2 = {sc[r], sc[r + 1]};
    const f32x2 d2 = s2 - m2;
    const f32x2 e2 = {__builtin_amdgcn_exp2f(d2.x), __builtin_amdgcn_exp2f(d2.y)};
    pv[r] = e2.x; pv[r + 1] = e2.y; ps2 += e2;
  }
  const float ps = xor32_sum(ps2.x + ps2.y);
  l += ps;
  bf16x8 pb[2];
#pragma unroll
  for (int s = 0; s < 2; ++s)
#pragma unroll
    for (int j = 0; j < 8; ++j) pb[s][j] = (short)f2bf(pv[8 * s + j]);
#pragma unroll
  for (int dt = 0; dt < 2; ++dt)
#pragma unroll
    for (int s = 0; s < 2; ++s) O[dt] = mfma32(vf[dt][s], pb[s], O[dt]);
}

DI void attn_compute(const bf16x8 (&qf)[4], const bf16x8 (&kf)[4], const u16* __restrict__ vp, const int lo, const int hi,
                     float& m, float& l, f32x16 (&O)[2], const int lh) {
  bf16x8 vf[2][2];
#pragma unroll
  for (int dt = 0; dt < 2; ++dt)
#pragma unroll
    for (int s = 0; s < 2; ++s) vf[dt][s] = *(const bf16x8*)(vp + dt * 1024 + s * 8);
  attn_core(qf, kf, vf, lo, hi, m, l, O, lh);
}

template <class NF, class DF, class BF>
DI void attn_run_shared(const bf16x8 (&qf)[4], NF next, DF desc, BF band, float& m, float& l, f32x16 (&O)[2], char* lds) {
  const int tid = tid_(), lane = tid & 63, lr = lane & 31, lh = lane >> 5;
  int cur = next(-1);
  if (cur < 0) return;
  const int krow = tid >> 3, kc = tid & 7;
  const int kdst = krow * 128 + ((kc ^ ((krow >> 1) & 7)) * 16);
  const int vdst = 4096 + ((((tid >> 7) * 2 + (tid & 1)) * 64 + ((tid >> 1) & 63)) * 16);
  const int ksw = (lr >> 1) & 7;
  uint4 kreg, vreg;
  {
    const u16 *kb, *vt; int kst; desc(cur, kb, kst, vt);
    kreg = *(const uint4*)(kb + (size_t)krow * kst + kc * 8);
    vreg = *(const uint4*)(vt + tid * 8);
  }
  int st = 0;
#pragma unroll 1
  while (true) {
    char* buf = lds + st * 8192;
    *(uint4*)(buf + kdst) = kreg;
    *(uint4*)(buf + vdst) = vreg;
    __syncthreads();
    const int nx = next(cur);
    {
      const u16 *kb, *vt; int kst; desc(nx >= 0 ? nx : cur, kb, kst, vt);
      kreg = *(const uint4*)(kb + (size_t)krow * kst + kc * 8);
      vreg = *(const uint4*)(vt + tid * 8);
    }
    bf16x8 kf[4], vf[2][2];
#pragma unroll
    for (int ks = 0; ks < 4; ++ks) kf[ks] = *(const bf16x8*)(buf + lr * 128 + (((ks * 2 + lh) ^ ksw) * 16));
#pragma unroll
    for (int dt = 0; dt < 2; ++dt)
#pragma unroll
      for (int s2 = 0; s2 < 2; ++s2) vf[dt][s2] = *(const bf16x8*)(buf + 4096 + ((dt * 2 + s2) * 64 + lane) * 16);
    { int lo, hi; band(cur, lo, hi); attn_core(qf, kf, vf, lo, hi, m, l, O, lh); }
    if (nx < 0) break;
    st ^= 1; cur = nx;
  }
  __syncthreads();
}

DI void attn_loadv(const u16* __restrict__ vp, bf16x8 (&vf)[2][2]) {
#pragma unroll
  for (int dt = 0; dt < 2; ++dt)
#pragma unroll
    for (int s = 0; s < 2; ++s) vf[dt][s] = *(const bf16x8*)(vp + dt * 1024 + s * 8);
}
template <class NF, class DF, class BF>
DI void attn_run(const bf16x8 (&qf)[4], NF next, DF desc, BF band, float& m, float& l, f32x16 (&O)[2], const int lh) {
  int cur = next(-1);
  if (cur < 0) return;
  bf16x8 ka[4], kb[4], va[2][2], vb[2][2];
  { const u16 *kp, *vp; desc(cur, kp, vp); attn_loadk(kp, ka); attn_loadv(vp, va); }
#pragma unroll 1
  while (true) {
    const int nx = next(cur);
    { const u16 *kp, *vp; desc(nx >= 0 ? nx : cur, kp, vp); attn_loadk(kp, kb); attn_loadv(vp, vb); }
    { int lo, hi; band(cur, lo, hi); attn_core(qf, ka, va, lo, hi, m, l, O, lh); }
    if (nx < 0) break;
    const int nn = next(nx);
    { const u16 *kp, *vp; desc(nn >= 0 ? nn : nx, kp, vp); attn_loadk(kp, ka); attn_loadv(vp, va); }
    { int lo, hi; band(nx, lo, hi); attn_core(qf, kb, vb, lo, hi, m, l, O, lh); }
    if (nn < 0) break;
    cur = nn;
  }
}

template <class NF, class BF>
DI void attn_run_shared2(const bf16x8 (&qf)[4], NF next, const u16* __restrict__ kbase, const u16* __restrict__ vbase,
                         const int ntile_max, BF band2, float& m, float& l, f32x16 (&O)[2], char* lds) {
  const int tid = tid_(), lane = tid & 63, lr = lane & 31, lh = lane >> 5;
  int cur = next(-1);
  if (cur < 0) return;
  const int krow = tid >> 3, kc = tid & 7;
  const int kdst = krow * 128 + ((kc ^ ((krow >> 1) & 7)) * 16);
  const int vdst = 4096 + ((((tid >> 7) * 2 + (tid & 1)) * 64 + ((tid >> 1) & 63)) * 16);
  const int ksw = (lr >> 1) & 7;
  uint4 k0, k1, v0, v1;
  auto fetch = [&](int J) {
    const u16* kp = kbase + ((size_t)(64 * J + krow)) * NP + kc * 8;
    k0 = *(const uint4*)kp; k1 = *(const uint4*)(kp + (size_t)32 * NP);
    const u16* vp = vbase + (size_t)(2 * J) * 2048 + tid * 8;
    v0 = *(const uint4*)vp; v1 = *(const uint4*)(vp + 2048);
  };
  fetch(cur);
  int st = 0;
#pragma unroll 1
  while (true) {
    char* buf = lds + st * 16384;
    *(uint4*)(buf + kdst) = k0; *(uint4*)(buf + vdst) = v0;
    *(uint4*)(buf + 8192 + kdst) = k1; *(uint4*)(buf + 8192 + vdst) = v1;
    __syncthreads();
    const int nx = next(cur);
    fetch(nx >= 0 ? nx : cur);
#pragma unroll 1
    for (int half = 0; half < 2; ++half) {
      if (2 * cur + half > ntile_max) break;
      const char* tb = buf + half * 8192;
      bf16x8 kf[4], vf[2][2];
#pragma unroll
      for (int ks = 0; ks < 4; ++ks) kf[ks] = *(const bf16x8*)(tb + lr * 128 + (((ks * 2 + lh) ^ ksw) * 16));
#pragma unroll
      for (int dt = 0; dt < 2; ++dt)
#pragma unroll
        for (int s2 = 0; s2 < 2; ++s2) vf[dt][s2] = *(const bf16x8*)(tb + 4096 + ((dt * 2 + s2) * 64 + lane) * 16);
      int lo, hi; band2(cur, half, lo, hi);
      attn_core(qf, kf, vf, lo, hi, m, l, O, lh);
    }
    if (nx < 0) break;
    st ^= 1; cur = nx;
  }
  __syncthreads();
}
#define M_INIT (-1e4f)
#define BIG 100000

DI void store_gated(const u16* zrow  , u16* orow  , const f32x16 (&O)[2]) {
  const int lh = (tid_() & 63) >> 5;
  const u16* z0 = zrow - 4 * lh + 8 * lh;
  u16* o0 = orow - 4 * lh + 8 * lh;
  uint4 zz[2][2];
#pragma unroll
  for (int dt = 0; dt < 2; ++dt)
#pragma unroll
    for (int a = 0; a < 2; ++a) zz[dt][a] = *(const uint4*)(z0 + dt * 32 + 16 * a);
#pragma unroll
  for (int dt = 0; dt < 2; ++dt)
#pragma unroll
    for (int a = 0; a < 2; ++a) {
      const u32x2_t rx = __builtin_amdgcn_permlane32_swap(zz[dt][a].x, zz[dt][a].z, false, false);
      const u32x2_t ry = __builtin_amdgcn_permlane32_swap(zz[dt][a].y, zz[dt][a].w, false, false);
      const unsigned zA0 = rx[0], zA1 = ry[0], zB0 = rx[1], zB1 = ry[1];
      const int iA = (2 * a) * 4, iB = (2 * a + 1) * 4;
      unsigned oA0 = pack2(O[dt][iA] * siluf_(bf2f((u16)(zA0 & 0xffff))), O[dt][iA + 1] * siluf_(bf2f((u16)(zA0 >> 16))));
      unsigned oA1 = pack2(O[dt][iA + 2] * siluf_(bf2f((u16)(zA1 & 0xffff))), O[dt][iA + 3] * siluf_(bf2f((u16)(zA1 >> 16))));
      unsigned oB0 = pack2(O[dt][iB] * siluf_(bf2f((u16)(zB0 & 0xffff))), O[dt][iB + 1] * siluf_(bf2f((u16)(zB0 >> 16))));
      unsigned oB1 = pack2(O[dt][iB + 2] * siluf_(bf2f((u16)(zB1 & 0xffff))), O[dt][iB + 3] * siluf_(bf2f((u16)(zB1 >> 16))));
      const u32x2_t sx = __builtin_amdgcn_permlane32_swap(oA0, oB0, false, false);
      const u32x2_t sy = __builtin_amdgcn_permlane32_swap(oA1, oB1, false, false);
      *(uint4*)(o0 + dt * 32 + 16 * a) = make_uint4(sx[0], sy[0], sx[1], sy[1]);
    }
}


DI void state_store16(u16* row0  , const f32x16 (&O)[2], const int lh, const bool doit = true) {
  u16* o0 = row0 + 8 * lh;
#pragma unroll
  for (int dt = 0; dt < 2; ++dt)
#pragma unroll
    for (int a = 0; a < 2; ++a) {
      const int iA = (2 * a) * 4, iB = (2 * a + 1) * 4;
      const unsigned oA0 = pack2(O[dt][iA], O[dt][iA + 1]), oA1 = pack2(O[dt][iA + 2], O[dt][iA + 3]);
      const unsigned oB0 = pack2(O[dt][iB], O[dt][iB + 1]), oB1 = pack2(O[dt][iB + 2], O[dt][iB + 3]);
      const u32x2_t sx = __builtin_amdgcn_permlane32_swap(oA0, oB0, false, false);
      const u32x2_t sy = __builtin_amdgcn_permlane32_swap(oA1, oB1, false, false);
      if (doit) *(uint4*)(o0 + dt * 32 + 16 * a) = make_uint4(sx[0], sy[0], sx[1], sy[1]);
    }
}
DI void state_load16(const u16* row0, f32x16 (&T)[2], const int lh) {
  const u16* z0 = row0 + 8 * lh;
  uint4 zz[2][2];
#pragma unroll
  for (int dt = 0; dt < 2; ++dt)
#pragma unroll
    for (int a = 0; a < 2; ++a) zz[dt][a] = *(const uint4*)(z0 + dt * 32 + 16 * a);
#pragma unroll
  for (int dt = 0; dt < 2; ++dt)
#pragma unroll
    for (int a = 0; a < 2; ++a) {
      const u32x2_t rx = __builtin_amdgcn_permlane32_swap(zz[dt][a].x, zz[dt][a].z, false, false);
      const u32x2_t ry = __builtin_amdgcn_permlane32_swap(zz[dt][a].y, zz[dt][a].w, false, false);
      const int iA = (2 * a) * 4, iB = (2 * a + 1) * 4;
      T[dt][iA] = bf2f((u16)(rx[0] & 0xffff)); T[dt][iA + 1] = bf2f((u16)(rx[0] >> 16));
      T[dt][iA + 2] = bf2f((u16)(ry[0] & 0xffff)); T[dt][iA + 3] = bf2f((u16)(ry[0] >> 16));
      T[dt][iB] = bf2f((u16)(rx[1] & 0xffff)); T[dt][iB + 1] = bf2f((u16)(rx[1] >> 16));
      T[dt][iB + 2] = bf2f((u16)(ry[1] & 0xffff)); T[dt][iB + 3] = bf2f((u16)(ry[1] >> 16));
    }
}

DI void mixA_far_item(const Params& p, int b, int h, int T0, int r) {
  const int lane = tid_() & 63, lr = lane & 31, lh = lane >> 5;
  const int tq = T0 + r + 16 * lr;
  const size_t rowq = (size_t)b * 4096 + tq;
  const u16* proj = p.proj;
  bf16x8 qf[4];
  {
    const u16* qp = proj + rowq * NP + C_QA + h * 64 + lh * 8;
#pragma unroll
    for (int ks = 0; ks < 4; ++ks) qf[ks] = *(const bf16x8*)(qp + ks * 16);
  }
  float m = M_INIT, l = 0.f; f32x16 O[2]; O[0] = zero16(); O[1] = zero16();
  const int kcol = C_KA + h * 64 + lh * 8;
  {
    const size_t bh = (size_t)(b * 6 + h);
    auto lbase_of = [&](int id) { return (T0 >> 4) - 128 + 32 * (4 - id); };
    auto next = [&](int prev) {
      int id = prev + 1;
      while (id < 5 && lbase_of(id) < 0) ++id;
      return id < 5 ? id : -1;
    };
    auto desc = [&](int id, const u16*& kp, const u16*& vp) {
      const int lbase = lbase_of(id);
      const int tk = (lbase + lr) * 16 + r;
      vp = p.VA16 + (((bh * 16 + r) * 8 + (size_t)(lbase >> 5)) * 2) * 1024 + lane * 16;
      kp = proj + ((size_t)b * 4096 + tk) * NP + kcol;
    };
    auto band = [&](int id, int& lo, int& hi) { hi = (T0 >> 4) + lr - lbase_of(id); lo = hi - 128; };
    attn_run(qf, next, desc, band, m, l, O, lh);
  }
  if (lh == 0) { float2 ml; ml.x = m; ml.y = l; *(float2*)(p.mlA + (rowq * 6 + h) * 2) = ml; }
  state_store16(p.obuf + rowq * 896 + h * 64, O, lh);
}

DI void mixA_item(const Params& p, int b, int h, int T0, int r4) {
  const int lane = tid_() & 63, lr = lane & 31, lh = lane >> 5;
  const int tq = T0 + r4 + 4 * lr;
  const size_t rowq = (size_t)b * 4096 + tq;
  const u16* proj = p.proj;
  bf16x8 qf[4];
  {
    const u16* qp = proj + rowq * NP + C_QA + h * 64 + lh * 8;
#pragma unroll
    for (int ks = 0; ks < 4; ++ks) qf[ks] = *(const bf16x8*)(qp + ks * 16);
  }
  float m, l; f32x16 O[2];
  {
    const float2 ml = *(const float2*)(p.mlA + (rowq * 6 + h) * 2);
    m = ml.x; l = ml.y;
    state_load16(p.obuf + rowq * 896 + h * 64, O, lh);
  }
  const int kcol = C_KA + h * 64 + lh * 8;
  {
    const size_t bh = (size_t)(b * 6 + h);
    auto lbase_of = [&](int id) { return id < 5 ? (T0 >> 2) - 128 + 32 * id : T0 - 128 + 32 * (id - 5); };
    auto next = [&](int prev) {
      int id = prev + 1;
      while (id < 13 && lbase_of(id) < 0) ++id;
      return id < 13 ? id : -1;
    };
    auto desc = [&](int id, const u16*& kp, const u16*& vp) {
      const int lbase = lbase_of(id);
      const size_t lt = (size_t)(lbase >> 5);
      int tk;
      if (id < 5) { tk = (lbase + lr) * 4 + r4; vp = p.VA4 + (((bh * 4 + r4) * 32 + lt) * 2) * 1024 + lane * 16; }
      else { tk = lbase + lr; vp = p.VA1 + ((bh * 128 + lt) * 2) * 1024 + lane * 16; }
      kp = proj + ((size_t)b * 4096 + tk) * NP + kcol;
    };
    auto band = [&](int id, int& lo, int& hi) {
      hi = (id < 5 ? (T0 >> 2) + lr : tq) - lbase_of(id);
      lo = hi - 128;
    };
    attn_run(qf, next, desc, band, m, l, O, lh);
  }
  const float inv = 1.f / l;
#pragma unroll
  for (int dt = 0; dt < 2; ++dt)
#pragma unroll
    for (int rr = 0; rr < 16; ++rr) O[dt][rr] *= inv;
  store_gated(p.proj + rowq * NP + C_ZA + h * 64 + 4 * lh, p.obuf + rowq * 896 + h * 64 + 4 * lh, O);
}

DI int moba_seg_col(int h, int k) {
  const int s = h * 3 + k;
  return s < 6 ? C_VA + 64 * s : (s < 10 ? C_VC + 64 * (s - 6) : (s == 10 ? C_VSB : C_VWB));
}

DI unsigned moba_select(const Params& p, const bf16x8 (&qf)[4], int b, int h, int bo, int lr, int lh) {
  const u16* kmp = p.kmean + ((size_t)(b * 4 + h) * 16 + (lr & 15)) * 64 + lh * 8;
  f32x16 s = zero16();
#pragma unroll
  for (int ks = 0; ks < 4; ++ks) s = mfma32(*(const bf16x8*)(kmp + ks * 16), qf[ks], s);
  float own[8], oth[8];
#pragma unroll
  for (int x = 0; x < 8; ++x) {
    const int n = 8 * (x >> 2) + 4 * lh + (x & 3);
    own[x] = n < bo ? s[x] : -1e30f;
  }
#pragma unroll
  for (int x = 0; x < 8; ++x) oth[x] = xor32_get(own[x], lh);
  unsigned mymask = 0;
#pragma unroll
  for (int x = 0; x < 8; ++x) {
    const int nx = 8 * (x >> 2) + 4 * lh + (x & 3);
    int rank = 0;
#pragma unroll
    for (int y = 0; y < 8; ++y) {
      const int ny = 8 * (y >> 2) + 4 * lh + (y & 3);
      const int no = 8 * (y >> 2) + 4 * (1 - lh) + (y & 3);
      if (y != x) rank += (own[y] > own[x]) || (own[y] == own[x] && ny < nx);
      rank += (oth[y] > own[x]) || (oth[y] == own[x] && no < nx);
    }
    if (rank < 3 && nx < bo) mymask |= 1u << nx;
  }
  mymask = xor32_or(mymask);
  return mymask;
}

DI void moba_mask_item(const Params& p, int b, int h, int qt) {
  const int lane = tid_() & 63, lr = lane & 31, lh = lane >> 5;
  const int bo = qt >> 3;
  unsigned mask = 0;
  if (bo > 0) {
    bf16x8 qf[4];
    const u16* qp = p.proj + ((size_t)b * 4096 + qt * 32 + lr) * NP + C_QC + h * 64 + lh * 8;
#pragma unroll
    for (int ks = 0; ks < 4; ++ks) qf[ks] = *(const bf16x8*)(qp + ks * 16);
    mask = moba_select(p, qf, b, h, bo, lr, lh);
  }
  if (lh == 0) p.selm16[(size_t)(b * 4 + h) * 4096 + qt * 32 + lr] = (u16)mask;
}

DI void moba_list_item(const Params& p, int b, int h, int n) {
  const int lane = tid_() & 63;
  const u16* selm = p.selm16 + (size_t)(b * 4 + h) * 4096;
  u16* lst = p.mlist + ((size_t)(b * 4 + h) * 16 + n) * 4096;
  int base = 0;
#pragma unroll 1
  for (int t0 = 256 * (n + 1); t0 < 4096; t0 += 512) {
    unsigned mk[8];
#pragma unroll
    for (int i = 0; i < 8; ++i) { const int t = t0 + 64 * i + lane; mk[i] = t < 4096 ? (unsigned)selm[t] : 0u; }
#pragma unroll
    for (int i = 0; i < 8; ++i) {
      const bool f = (mk[i] >> n) & 1u;
      const unsigned long long bal = __ballot(f);
      const int pos = base + __popcll(bal & ((1ull << lane) - 1ull));
      if (f) lst[pos] = (u16)(t0 + 64 * i + lane);
      base += __popcll(bal);
    }
  }
  if (lane == 0) p.mcnt[(b * 4 + h) * 16 + n] = base;
}

DI int moba_part_token(const Params& p, int bh, int n, int c, int cntn) {
  const int lr = tid_() & 31;
  const u16* lst = p.mlist + ((size_t)bh * 16 + n) * 4096;
  const int idx = c * 32 + lr;
  return (int)lst[idx < cntn ? idx : cntn - 1];
}
DI void moba_part_item(const Params& p, int b, int h, int n, int c, const int cntn, const int t) {
  const int lane = tid_() & 63, lr = lane & 31, lh = lane >> 5;
  const bool valid = c * 32 + lr < cntn;
  const size_t rowq = (size_t)b * 4096 + t;
  const unsigned mk = p.selm16[(size_t)(b * 4 + h) * 4096 + t];
  const u16* proj = p.proj;
  bf16x8 qf[4];
  {
    const u16* qp = proj + rowq * NP + C_QC + h * 64 + lh * 8;
#pragma unroll
    for (int ks = 0; ks < 4; ++ks) qf[ks] = *(const bf16x8*)(qp + ks * 16);
  }
  float m = M_INIT, l = 0.f; f32x16 O[2]; O[0] = zero16(); O[1] = zero16();
  {
    const size_t krow0 = (size_t)b * 4096;
    const int kcol = C_KC + h * 64 + lh * 8;
    const u16* vbase = p.VC + ((size_t)(b * 4 + h) * 128 * 2) * 1024 + lane * 16;
    const int kt0 = n * 8;
    attn_run(qf, [&](int prev) { return prev < 0 ? kt0 : (prev + 1 < kt0 + 8 ? prev + 1 : -1); },
             [&](int kt, const u16*& kp, const u16*& vp) { kp = proj + (krow0 + kt * 32 + lr) * NP + kcol; vp = vbase + (size_t)kt * 2048; },
             [&](int, int& lo, int& hi) { lo = -BIG; hi = BIG; }, m, l, O, lh);
  }
  const int k = __popc(mk & ((1u << n) - 1u));
  if (valid) {
    if (lh == 0) { float2 ml; ml.x = m; ml.y = l; *(float2*)(p.mlC + ((rowq * 4 + h) * 3 + k) * 2) = ml; }
  }
  state_store16(p.proj + rowq * NP + moba_seg_col(h, k), O, lh, valid);
}

DI void moba_item(const Params& p, int b, int h, int qt) {
  const int lane = tid_() & 63, lr = lane & 31, lh = lane >> 5;
  const int t0 = qt * 32, bo = qt >> 3, tq = t0 + lr;
  const size_t rowq = (size_t)b * 4096 + tq;
  const u16* proj = p.proj;
  bf16x8 qf[4];
  {
    const u16* qp = proj + rowq * NP + C_QC + h * 64 + lh * 8;
#pragma unroll
    for (int ks = 0; ks < 4; ++ks) qf[ks] = *(const bf16x8*)(qp + ks * 16);
  }
  float m = M_INIT, l = 0.f; f32x16 O[2]; O[0] = zero16(); O[1] = zero16();
  if (bo > 0) {
    const unsigned mk = p.selm16[(size_t)(b * 4 + h) * 4096 + tq];
    const int nsel = __popc(mk);
#pragma unroll
    for (int k = 0; k < 3; ++k) {
      const bool has = k < nsel;
      const float2 ml = *(const float2*)(p.mlC + ((rowq * 4 + h) * 3 + k) * 2);
      const float mk_ = has ? ml.x : -1e30f, lk = has ? ml.y : 0.f;
      const float mn = fmaxf(m, mk_);
      const float a = __builtin_amdgcn_exp2f(m - mn), bs = has ? __builtin_amdgcn_exp2f(mk_ - mn) : 0.f;
      l = l * a + lk * bs; m = mn;
      f32x16 T[2];
      state_load16(proj + rowq * NP + moba_seg_col(h, k), T, lh);
#pragma unroll
      for (int dt = 0; dt < 2; ++dt)
#pragma unroll
        for (int r = 0; r < 16; ++r) O[dt][r] = O[dt][r] * a + (has ? T[dt][r] : 0.f) * bs;
    }
  }
  {
    const size_t krow0 = (size_t)b * 4096;
    const int kcol = C_KC + h * 64 + lh * 8;
    const u16* vbase = p.VC + ((size_t)(b * 4 + h) * 128 * 2) * 1024 + lane * 16;
    attn_run(qf, [&](int prev) { return prev < 0 ? qt : (prev == qt ? (bo * 8 < qt ? bo * 8 : -1) : (prev + 1 < qt ? prev + 1 : -1)); },
             [&](int kt, const u16*& kp, const u16*& vp) { kp = proj + (krow0 + kt * 32 + lr) * NP + kcol; vp = vbase + (size_t)kt * 2048; },
             [&](int kt, int& lo, int& hi) { lo = -BIG; hi = kt == qt ? lr : BIG; }, m, l, O, lh);
  }
  const float inv = 1.f / l;
#pragma unroll
  for (int dt = 0; dt < 2; ++dt)
#pragma unroll
    for (int rr = 0; rr < 16; ++rr) O[dt][rr] *= inv;
  store_gated(p.proj + rowq * NP + C_ZC + h * 64 + 4 * lh, p.obuf + rowq * 896 + 640 + h * 64 + 4 * lh, O);
}

DI void nsa_item(const Params& p, int b, int qt, char* smraw) {
  float* pslc = (float*)smraw;
  unsigned* selm = (unsigned*)(smraw + 33280);
  const int tid = tid_(), lane = tid & 63, g = tid >> 6, lr = lane & 31, lh = lane >> 5;
  const int t0 = qt * 32, tq = t0 + lr;
  const size_t rowq = (size_t)b * 4096 + tq;
  const u16* proj = p.proj;
  bf16x8 qf[4];
  {
    const u16* qp = proj + rowq * NP + C_QB + g * 64 + lh * 8;
#pragma unroll
    for (int ks = 0; ks < 4; ++ks) qf[ks] = *(const bf16x8*)(qp + ks * 16);
  }
  const int nvq = tq >= 31 ? ((tq - 31) >> 4) + 1 : 0;
  const int nct = ((t0 >> 4) + 1 + 31) >> 5;
  float m_c = M_INIT, l_c = 0.f; f32x16 Oc[2]; Oc[0] = zero16(); Oc[1] = zero16();
  const u16* kcb = p.kc + (size_t)b * 256 * 64 + lh * 8;
  const u16* vcb = p.vcF + (size_t)b * 16 * 1024 + lane * 16;
  char* kvlds = smraw + 34816;
  attn_run_shared(qf, [&](int prev) { return prev + 1 < nct ? prev + 1 : -1; },
                  [&](int ct, const u16*& kb, int& kst, const u16*& vt) {
                    kb = p.kc + ((size_t)b * 256 + ct * 32) * 64; kst = 64; vt = p.vcF + ((size_t)b * 8 + ct) * 2048;
                  },
                  [&](int ct, int& lo, int& hi) { lo = -BIG; hi = nvq - 1 - ct * 32; }, m_c, l_c, Oc, kvlds);
  const float invc = l_c > 0.f ? 1.f / l_c : 0.f;
  const u16* gp = proj + rowq * NP + C_GB + g;
  const u16 gq0 = gp[0], gq1 = gp[4], gq2 = gp[8];
  unsigned Opk[2][8];
  {
    const float g0 = sigmoidf_(bf2f(gq0)) * invc;
#pragma unroll
    for (int dt = 0; dt < 2; ++dt)
#pragma unroll
      for (int rr = 0; rr < 8; ++rr) Opk[dt][rr] = pack2(g0 * Oc[dt][2 * rr], g0 * Oc[dt][2 * rr + 1]);
  }
  {
    float carry = 0.f;
    const int ptid = tid_(), krow = ptid >> 3, kc = ptid & 7;
    const int kdst = krow * 128 + ((kc ^ ((krow >> 1) & 7)) * 16);
    const int ksw = (lr >> 1) & 7;
    const u16* kcg = p.kc + (size_t)b * 256 * 64 + (size_t)krow * 64 + kc * 8;
    uint4 kreg = *(const uint4*)kcg;
#pragma unroll 1
    for (int ct = 0; ct < 8; ++ct) {
      float tot[4] = {0.f, 0.f, 0.f, 0.f};
      if (ct < nct) {
        char* buf = kvlds + (ct & 1) * 8192;
        *(uint4*)(buf + kdst) = kreg;
        __syncthreads();
        kreg = *(const uint4*)(kcg + (size_t)(ct + 1 < nct ? ct + 1 : ct) * 32 * 64);
        f32x16 sc = zero16();
#pragma unroll
        for (int ks = 0; ks < 4; ++ks)
          sc = mfma32(*(const bf16x8*)(buf + lr * 128 + (((ks * 2 + lh) ^ ksw) * 16)), qf[ks], sc);
        float gs[4], sp[4];
#pragma unroll
        for (int i = 0; i < 4; ++i) {
          float s4 = 0.f, last = 0.f;
#pragma unroll
          for (int j = 0; j < 4; ++j) {
            const int c = ct * 32 + 4 * lh + 8 * i + j;
            const float e = (c < nvq) ? __builtin_amdgcn_exp2f(sc[i * 4 + j] - m_c) * invc : 0.f;
            s4 += e; last = e;
          }
          gs[i] = s4; sp[i] = last;
        }
        float ps[4];
#pragma unroll
        for (int i = 0; i < 4; ++i) ps[i] = xor32_get(sp[i], lh);
        if (lh) {
#pragma unroll
          for (int i = 0; i < 4; ++i) tot[i] = gs[i] + ps[i];
        } else {
          tot[0] = gs[0] + carry; tot[1] = gs[1] + ps[0]; tot[2] = gs[2] + ps[1]; tot[3] = gs[3] + ps[2];
          carry = ps[3];
        }
      } else {
        if (!lh) { tot[0] = carry; carry = 0.f; }
      }
#pragma unroll
      for (int i = 0; i < 4; ++i) pslc[(g * 32 + lr) * 65 + ct * 8 + 2 * i + lh] = tot[i];
    }
  }
  __syncthreads();
#pragma unroll 1
  for (int qi = 0; qi < 8; ++qi) {
    const int q = g * 8 + qi, J = lane, tqq = t0 + q, cur = tqq >> 6;
    const bool forced = (J == 0) || (J == cur) || (J == cur - 1);
    const bool valid = (J * 64 <= tqq);
    const float psum = ((pslc[(0 * 32 + q) * 65 + J] + pslc[(1 * 32 + q) * 65 + J]) + pslc[(2 * 32 + q) * 65 + J]) + pslc[(3 * 32 + q) * 65 + J];
    const float scv = forced ? 1e4f : (valid ? psum : -1e30f);
    int rank = 0;
#pragma unroll 4
    for (int j2 = 0; j2 < 64; ++j2) {
      const float o = __int_as_float(__builtin_amdgcn_readlane(__float_as_int(scv), j2));
      rank += ((o > scv) || (o == scv && j2 < J)) ? 1 : 0;
    }
    const bool sel = (rank < 16) && valid;
    const unsigned long long mk = __ballot(sel);
    if (lane == 0) { selm[q * 2] = (unsigned)mk; selm[q * 2 + 1] = (unsigned)(mk >> 32); }
  }
  __syncthreads();
  const unsigned mlo = selm[lr * 2], mhi = selm[lr * 2 + 1];
  unsigned alo = mlo, ahi = mhi;
#pragma unroll
  for (int o = 1; o < 32; o <<= 1) { alo |= __shfl_xor(alo, o); ahi |= __shfl_xor(ahi, o); }
  alo = __builtin_amdgcn_readfirstlane(alo); ahi = __builtin_amdgcn_readfirstlane(ahi);
  float m_s = M_INIT, l_s = 0.f; f32x16 Os[2]; Os[0] = zero16(); Os[1] = zero16();
  {
    const u16* vb = p.VS + ((size_t)b * 128 * 2) * 1024 + lane * 16;
    const unsigned long long any64 = ((unsigned long long)ahi << 32) | alo;
    const unsigned long long my64 = ((unsigned long long)mhi << 32) | mlo;
    const int Jmax = qt >> 1;
    auto next = [&](int prevJ) {
      const int J0 = prevJ + 1;
      if (J0 > Jmax) return -1;
      const unsigned long long mk = any64 >> J0;
      if (!mk) return -1;
      const int J = J0 + __builtin_ctzll(mk);
      return J <= Jmax ? J : -1;
    };
    auto band2 = [&](int J, int half, int& lo, int& hi) {
      lo = -BIG; hi = ((my64 >> J) & 1ull) ? tq - (2 * J + half) * 32 : -2 * BIG;
    };
    attn_run_shared2(qf, next, proj + ((size_t)b * 4096) * NP + C_KSB, p.VS + ((size_t)b * 128) * 2048, qt, band2, m_s, l_s, Os, kvlds);
  }
  {
    const float g1 = sigmoidf_(bf2f(gq1)) / l_s;
#pragma unroll
    for (int dt = 0; dt < 2; ++dt)
#pragma unroll
      for (int rr = 0; rr < 8; ++rr)
        Opk[dt][rr] = pack2(bf2f((u16)(Opk[dt][rr] & 0xffff)) + g1 * Os[dt][2 * rr], bf2f((u16)(Opk[dt][rr] >> 16)) + g1 * Os[dt][2 * rr + 1]);
  }
  m_s = M_INIT; l_s = 0.f; Os[0] = zero16(); Os[1] = zero16();
  {
    const u16* vb = p.VW + ((size_t)b * 128 * 2) * 1024 + lane * 16;
    const int klo = qt - 16 < 0 ? 0 : qt - 16;
    attn_run_shared(qf, [&](int prev) { return prev < 0 ? qt : (prev - 1 >= klo ? prev - 1 : -1); },
                    [&](int kt, const u16*& kb, int& kst, const u16*& vt) {
                      kb = proj + ((size_t)b * 4096 + kt * 32) * NP + C_KWB; kst = NP; vt = p.VW + ((size_t)b * 128 + kt) * 2048;
                    },
                    [&](int kt, int& lo, int& hi) { hi = tq - kt * 32; lo = hi - 511; }, m_s, l_s, Os, kvlds);
  }
  {
    const float g2 = sigmoidf_(bf2f(gq2)) / l_s;
#pragma unroll
    for (int dt = 0; dt < 2; ++dt)
#pragma unroll
      for (int rr = 0; rr < 8; ++rr) {
        Os[dt][2 * rr] = bf2f((u16)(Opk[dt][rr] & 0xffff)) + g2 * Os[dt][2 * rr];
        Os[dt][2 * rr + 1] = bf2f((u16)(Opk[dt][rr] >> 16)) + g2 * Os[dt][2 * rr + 1];
      }
  }
  store_gated(p.proj + rowq * NP + C_ZB + g * 64 + 4 * lh, p.obuf + rowq * 896 + 384 + g * 64 + 4 * lh, Os);
  __syncthreads();
}

DI void phase_attn_far(const Params& p_in, const BlkMap bm) {
  const Params p = launder(p_in);
  const int wid = tid_() >> 6;
  for (int it = bm.j * 4 + wid; it < 512; it += bm.per * 4) {
    const int bh = bm.x + 8 * (it >> 7);
    moba_mask_item(p, bh >> 2, bh & 3, it & 127);
  }
  for (int w = bm.j; w < 192; w += bm.per) {
    const int bh = bm.x + 8 * (w >> 5), sub = w & 31;
    mixA_far_item(p, bh / 6, bh % 6, (sub >> 2) * 512, (sub & 3) * 4 + wid);
  }
}

DI void phase_attn_lists(const Params& p_in, const BlkMap bm) {
  const Params p = launder(p_in);
  const int wid = tid_() >> 6;
  for (int it = bm.j * 4 + wid; it < 60; it += bm.per * 4) {
    const int bh = bm.x + 8 * (it / 15);
    moba_list_item(p, bh >> 2, bh & 3, it % 15);
  }
}

DI void phase_attn(const Params& p_in, const BlkMap bm, char* smraw) {
  const Params p = launder(p_in);
  const int wid = tid_() >> 6;
  for (int w = bm.j; w < 128; w += bm.per) {
    const int qt = w < 64 ? 127 - w : w - 64;
    nsa_item(p, bm.x, qt, smraw);
  }
  for (int w = bm.j; w < 192; w += bm.per) {
    const int bh = bm.x + 8 * (w >> 5), sub = w & 31;
    mixA_item(p, bh / 6, bh % 6, sub * 128, wid);
  }
  {
    const int nwv = bm.per * 4;
    int tot[4];
#pragma unroll
    for (int i = 0; i < 4; ++i) {
      const int* cnt = p.mcnt + (bm.x + 8 * i) * 16;
      int tt = 0;
#pragma unroll 1
      for (int n = 0; n < 15; ++n) tt += (cnt[n] + 31) >> 5;
      tot[i] = tt;
    }
    const int ntot = tot[0] + tot[1] + tot[2] + tot[3];
    auto decode = [&](int it, int& bh, int& n, int& c, int& cntn) {
      int f = it, i = 0;
      if (f >= tot[0]) { f -= tot[0]; i = 1; if (f >= tot[1]) { f -= tot[1]; i = 2; if (f >= tot[2]) { f -= tot[2]; i = 3; } } }
      bh = bm.x + 8 * i;
      const int* cnt = p.mcnt + bh * 16;
      n = 0; cntn = cnt[0];
#pragma unroll 1
      for (; n < 14; ++n) { const int ch = (cntn + 31) >> 5; if (f < ch) break; f -= ch; cntn = cnt[n + 1]; }
      c = f;
    };
    int it = bm.j * 4 + wid;
    if (it < ntot) {
      int bh, n, c, cntn; decode(it, bh, n, c, cntn);
      int t = moba_part_token(p, bh, n, c, cntn);
#pragma unroll 1
      while (true) {
        const int it2 = it + nwv;
        const bool more = it2 < ntot;
        int bh2 = bh, n2 = n, c2 = c, cntn2 = cntn;
        if (more) decode(it2, bh2, n2, c2, cntn2);
        const int t2 = moba_part_token(p, bh2, n2, c2, cntn2);
        moba_part_item(p, bh >> 2, bh & 3, n, c, cntn, t);
        if (!more) break;
        it = it2; bh = bh2; n = n2; c = c2; cntn = cntn2; t = t2;
      }
    }
  }
}

DI void phase_attn_fin(const Params& p_in, const BlkMap bm) {
  const Params p = launder(p_in);
  const int wid = tid_() >> 6;
  for (int w = bm.j; w < 128; w += bm.per) {
    const int bh = bm.x + 8 * (w >> 5), qg = w & 31;
    moba_item(p, bh >> 2, bh & 3, qg * 4 + wid);
  }
}

DI void phase_merge(const Params& p_in, const BlkMap bm, int l, u16* sm) {
  const Params p = launder(p_in);
  const int tid = tid_(), lane = tid & 63, wid = tid >> 6, wm = wid >> 1, wn = wid & 1;
  const int lr = lane & 31, lh = lane >> 5;
  const u16* Wbr = p.Wbr + (size_t)l * 1024 * 896;
  const u16* Wg = p.Wg + (size_t)l * 3072 * 1024;
  for (int k = 0;; ++k) {
    int mt, nt;
    if (!tile_map(bm, k, 256, 8, mt, nt)) break;
    const int m0 = mt * 128, n0 = nt * 128;
    f32x16 yacc[2][2];
#pragma unroll
    for (int a = 0; a < 2; ++a)
#pragma unroll
      for (int b = 0; b < 2; ++b) yacc[a][b] = zero16();
#pragma unroll 1
    for (int br = 0; br < 3; ++br) {
      const int kofs = br == 0 ? 0 : (br == 1 ? 384 : 640);
      const int Kb = br == 0 ? 384 : 256;
      unsigned sg[2][2][8];
      {
        f32x16 gg[2][2];
#pragma unroll
        for (int a = 0; a < 2; ++a)
#pragma unroll
          for (int b = 0; b < 2; ++b) gg[a][b] = zero16();
        gemm_loop<2, 2, 4, true>(p.xb + (size_t)m0 * 1024, 1024, Wg + (size_t)(br * 1024 + n0) * 1024, 1024, 1024, gg, sm);
#pragma unroll
        for (int a = 0; a < 2; ++a)
#pragma unroll
          for (int b = 0; b < 2; ++b)
#pragma unroll
            for (int r = 0; r < 8; ++r) sg[a][b][r] = pack2(sigmoidf_(gg[a][b][2 * r]), sigmoidf_(gg[a][b][2 * r + 1]));
      }
      f32x16 u[2][2];
#pragma unroll
      for (int a = 0; a < 2; ++a)
#pragma unroll
        for (int b = 0; b < 2; ++b) u[a][b] = zero16();
      gemm_loop<2, 2, 4, true>(p.obuf + (size_t)m0 * 896 + kofs, 896, Wbr + (size_t)n0 * 896 + kofs, 896, Kb, u, sm);
#pragma unroll
      for (int a = 0; a < 2; ++a)
#pragma unroll
        for (int b = 0; b < 2; ++b)
#pragma unroll
          for (int r = 0; r < 8; ++r) {
            yacc[a][b][2 * r] += bf2f((u16)(sg[a][b][r] & 0xffff)) * u[a][b][2 * r];
            yacc[a][b][2 * r + 1] += bf2f((u16)(sg[a][b][r] >> 16)) * u[a][b][2 * r + 1];
          }
    }
    tile_store_bf16<2>(yacc, p.y + (size_t)m0 * 1024 + n0, 1024, (char*)sm);
  }
}

DI void phase_out(const Params& p_in, const BlkMap bm, int l, const float* xres, u16* sm) {
  const Params p = launder(p_in);
  const int tid = tid_(), lane = tid & 63, wid = tid >> 6, wm = wid >> 1, wn = wid & 1;
  const int lr = lane & 31, lh = lane >> 5;
  const u16* Wo = p.Wout + (size_t)l * 1024 * 1024;
  for (int k = 0;; ++k) {
    int mt, nt;
    if (!tile_map(bm, k, 128, 8, mt, nt)) break;
    const int m0 = mt * 256, n0 = nt * 128;
    f32x16 acc[4][2];
#pragma unroll
    for (int a = 0; a < 4; ++a)
#pragma unroll
      for (int b = 0; b < 2; ++b) acc[a][b] = zero16();
    gemm_loop<4, 2, 3, false>(p.y + (size_t)m0 * 1024, 1024, Wo + (size_t)n0 * 1024, 1024, 1024, acc, sm);
#pragma unroll
    for (int mi = 0; mi < 4; ++mi) {
      float res[2][16];
#pragma unroll
      for (int ni = 0; ni < 2; ++ni)
#pragma unroll
        for (int r = 0; r < 16; ++r) {
          const int row = m0 + wm * 128 + mi * 32 + 4 * lh + 8 * (r >> 2) + (r & 3);
          res[ni][r] = __builtin_nontemporal_load(xres + (size_t)row * 1024 + n0 + wn * 64 + ni * 32 + lr);
        }
#pragma unroll
      for (int ni = 0; ni < 2; ++ni)
#pragma unroll
        for (int r = 0; r < 16; ++r) {
          const int row = m0 + wm * 128 + mi * 32 + 4 * lh + 8 * (r >> 2) + (r & 3);
          __builtin_nontemporal_store(res[ni][r] + acc[mi][ni][r], p.out + (size_t)row * 1024 + n0 + wn * 64 + ni * 32 + lr);
        }
    }
  }
}

#define XB_TMO      128
#define XB_XCNT(j)  (256  + 64 * (j))
#define XB_XSUB(j)  (1280 + 64 * (j))
#define XB_XGEN(j)  (2304 + 64 * (j))
#define XB_TOP      3328
#define XB_TOPGEN   3392
#define XB_RANK(j)  (3456 + 64 * (j))
#define XCD_BAR_WORDS 4480
#define XB_SPIN_CAP (1u << 18)
#define LAS __attribute__((address_space(3)))
DI unsigned xb_ld(unsigned* p) { return __hip_atomic_load(p, __ATOMIC_RELAXED, __HIP_MEMORY_SCOPE_AGENT); }
DI unsigned xb_add(unsigned* p, unsigned v) { return __hip_atomic_fetch_add(p, v, __ATOMIC_RELAXED, __HIP_MEMORY_SCOPE_AGENT); }
DI unsigned xb_xcc_id() { return (unsigned)__builtin_amdgcn_s_getreg((3 << 11) | 20) & 0xFu; }
#define XB_SPIN(cond, bar) do { unsigned _sp = 0; while (cond) { __builtin_amdgcn_s_sleep(1); \
    if ((++_sp & 255u) == 0u) { if (xb_ld(&(bar)[XB_TMO])) break; if (_sp > XB_SPIN_CAP) { atomicAdd(&(bar)[XB_TMO], 1u); break; } } } } while (0)
struct XcdBarrier { unsigned* bar; unsigned x; volatile LAS unsigned* st; };
DI XcdBarrier xcd_barrier_post(unsigned* bar, volatile LAS unsigned* st) {
  XcdBarrier b; b.bar = bar; b.x = xb_xcc_id(); b.st = st;
  if (threadIdx.x == 0) (void)xb_add(&bar[XB_XCNT(b.x)], 1u);
  return b;
}
DI void xcd_barrier_complete(unsigned* bar, unsigned x, unsigned& nloc, unsigned& nx) {
  const unsigned G = gridDim.x * gridDim.y * gridDim.z;
  unsigned sum, cnt, mine, sp = 0u;
  for (;;) {
    sum = 0u; cnt = 0u; mine = 0u;
#pragma unroll
    for (unsigned j = 0; j < 16; ++j) { const unsigned c = xb_ld(&bar[XB_XCNT(j)]); sum += c; cnt += (c > 0u) ? 1u : 0u; mine = (j == x) ? c : mine; }
    if (sum == G) break;
    __builtin_amdgcn_s_sleep(1);
    if ((++sp & 255u) == 0u) { if (xb_ld(&bar[XB_TMO])) break; if (sp > XB_SPIN_CAP) { atomicAdd(&bar[XB_TMO], 1u); break; } }
  }
  nloc = mine > 0u ? mine : 1u; nx = cnt > 0u ? cnt : 1u;
}
DI void xcd_barrier(const XcdBarrier& b) {
  asm volatile("s_waitcnt vmcnt(0)" ::: "memory");
  __syncthreads();
  if (threadIdx.x == 0) {
    unsigned* bar = b.bar;
    __builtin_amdgcn_s_waitcnt(0);
    unsigned nloc = b.st[0], nx = b.st[1];
    if (nloc == 0u) { xcd_barrier_complete(bar, b.x, nloc, nx); b.st[0] = nloc; b.st[1] = nx; }
    const unsigned old = xb_add(&bar[XB_XSUB(b.x)], 1u);
    const unsigned gen = old / nloc;
    if (old + 1u == (gen + 1u) * nloc) {
      __builtin_amdgcn_fence(__ATOMIC_RELEASE, "agent");
      asm volatile("s_waitcnt vmcnt(0)" ::: "memory");
      const unsigned og = xb_add(&bar[XB_TOP], 1u);
      const unsigned tg = og / nx;
      if (og + 1u == (tg + 1u) * nx) xb_add(&bar[XB_TOPGEN], 1u);
      else XB_SPIN(xb_ld(&bar[XB_TOPGEN]) == tg, bar);
      __builtin_amdgcn_fence(__ATOMIC_ACQUIRE, "agent");
      xb_add(&bar[XB_XGEN(b.x)], 1u);
      asm volatile("s_waitcnt vmcnt(0)" ::: "memory");
    } else {
      XB_SPIN(xb_ld(&bar[XB_XGEN(b.x)]) == gen, bar);
      __builtin_amdgcn_fence(__ATOMIC_ACQUIRE, "agent");
      asm volatile("s_waitcnt vmcnt(0)" ::: "memory");
    }
  }
  __syncthreads();
}

__global__ void __launch_bounds__(256, 2) hybrid_megakernel(Params p) {
  extern __shared__ __attribute__((aligned(16))) char smraw[];
  cg::grid_group grid = cg::this_grid();
  volatile LAS unsigned* xst = (volatile LAS unsigned*)(smraw + SMEM_MAIN);
  if (threadIdx.x == 0) { xst[0] = 0u; xst[1] = 0u; }
  __syncthreads();
  const XcdBarrier xb = xcd_barrier_post(p.bar, xst);
  if (threadIdx.x == 0) xst[2] = xb_add(&p.bar[XB_RANK(xb.x)], 1u);
  if (p.out == nullptr) grid.sync();
  prep_weights(p, (float*)smraw);
  prep_misc(p);
  rmsnorm_rows(p.x, p.norm_g, p.xb);
  xcd_barrier(xb);
  BlkMap bm;
  {
    bool ok = true; unsigned mine = 0;
#pragma unroll
    for (unsigned j = 0; j < 16; ++j) {
      const unsigned c = xb_ld(&p.bar[XB_XCNT(j)]);
      ok = ok && (j < 8 ? c > 0u : c == 0u);
      mine = (j == xb.x) ? c : mine;
    }
    const unsigned rank = xst[2];
    bm.x = ok ? (int)xb.x : (int)(blockIdx.x & 7);
    bm.j = ok ? (int)rank : (int)(blockIdx.x >> 3);
    bm.per = ok ? (int)mine : (int)(gridDim.x >> 3);
    bm.x = __builtin_amdgcn_readfirstlane(bm.x); bm.j = __builtin_amdgcn_readfirstlane(bm.j); bm.per = __builtin_amdgcn_readfirstlane(bm.per);
  }
#pragma unroll 1
  for (int l = 0; l < 2; ++l) {
    const float* xin = l == 0 ? p.x : p.out;
    phase_inproj(p, bm, l, (u16*)smraw);
    xcd_barrier(xb);
    phase_mid(p, l, smraw);
    xcd_barrier(xb);
    phase_attn_far(p, bm);
    xcd_barrier(xb);
    phase_attn_lists(p, bm);
    xcd_barrier(xb);
    phase_attn(p, bm, smraw);
    xcd_barrier(xb);
    phase_attn_fin(p, bm);
    xcd_barrier(xb);
    phase_merge(p, bm, l, (u16*)smraw);
    xcd_barrier(xb);
    phase_out(p, bm, l, xin, (u16*)smraw);
    if (l == 0) {
      xcd_barrier(xb);
      rmsnorm_rows(p.out, p.norm_g + 1024, p.xb);
      xcd_barrier(xb);
    }
  }
}

extern "C" void kernel_launch(void* const* d_in, const int* in_sizes, int n_in, void* d_out, int out_size,
                              void* d_ws, size_t ws_size, hipStream_t stream) {
  Params p{};
  p.x = (const float*)d_in[0]; p.pos = (const int*)d_in[1]; p.norm_g = (const float*)d_in[2]; p.w_in = (const float*)d_in[3];
  p.qna = (const float*)d_in[4]; p.kna = (const float*)d_in[5]; p.qnb = (const float*)d_in[6]; p.knb = (const float*)d_in[7];
  p.qnc = (const float*)d_in[8]; p.knc = (const float*)d_in[9]; p.cmp_pos = (const float*)d_in[10];
  p.ckw1 = (const float*)d_in[11]; p.ckw2 = (const float*)d_in[12]; p.cvw1 = (const float*)d_in[13]; p.cvw2 = (const float*)d_in[14];
  p.wbra = (const float*)d_in[15]; p.wbrb = (const float*)d_in[16]; p.wbrc = (const float*)d_in[17]; p.wout = (const float*)d_in[18];
  p.out = (float*)d_out;
  char* ws = (char*)d_ws; size_t off = 0;
  auto take = [&](size_t bytes) { char* r = ws + off; off += (bytes + 255) & ~(size_t)255; return r; };
  p.xb = (u16*)take((size_t)32768 * 1024 * 2);
  p.proj = (u16*)take((size_t)32768 * NP * 2);
  p.Wt1 = (u16*)take((size_t)2 * NP * 1024 * 2);
  p.Wg = (u16*)take((size_t)2 * 3072 * 1024 * 2);
  p.Wbr = (u16*)take((size_t)2 * 1024 * 896 * 2);
  p.Wout = (u16*)take((size_t)2 * 1024 * 1024 * 2);
  p.W1t = (u16*)take((size_t)4 * 128 * 2048 * 2);
  p.W2t = (u16*)take((size_t)4 * 64 * 128 * 2);
  p.bias1 = (float*)take(512 * 4);
  p.kc = (u16*)take((size_t)2048 * 64 * 2);
  p.vcF = (u16*)take((size_t)2048 * 64 * 2);
  p.VS = (u16*)take((size_t)2048 * 1024 * 2);
  p.VW = (u16*)take((size_t)2048 * 1024 * 2);
  p.VC = (u16*)take((size_t)8192 * 1024 * 2);
  p.kmean = (u16*)take((size_t)512 * 64 * 2);
  p.rope = (float*)take((size_t)32768 * 16 * 4);
  p.obuf = (u16*)take((size_t)32768 * 896 * 2);
  p.bar = (unsigned*)take((size_t)XCD_BAR_WORDS * 4);
  p.mlA = (float*)take((size_t)32768 * 6 * 2 * 4);
  p.selm16 = (u16*)take((size_t)32 * 4096 * 2);
  p.mlist = (u16*)take((size_t)32 * 16 * 4096 * 2);
  p.mcnt = (int*)take((size_t)32 * 16 * 4);
  p.mlC = (float*)take((size_t)32768 * 4 * 3 * 2 * 4);
  char* va = take((size_t)3 * 12288 * 1024 * 2);
  p.VA1 = (u16*)va; p.VA4 = (u16*)(va + (size_t)12288 * 1024 * 2); p.VA16 = (u16*)(va + (size_t)2 * 12288 * 1024 * 2);
  p.y = (u16*)va;
  if (off > ws_size) { fprintf(stderr, "workspace too small: need %zu have %zu\n", off, ws_size); return; }

  static int grid_blocks = 0;
  if (!grid_blocks) {
    int dev = 0, cus = 0, per_cu = 0;
    hipGetDevice(&dev);
    hipDeviceGetAttribute(&cus, hipDeviceAttributeMultiprocessorCount, dev);
    hipFuncSetAttribute((const void*)hybrid_megakernel, hipFuncAttributeMaxDynamicSharedMemorySize, SMEM_BYTES);
    hipOccupancyMaxActiveBlocksPerMultiprocessor(&per_cu, hybrid_megakernel, 256, SMEM_BYTES);
    if (per_cu > 2) per_cu = 2;
    if (per_cu < 1) per_cu = 1;
    if (cus < 8) cus = 8;
    grid_blocks = cus * per_cu;
  }
  hipMemsetAsync(p.bar, 0, (size_t)XCD_BAR_WORDS * 4, stream);
  void* args[] = {&p};
  hipError_t e = hipLaunchCooperativeKernel((void*)hybrid_megakernel, dim3(grid_blocks), dim3(256), args, SMEM_BYTES, stream);
  if (e != hipSuccess) fprintf(stderr, "cooperative launch failed: %s (grid %d)\n", hipGetErrorString(e), grid_blocks);
}
```
